# Optimizing an MI355X kernel written in HIP

```python
import math
import jax, jax.numpy as jnp
from jax import lax
import numpy as np

D_MODEL = 1024
BATCH = 16
SEQ = 4096
DEPTH = 4

CHUNK = 64
N_META = 16
Q_BLOCK = 128
DA_HEADS = D_MODEL // 128
DA_HEAD_DIM = 32
DA_WIDTH = DA_HEADS * 2 * DA_HEAD_DIM
LRU_WIDTH = D_MODEL
LRU_HEADS = D_MODEL // 64
LRU_BLOCK = LRU_WIDTH // LRU_HEADS
CONV_WIDTH = 4
LRU_C = 8.0
D_FF = 256 * ((8 * D_MODEL // 3 + 255) // 256)
N_EXPERTS = 8
TOP_K = 2
N_DENSE = (DEPTH + 1) // 2
N_MOE = DEPTH // 2
ALPHA = (2 * DEPTH) ** 0.25
BETA = (8 * DEPTH) ** -0.25
LN_EPS = 1e-5
RMS_EPS = 1e-5
PROJ_WIDTH = 3 * DA_WIDTH + 2 * LRU_WIDTH + 2 * D_MODEL
PROJ_SPLITS = (DA_WIDTH, 2 * DA_WIDTH, 3 * DA_WIDTH, 3 * DA_WIDTH + LRU_WIDTH,
               3 * DA_WIDTH + 2 * LRU_WIDTH, 3 * DA_WIDTH + 2 * LRU_WIDTH + D_MODEL)

kernel_name = 'hybrid_diffattn_rglru_moe_deepnorm'


def layer_norm(x, g, b):
    xf = x.astype(jnp.float32)
    mu = jnp.mean(xf, axis=-1, keepdims=True)
    var = jnp.mean(jnp.square(xf - mu), axis=-1, keepdims=True)
    y = (xf - mu) * lax.rsqrt(var + LN_EPS)
    return (y * g.astype(jnp.float32) + b.astype(jnp.float32)).astype(x.dtype)


def diff_attention(q, k, v, lam, lam_init, subln_g):
    B, T = q.shape[0], q.shape[1]
    q = q * (DA_HEAD_DIM ** -0.5)

    def attend(qb, kb, vb, mask):
        s = jnp.einsum('bqhmd,bkhmd->bhmqk', qb, kb).astype(jnp.float32)
        if mask is not None:
            s = jnp.where(mask, s, -jnp.inf)
        p = jax.nn.softmax(s, axis=-1)
        a = p[:, :, 0] - lam * p[:, :, 1]
        return jnp.einsum('bhqk,bkhe->bqhe', a.astype(vb.dtype), vb)

    outs = [attend(q[:, :N_META], k[:, :N_META], v[:, :N_META], None)]
    cidx = np.arange(Q_BLOCK) // CHUNK
    diag = jnp.asarray(cidx[None, :] <= cidx[:, None])
    n_blocks = (T - N_META) // Q_BLOCK
    for blk in range(n_blocks):
        q0 = N_META + blk * Q_BLOCK
        k_end = q0 + Q_BLOCK
        mask = jnp.concatenate([jnp.ones((Q_BLOCK, q0), dtype=bool), diag], axis=1)
        outs.append(attend(q[:, q0:k_end], k[:, :k_end], v[:, :k_end], mask))
    o = jnp.concatenate(outs, axis=1)
    of = o.astype(jnp.float32)
    of = of * lax.rsqrt(jnp.mean(jnp.square(of), axis=-1, keepdims=True) + RMS_EPS)
    of = of * subln_g.astype(jnp.float32) * (1.0 - lam_init)
    return of.astype(o.dtype).reshape(B, T, DA_WIDTH)


def causal_depthwise_conv(x, w, b):
    T = x.shape[1]
    xp = jnp.pad(x, ((0, 0), (CONV_WIDTH - 1, 0), (0, 0)))
    y = xp[:, 0:T] * w[0]
    for j in range(1, CONV_WIDTH):
        y = y + xp[:, j:j + T] * w[j]
    return y + b


def rg_lru(x, w_r, b_r, w_i, b_i, lam_param):
    B, T, C = x.shape
    xb = x.reshape(B, T, LRU_HEADS, LRU_BLOCK)
    r = jax.nn.sigmoid((jnp.einsum('bthi,hij->bthj', xb, w_r).reshape(B, T, C) + b_r).astype(jnp.float32))
    i = jax.nn.sigmoid((jnp.einsum('bthi,hij->bthj', xb, w_i).reshape(B, T, C) + b_i).astype(jnp.float32))
    log_a = -LRU_C * r * jax.nn.softplus(-lam_param.astype(jnp.float32))
    a = jnp.exp(log_a)
    mult = jnp.sqrt(-jnp.expm1(2.0 * log_a))
    u = mult * i * x.astype(jnp.float32)

    def combine(left, right):
        a_l, u_l = left
        a_r, u_r = right
        return a_l * a_r, a_r * u_l + u_r

    _, h = lax.associative_scan(combine, (a, u), axis=1)
    return h.astype(x.dtype)


def token_mixer(h, layer, w_in, b_gate, da_lambda, da_subln_g, conv_w, conv_b,
                lru_wr, lru_br, lru_wi, lru_bi, lru_lambda, w_attn_out, w_lru_out, w_o):
    B, T, _ = h.shape
    z = h @ w_in
    q, k, v, xr, gr, ga, gl = jnp.split(z, PROJ_SPLITS, axis=-1)
    q = q.reshape(B, T, DA_HEADS, 2, DA_HEAD_DIM)
    k = k.reshape(B, T, DA_HEADS, 2, DA_HEAD_DIM)
    v = v.reshape(B, T, DA_HEADS, 2 * DA_HEAD_DIM)
    lam_init = 0.8 - 0.6 * math.exp(-0.3 * layer)
    lf = da_lambda.astype(jnp.float32)
    lam = jnp.exp(jnp.sum(lf[0] * lf[1])) - jnp.exp(jnp.sum(lf[2] * lf[3])) + lam_init
    attn_up = diff_attention(q, k, v, lam, lam_init, da_subln_g) @ w_attn_out
    xr = causal_depthwise_conv(xr, conv_w, conv_b)
    rec = rg_lru(xr, lru_wr, lru_br, lru_wi, lru_bi, lru_lambda) * jax.nn.gelu(gr)
    lru_up = rec @ w_lru_out
    merged = jax.nn.sigmoid(ga + b_gate[0]) * attn_up + jax.nn.sigmoid(gl + b_gate[1]) * lru_up
    return merged @ w_o


def swiglu(h, w_gate, w_up, w_down):
    return (jax.nn.silu(h @ w_gate) * (h @ w_up)) @ w_down


def moe_swiglu(h, w_router, w_gate, w_up, w_down):
    logits = (h @ w_router).astype(jnp.float32)
    top_vals, top_idx = lax.top_k(logits, TOP_K)
    top_w = jax.nn.softmax(top_vals, axis=-1)
    comb = jnp.sum(jax.nn.one_hot(top_idx, N_EXPERTS, dtype=jnp.float32) * top_w[..., None], axis=-2)
    out = jnp.zeros_like(h)
    for e in range(N_EXPERTS):
        out = out + comb[..., e:e + 1].astype(h.dtype) * swiglu(h, w_gate[e], w_up[e], w_down[e])
    return out


def setup_inputs(seed: int = 0) -> dict:
    key = jax.random.key(seed)
    ks = jax.random.split(key, 32)
    f32 = jnp.float32
    nrm = lambda k, shape, s: jax.random.normal(k, shape, f32) * s
    u = jax.random.uniform(ks[13], (DEPTH, LRU_WIDTH), f32, 0.9, 0.999)
    sig = u ** (1.0 / LRU_C)
    lru_lambda = jnp.log(sig) - jnp.log1p(-sig)
    return {
        'x': nrm(ks[0], (BATCH, SEQ, D_MODEL), 1.0),
        'meta_tokens': nrm(ks[1], (N_META, D_MODEL), 1.0),
        'ln_in_g': 1.0 + nrm(ks[2], (D_MODEL,), 0.02),
        'ln_in_b': nrm(ks[3], (D_MODEL,), 0.02),
        'w_in': nrm(ks[4], (DEPTH, D_MODEL, PROJ_WIDTH), D_MODEL ** -0.5),
        'b_gate': nrm(ks[5], (DEPTH, 2, D_MODEL), 0.02),
        'da_lambda': nrm(ks[6], (DEPTH, 4, DA_HEAD_DIM), 0.1),
        'da_subln_g': 1.0 + nrm(ks[7], (DEPTH, 2 * DA_HEAD_DIM), 0.02),
        'conv_w': nrm(ks[8], (DEPTH, CONV_WIDTH, LRU_WIDTH), CONV_WIDTH ** -0.5),
        'conv_b': nrm(ks[9], (DEPTH, LRU_WIDTH), 0.02),
        'lru_wr': nrm(ks[10], (DEPTH, LRU_HEADS, LRU_BLOCK, LRU_BLOCK), LRU_BLOCK ** -0.5),
        'lru_br': nrm(ks[11], (DEPTH, LRU_WIDTH), 0.02),
        'lru_wi': nrm(ks[12], (DEPTH, LRU_HEADS, LRU_BLOCK, LRU_BLOCK), LRU_BLOCK ** -0.5),
        'lru_bi': nrm(ks[14], (DEPTH, LRU_WIDTH), 0.02),
        'lru_lambda': lru_lambda,
        'w_attn_out': nrm(ks[15], (DEPTH, DA_WIDTH, D_MODEL), DA_WIDTH ** -0.5 * BETA),
        'w_lru_out': nrm(ks[16], (DEPTH, LRU_WIDTH, D_MODEL), LRU_WIDTH ** -0.5 * BETA),
        'w_o': nrm(ks[17], (DEPTH, D_MODEL, D_MODEL), D_MODEL ** -0.5 * BETA),
        'ln_g': 1.0 + nrm(ks[18], (DEPTH, 2, D_MODEL), 0.02),
        'ln_b': nrm(ks[19], (DEPTH, 2, D_MODEL), 0.02),
        'ffn_wg': nrm(ks[20], (N_DENSE, D_MODEL, D_FF), D_MODEL ** -0.5),
        'ffn_wu': nrm(ks[21], (N_DENSE, D_MODEL, D_FF), D_MODEL ** -0.5),
        'ffn_wd': nrm(ks[22], (N_DENSE, D_FF, D_MODEL), D_FF ** -0.5 * BETA),
        'router_w': nrm(ks[23], (N_MOE, D_MODEL, N_EXPERTS), D_MODEL ** -0.5),
        'moe_wg': nrm(ks[24], (N_MOE, N_EXPERTS, D_MODEL, D_FF), D_MODEL ** -0.5),
        'moe_wu': nrm(ks[25], (N_MOE, N_EXPERTS, D_MODEL, D_FF), D_MODEL ** -0.5),
        'moe_wd': nrm(ks[26], (N_MOE, N_EXPERTS, D_FF, D_MODEL), D_FF ** -0.5 * BETA),
    }


def reference(x, meta_tokens, ln_in_g, ln_in_b, w_in, b_gate, da_lambda, da_subln_g,
              conv_w, conv_b, lru_wr, lru_br, lru_wi, lru_bi, lru_lambda,
              w_attn_out, w_lru_out, w_o, ln_g, ln_b, ffn_wg, ffn_wu, ffn_wd,
              router_w, moe_wg, moe_wu, moe_wd):
    B = x.shape[0]
    meta = jnp.broadcast_to(meta_tokens[None].astype(x.dtype), (B, N_META, D_MODEL))
    h = layer_norm(jnp.concatenate([meta, x], axis=1), ln_in_g, ln_in_b)
    for i in range(DEPTH):
        mix = token_mixer(h, i, w_in[i], b_gate[i], da_lambda[i], da_subln_g[i],
                          conv_w[i], conv_b[i], lru_wr[i], lru_br[i], lru_wi[i], lru_bi[i],
                          lru_lambda[i], w_attn_out[i], w_lru_out[i], w_o[i])
        h = layer_norm(ALPHA * h + mix, ln_g[i, 0], ln_b[i, 0])
        if i % 2 == 0:
            f = swiglu(h, ffn_wg[i // 2], ffn_wu[i // 2], ffn_wd[i // 2])
        else:
            f = moe_swiglu(h, router_w[i // 2], moe_wg[i // 2], moe_wu[i // 2], moe_wd[i // 2])
        h = layer_norm(ALPHA * h + f, ln_g[i, 1], ln_b[i, 1])
    return h[:, N_META:]
```

```cpp
#include <hip/hip_runtime.h>
#include <cstdio>
#include <cstdint>

#define DI __device__ __forceinline__
#define LAS __attribute__((address_space(3)))
typedef unsigned short bf16_t;
typedef short bf16x8 __attribute__((ext_vector_type(8)));
typedef float f32x4 __attribute__((ext_vector_type(4)));
typedef float f32x16 __attribute__((ext_vector_type(16)));
typedef unsigned u32x4 __attribute__((ext_vector_type(4)));
typedef unsigned u32x2 __attribute__((ext_vector_type(2)));

constexpr int D = 1024, NBATCH = 16, SEQ = 4096, DEPTH = 4;
constexpr int TP = 4160;
constexpr int PADR = 48, FRAME0 = 64;
constexpr int GB = 8, NGRP = NBATCH / GB;
constexpr int MG = GB * TP;
constexpr int NMT = MG / 256;
constexpr int LDZ = 5120;
constexpr int ZQ = 0, ZK = 512, ZXR = 1024, ZGR = 2048, ZGA = 3072, ZGL = 4096;
constexpr int DFF = 2816, NEXP = 8, PROJW = 5632;
constexpr int NCHUNK = TP / 64;
constexpr int NQB = TP / 32;
constexpr float ALPHA = 1.681792830507429f;
constexpr float LOG2E = 1.4426950408889634f;
constexpr float QSCALE = 0.17677669529663687f * LOG2E;
constexpr int SLOT_ROWS = 2 * MG + 8 * 256;

constexpr size_t MiB = 1u << 20;
constexpr size_t WS_CTL = 0, CTL_BYTES = 1 * MiB;
constexpr size_t WS_TAB = 1 * MiB;
constexpr size_t WS_WIN = 2 * MiB;
constexpr size_t WS_WMIX = 46 * MiB;
constexpr size_t WS_WO = 58 * MiB;
constexpr size_t WS_WR = 66 * MiB;
constexpr size_t WS_WI = 66 * MiB + 512 * 1024;
constexpr size_t WS_WGUD = 67 * MiB;
constexpr size_t WS_WDD = 89 * MiB;
constexpr size_t WS_WGUM = 100 * MiB;
constexpr size_t WS_WDM = 276 * MiB;
constexpr size_t WS_H = 364 * MiB;
constexpr size_t WS_AGG = 429 * MiB;
constexpr size_t WS_ROUTE = 434 * MiB;
constexpr size_t WS_YSLOT = 438 * MiB;
constexpr size_t WS_Z = 572 * MiB;
constexpr size_t WS_VT = 897 * MiB;
constexpr size_t WS_ACT = WS_Z;
constexpr size_t WS_END = 941 * MiB;
constexpr size_t OUT_Y = 128 * MiB;
static_assert(WS_WIN + (size_t)DEPTH * PROJW * D * 2 <= WS_WMIX, "map");
static_assert(WS_WMIX + (size_t)DEPTH * D * 1536 * 2 <= WS_WO, "map");
static_assert(WS_WGUD + (size_t)2 * PROJW * D * 2 <= WS_WDD && WS_WDD + (size_t)2 * D * DFF * 2 <= WS_WGUM, "map");
static_assert(WS_WGUM + (size_t)16 * PROJW * D * 2 <= WS_WDM && WS_WDM + (size_t)16 * D * DFF * 2 <= WS_H, "map");
static_assert(WS_H + (size_t)MG * D * 2 <= WS_AGG && WS_AGG + (size_t)2 * GB * NCHUNK * D * 4 <= WS_ROUTE, "map");
static_assert(WS_ROUTE + (size_t)MG * 32 + (size_t)2 * 8 * MG * 4 <= WS_YSLOT && WS_YSLOT + (size_t)SLOT_ROWS * D * 2 <= WS_Z, "map");
static_assert(WS_Z + (size_t)MG * LDZ * 2 <= WS_VT && WS_VT + (size_t)512 * MG * 2 <= WS_END && WS_ACT + (size_t)SLOT_ROWS * DFF * 2 <= WS_END, "map");

constexpr int CW_BAR = 4096;
constexpr int CW_Q = 8192;
constexpr int CW_CNT = 12288;

constexpr int LDS_STAGE = 131072;
constexpr int MISC_OFF = LDS_STAGE;
constexpr int LDS_BYTES = LDS_STAGE + 1024;

DI float bf_lo(unsigned w) { return __uint_as_float(w << 16); }
DI float bf_hi(unsigned w) { return __uint_as_float(w & 0xffff0000u); }
DI float bf2f(bf16_t b) { return __uint_as_float((unsigned)b << 16); }
DI unsigned cvt_pk_bf16(float lo, float hi) { unsigned r; asm volatile("v_cvt_pk_bf16_f32 %0, %1, %2" : "=v"(r) : "v"(lo), "v"(hi)); return r; }
DI bf16_t f2bf(float f) { return (bf16_t)(cvt_pk_bf16(f, 0.f) & 0xffffu); }
DI float ex2(float x) { return __builtin_amdgcn_exp2f(x); }
DI float rcpf_(float x) { return __builtin_amdgcn_rcpf(x); }
DI float sigm(float x) { return rcpf_(1.0f + ex2(-LOG2E * x)); }
DI float silu_(float x) { return x * sigm(x); }
DI float gelu_tanh(float x) { const float u = 0.7978845608028654f * (x + 0.044715f * x * x * x); return x * sigm(2.0f * u); }
DI int opaque(int x) { asm volatile("" : "+v"(x)); return x; }
DI float wave_sum(float v) {
#pragma unroll
    for (int o = 1; o < 64; o <<= 1) v += __shfl_xor(v, o);
    return v;
}
DI void unpack8(const u32x4 w, float (&f)[8]) { f[0] = bf_lo(w.x); f[1] = bf_hi(w.x); f[2] = bf_lo(w.y); f[3] = bf_hi(w.y); f[4] = bf_lo(w.z); f[5] = bf_hi(w.z); f[6] = bf_lo(w.w); f[7] = bf_hi(w.w); }
DI u32x4 pack8(const f32x4 a, const f32x4 b) { u32x4 w; w.x = cvt_pk_bf16(a[0], a[1]); w.y = cvt_pk_bf16(a[2], a[3]); w.z = cvt_pk_bf16(b[0], b[1]); w.w = cvt_pk_bf16(b[2], b[3]); return w; }

#define XB_TMO      128
#define XB_XCNT(j)  (256  + 64 * (j))
#define XB_XSUB(j)  (1280 + 64 * (j))
#define XB_XGEN(j)  (2304 + 64 * (j))
#define XB_TOP      3328
#define XB_TOPGEN   3392
#define XCD_BAR_WORDS 3456
#define XB_SPIN_CAP (1u << 18)
DI unsigned xb_ld(unsigned* p)              { return __hip_atomic_load(p, __ATOMIC_RELAXED, __HIP_MEMORY_SCOPE_AGENT); }
DI unsigned xb_add(unsigned* p, unsigned v) { return __hip_atomic_fetch_add(p, v, __ATOMIC_RELAXED, __HIP_MEMORY_SCOPE_AGENT); }
DI unsigned xb_xcc_id() { return (unsigned)__builtin_amdgcn_s_getreg((3 << 11) | 20) & 0xFu; }
#define XB_SPIN(cond, bar) do { unsigned _sp = 0; while (cond) { __builtin_amdgcn_s_sleep(1); \
    if ((++_sp & 255u) == 0u) { if (xb_ld(&(bar)[XB_TMO])) break; if (_sp > XB_SPIN_CAP) { atomicAdd(&(bar)[XB_TMO], 1u); break; } } } } while (0)
struct XcdBarrier { unsigned* bar; unsigned x; volatile LAS unsigned* st; };
DI XcdBarrier xcd_barrier_post(unsigned* bar, volatile LAS unsigned* st) {
    XcdBarrier b; b.bar = bar; b.x = xb_xcc_id(); b.st = st;
    if (threadIdx.x == 0) (void)xb_add(&bar[XB_XCNT(b.x)], 1u);
    return b;
}
DI void xcd_barrier_complete(unsigned* bar, unsigned x, unsigned& nloc, unsigned& nx) {
    const unsigned G = gridDim.x * gridDim.y * gridDim.z;
    unsigned sum, cnt, mine, sp = 0u;
    for (;;) {
        sum = 0u; cnt = 0u; mine = 0u;
#pragma unroll
        for (unsigned j = 0; j < 16; ++j) { const unsigned c = xb_ld(&bar[XB_XCNT(j)]); sum += c; cnt += (c > 0u) ? 1u : 0u; mine = (j == x) ? c : mine; }
        if (sum == G) break;
        __builtin_amdgcn_s_sleep(1);
        if ((++sp & 255u) == 0u) { if (xb_ld(&bar[XB_TMO])) break; if (sp > XB_SPIN_CAP) { atomicAdd(&bar[XB_TMO], 1u); break; } }
    }
    nloc = mine > 0u ? mine : 1u; nx = cnt > 0u ? cnt : 1u;
}
DI void xcd_barrier(const XcdBarrier& b) {
    asm volatile("s_waitcnt vmcnt(0)" ::: "memory");
    __syncthreads();
    if (threadIdx.x == 0) {
        unsigned* bar = b.bar;
        __builtin_amdgcn_s_waitcnt(0);
        unsigned nloc = b.st[0], nx = b.st[1];
        if (nloc == 0u) { xcd_barrier_complete(bar, b.x, nloc, nx); b.st[0] = nloc; b.st[1] = nx; }
        const unsigned old = xb_add(&bar[XB_XSUB(b.x)], 1u);
        const unsigned gen = old / nloc;
        if (old + 1u == (gen + 1u) * nloc) {
            __builtin_amdgcn_fence(__ATOMIC_RELEASE, "agent");
            asm volatile("s_waitcnt vmcnt(0)" ::: "memory");
            const unsigned og = xb_add(&bar[XB_TOP], 1u);
            const unsigned tg = og / nx;
            if (og + 1u == (tg + 1u) * nx) xb_add(&bar[XB_TOPGEN], 1u);
            else XB_SPIN(xb_ld(&bar[XB_TOPGEN]) == tg, bar);
            __builtin_amdgcn_fence(__ATOMIC_ACQUIRE, "agent");
            xb_add(&bar[XB_XGEN(b.x)], 1u);
            asm volatile("s_waitcnt vmcnt(0)" ::: "memory");
        } else {
            XB_SPIN(xb_ld(&bar[XB_XGEN(b.x)]) == gen, bar);
            __builtin_amdgcn_fence(__ATOMIC_ACQUIRE, "agent");
            asm volatile("s_waitcnt vmcnt(0)" ::: "memory");
        }
    }
    __syncthreads();
}

namespace g8 {
constexpr int BM = 256, BK = 64, HALF = 128, HTB = HALF * BK * 2, STAGE_BYTES = 8 * HTB, NXCD = 8, WGM = 8;
static_assert(STAGE_BYTES == LDS_STAGE, "stage");
__host__ __device__ __forceinline__ int lds_byte(int r, int c) { const int st = (r >> 4) * 2 + (c >> 5), rr = r & 15, cc = c & 31, ob = rr * 64 + cc * 2; return st * 1024 + (ob ^ (((ob >> 9) & 1) << 5)); }
__host__ __device__ __forceinline__ void stage_rc(int b, int& R, int& C) { const int st = b / 1024, sb = b % 1024, swz = sb ^ (((sb >> 9) & 1) << 5); R = (st >> 1) * 16 + swz / 64; C = (st & 1) * 32 + (swz % 64) / 2; }
__host__ __device__ __forceinline__ int perm32(int rho) { const int n = rho >> 4, i = rho & 15; return 8 * (i >> 2) + 4 * n + (i & 3); }
struct Unit { int pm, pn, aux, x0, x1; };
DI int static_map(int L, int nM, int nN) {
    const int nwg = nM * nN; int wgid = L;
    { const int q = nwg / NXCD, r = nwg % NXCD, xcd = wgid % NXCD, off = wgid / NXCD; wgid = (xcd < r ? xcd * (q + 1) : r * (q + 1) + (xcd - r) * q) + off; }
    const int nig = WGM * nN, gid = wgid / nig, fm = gid * WGM, gsz = (nM - fm) < WGM ? (nM - fm) : WGM;
    return (fm + ((wgid % nig) % gsz)) | (((wgid % nig) / gsz) << 16);
}
typedef f32x4 Acc[2][2][4][2];

template <class P>
DI void gemm_phase(LAS unsigned char* lds, const P& prob) {
    const int tid = opaque(threadIdx.x), wid = __builtin_amdgcn_readfirstlane(tid >> 6), lane = tid & 63, wr = wid >> 2, wc = wid & 3, fr = lane & 15, fq = lane >> 4;
    int R[2], C[2]; unsigned voffB[2], voffA[2];
#pragma unroll
    for (int i = 0; i < 2; ++i) { stage_rc(tid * 16 + i * 8192, R[i], C[i]); const int Rb = P::PERM ? ((R[i] & ~31) + perm32(R[i] & 31)) : R[i]; voffB[i] = (unsigned)(Rb * P::LDB + C[i]) * 2u;
        voffA[i] = (unsigned)R[i] * prob.ldaB() + (unsigned)C[i] * 2u; }
    constexpr unsigned hstepB = (unsigned)HALF * P::LDB * 2u;
    const unsigned hstepA = (unsigned)HALF * prob.ldaB();
    const unsigned ldsw = (unsigned)wid * 1024u;
    const int aoff = lds_byte(wr * 64 + fr, fq * 8), boff = lds_byte(wc * 32 + fr, fq * 8);
#define G8_SA(b, h) (((b) * 2 + (h)) * HTB)
#define G8_SB(b, h) ((4 + (b) * 2 + (h)) * HTB)
#define G8_STAGE_B(bufoff, gbase) do { _Pragma("unroll") for (int _i = 0; _i < 2; ++_i) \
        __builtin_amdgcn_global_load_lds((const unsigned*)((const char*)(gbase) + voffB[_i]), (LAS unsigned*)(lds + (bufoff) + ldsw + _i * 8192), 16, 0, 0); } while (0)
#define G8_STAGE_A(bufoff, h, ub, gv, koff) do { if constexpr (P::GATHER) { const char* _kb = Ab + (koff); _Pragma("unroll") for (int _i = 0; _i < 2; ++_i) \
            __builtin_amdgcn_global_load_lds((const unsigned*)(_kb + (gv)[h][_i]), (LAS unsigned*)(lds + (bufoff) + ldsw + _i * 8192), 16, 0, 0); } \
        else { const char* _kb = Ab + ((ub) + (h) * hstepA + (koff)); _Pragma("unroll") for (int _i = 0; _i < 2; ++_i) \
            __builtin_amdgcn_global_load_lds((const unsigned*)(_kb + voffA[_i]), (LAS unsigned*)(lds + (bufoff) + ldsw + _i * 8192), 16, 0, 0); } } while (0)
#define G8_LDA(dst, b, h) do { _Pragma("unroll") for (int m = 0; m < 4; ++m) _Pragma("unroll") for (int k = 0; k < 2; ++k) dst[m][k] = *(const LAS bf16x8*)(lds + G8_SA(b, h) + aoff + m * 2048 + k * 1024); } while (0)
#define G8_LDB(dst, b, h) do { _Pragma("unroll") for (int n = 0; n < 2; ++n) _Pragma("unroll") for (int k = 0; k < 2; ++k) dst[n][k] = *(const LAS bf16x8*)(lds + G8_SB(b, h) + boff + n * 2048 + k * 1024); } while (0)
#define G8_MMA(ai, bj, At, Bt) do { __builtin_amdgcn_s_setprio(1); _Pragma("unroll") for (int m = 0; m < 4; ++m) _Pragma("unroll") for (int n = 0; n < 2; ++n) _Pragma("unroll") for (int k = 0; k < 2; ++k) \
        acc[ai][bj][m][n] = __builtin_amdgcn_mfma_f32_16x16x32_bf16(Bt[n][k], At[m][k], acc[ai][bj][m][n], 0, 0, 0); __builtin_amdgcn_s_setprio(0); } while (0)
#define G8_WAIT_V(n) asm volatile("s_waitcnt vmcnt(" #n ")" ::: "memory")
#define G8_WAIT_L(n) asm volatile("s_waitcnt lgkmcnt(" #n ")" ::: "memory")
#define G8_BAR __builtin_amdgcn_s_barrier()
#define G8_SCHED __builtin_amdgcn_sched_barrier(0)
    Unit cur, nxt; int ui = 0;
    if (!prob.next(0, cur)) return;
    Acc acc;
#pragma unroll
    for (int a = 0; a < 2; ++a)
#pragma unroll
        for (int b = 0; b < 2; ++b)
#pragma unroll
            for (int m = 0; m < 4; ++m)
#pragma unroll
                for (int n = 0; n < 2; ++n) acc[a][b][m][n] = (f32x4){0.f, 0.f, 0.f, 0.f};
    bf16x8 At[4][2], B0[2][2], B1[2][2];
    unsigned gvA[2][2], gvN[2][2];
    unsigned cU = 0, nU = 0;
    if constexpr (P::GATHER) prob.a_gather(cur, R, C, gvA); else cU = prob.a_unit(cur);
    const char* const Ab = prob.Abase;
    const char* cB = prob.b_ptr(cur);
    G8_STAGE_B(G8_SB(0, 0), cB); G8_STAGE_B(G8_SB(0, 1), cB + hstepB); G8_STAGE_A(G8_SA(0, 0), 0, cU, gvA, prob.koffA(cur, 0)); G8_STAGE_A(G8_SA(0, 1), 1, cU, gvA, prob.koffA(cur, 0));
    if (wr == 1) G8_BAR;
    G8_WAIT_V(2); G8_BAR;
    G8_STAGE_B(G8_SB(1, 0), cB + 128); G8_STAGE_A(G8_SA(1, 0), 0, cU, gvA, prob.koffA(cur, 1)); G8_STAGE_B(G8_SB(1, 1), cB + hstepB + 128);
    G8_WAIT_V(6); G8_BAR;
    for (;;) {
        const bool has_next = prob.next(ui + 1, nxt);
        if (!has_next) nxt = cur;
        if constexpr (P::GATHER) { if (has_next) prob.a_gather(nxt, R, C, gvN); else {
#pragma unroll
            for (int h = 0; h < 2; ++h)
#pragma unroll
                for (int i = 0; i < 2; ++i) gvN[h][i] = gvA[h][i]; } }
        else nU = has_next ? prob.a_unit(nxt) : cU;
        const char* nB = has_next ? prob.b_ptr(nxt) : cB;
        const int nt = prob.nt(cur);
        for (int t = 0; t < nt; t += 2) {
            const bool last = (t == nt - 2);
            const unsigned k1 = prob.koffA(cur, t + 1), k2 = last ? prob.koffA(nxt, 0) : prob.koffA(cur, t + 2), k3 = last ? prob.koffA(nxt, 1) : prob.koffA(cur, t + 3);
            unsigned v2[2][2]; unsigned u2 = 0;
            if constexpr (P::GATHER) {
#pragma unroll
                for (int h = 0; h < 2; ++h)
#pragma unroll
                    for (int i = 0; i < 2; ++i) v2[h][i] = last ? gvN[h][i] : gvA[h][i];
            } else u2 = last ? nU : cU;
            const char* b2 = last ? nB : cB + (size_t)(t + 2) * 128; const char* b3 = b2 + 128;
            G8_LDB(B0, 0, 0); G8_LDB(B1, 0, 1); G8_SCHED; G8_LDA(At, 0, 0); G8_STAGE_A(G8_SA(1, 1), 1, cU, gvA, k1);
            G8_WAIT_V(8); G8_WAIT_L(0); G8_BAR; G8_MMA(0, 0, At, B0); G8_MMA(0, 1, At, B1); G8_BAR; G8_SCHED;
            G8_LDA(At, 0, 1); G8_STAGE_B(G8_SB(0, 0), b2); G8_STAGE_B(G8_SB(0, 1), b2 + hstepB); G8_STAGE_A(G8_SA(0, 0), 0, u2, v2, k2);
            G8_WAIT_V(8); G8_WAIT_L(0); G8_BAR; G8_MMA(1, 0, At, B0); G8_MMA(1, 1, At, B1); G8_BAR; G8_SCHED;
            G8_LDB(B0, 1, 0); G8_LDB(B1, 1, 1); G8_SCHED; G8_LDA(At, 1, 0); G8_STAGE_A(G8_SA(0, 1), 1, u2, v2, k2);
            G8_WAIT_V(8); G8_WAIT_L(0); G8_BAR; G8_MMA(0, 0, At, B0); G8_MMA(0, 1, At, B1); G8_BAR; G8_SCHED;
            G8_LDA(At, 1, 1); G8_STAGE_B(G8_SB(1, 0), b3); G8_STAGE_B(G8_SB(1, 1), b3 + hstepB); G8_STAGE_A(G8_SA(1, 0), 0, u2, v2, k3);
            G8_WAIT_V(8); G8_WAIT_L(0); G8_BAR; G8_MMA(1, 0, At, B0); G8_MMA(1, 1, At, B1); G8_BAR; G8_SCHED;
        }
        if (wr == 0) G8_BAR;
        prob.epi(acc, cur, wr, wc, fr, fq);
        if (!has_next) break;
        if (!prob.keep(cur)) {
#pragma unroll
            for (int a = 0; a < 2; ++a)
#pragma unroll
                for (int b = 0; b < 2; ++b)
#pragma unroll
                    for (int m = 0; m < 4; ++m)
#pragma unroll
                        for (int n = 0; n < 2; ++n) acc[a][b][m][n] = (f32x4){0.f, 0.f, 0.f, 0.f};
        }
        cur = nxt; cB = nB; cU = nU; ++ui;
        if constexpr (P::GATHER) {
#pragma unroll
            for (int h = 0; h < 2; ++h)
#pragma unroll
                for (int i = 0; i < 2; ++i) gvA[h][i] = gvN[h][i];
        }
        if (wr == 1) G8_BAR;
    }
    G8_WAIT_V(0);
    G8_BAR;
#undef G8_SA
#undef G8_SB
#undef G8_STAGE_A
#undef G8_STAGE_B
#undef G8_LDA
#undef G8_LDB
#undef G8_MMA
#undef G8_WAIT_V
#undef G8_WAIT_L
#undef G8_BAR
#undef G8_SCHED
}
}
using g8::Unit; using g8::Acc;

#define ROW_OF(pm, ai, m) ((pm) * 256 + (ai) * 128 + wr * 64 + (m) * 16 + fr)

struct ProbBase { const char* Abase; int G, c; };

struct ProbInProj : ProbBase {
    static constexpr bool PERM = true; static constexpr int NT = 16, LDB = 1024;
    unsigned offW; const float* bg0; const float* bg1; bf16_t* Z; bf16_t* VT;
    static constexpr int U1 = NMT * 20, U2 = 2 * NMT;
    DI bool next(int i, Unit& u) const {
        const int L = i * G + c; if (L >= U1 + U2) return false;
        const int L2 = L - U1; const bool second = L2 >= 0;
        const int pk = g8::static_map(second ? 0 : L, NMT, 20);
        Unit t; t.aux = second ? 1 : 0; t.pm = second ? L2 / NMT : (pk & 0xffff); t.pn = second ? L2 % NMT : (pk >> 16); t.x0 = 0; t.x1 = 0; u = t; return true;
    }
    static constexpr bool GATHER = false;
    DI unsigned ldaB() const { return 2048u; }
    DI unsigned a_unit(const Unit& u) const { return (u.aux ? offW + 5120u * 2048u : (unsigned)WS_H) + (unsigned)u.pm * (256u * 2048u); }
    DI unsigned koffA(const Unit&, int t) const { return (unsigned)t * 128u; }
    DI int nt(const Unit&) const { return NT; }
    DI bool keep(const Unit&) const { return false; }
    DI const char* b_ptr(const Unit& u) const { return Abase + (u.aux ? (size_t)WS_H : (size_t)offW) + (size_t)u.pn * 256 * 2048; }
    DI void epi(Acc& acc, const Unit& u, int wr, int wc, int fr, int fq) const {
        if (u.aux == 0) {
            const int colt = u.pn * 256;
            const int kind = colt < ZGR ? 0 : (colt < ZGA ? 1 : (colt < ZGL ? 2 : 3));
            f32x4 bv[2][2];
#pragma unroll
            for (int bj = 0; bj < 2; ++bj)
#pragma unroll
                for (int n = 0; n < 2; ++n) bv[bj][n] = (f32x4){0.f, 0.f, 0.f, 0.f};
            if (kind >= 2) { const float* bp = (kind == 2 ? bg0 + (colt - ZGA) : bg1 + (colt - ZGL)) + wc * 32 + 8 * fq;
#pragma unroll
                for (int bj = 0; bj < 2; ++bj)
#pragma unroll
                    for (int n = 0; n < 2; ++n) bv[bj][n] = *(const f32x4*)(bp + bj * 128 + 4 * n); }
#pragma unroll
            for (int ai = 0; ai < 2; ++ai)
#pragma unroll
                for (int m = 0; m < 4; ++m) { bf16_t* rowp = Z + (size_t)ROW_OF(u.pm, ai, m) * LDZ + colt + wc * 32 + 8 * fq;
#pragma unroll
                    for (int bj = 0; bj < 2; ++bj) { f32x4 v0 = acc[ai][bj][m][0] + bv[bj][0], v1 = acc[ai][bj][m][1] + bv[bj][1];
                        if (kind == 1) {
#pragma unroll
                            for (int j = 0; j < 4; ++j) { v0[j] = gelu_tanh(v0[j]); v1[j] = gelu_tanh(v1[j]); } }
                        else if (kind >= 2) {
#pragma unroll
                            for (int j = 0; j < 4; ++j) { v0[j] = sigm(v0[j]); v1[j] = sigm(v1[j]); } }
                        *(u32x4*)(rowp + bj * 128) = pack8(v0, v1); } }
        } else {
#pragma unroll
            for (int ai = 0; ai < 2; ++ai)
#pragma unroll
                for (int m = 0; m < 4; ++m) { bf16_t* rowp = VT + (size_t)ROW_OF(u.pm, ai, m) * MG + u.pn * 256 + wc * 32 + 8 * fq;
#pragma unroll
                    for (int bj = 0; bj < 2; ++bj) *(u32x4*)(rowp + bj * 128) = pack8(acc[ai][bj][m][0], acc[ai][bj][m][1]); }
        }
    }
};

struct ProbMix : ProbBase {
    static constexpr bool PERM = true; static constexpr int LDB = 1536;
    unsigned offW; bf16_t* Z;
    DI bool next(int i, Unit& u) const { const int L = (i >> 1) * G + c; if (L >= NMT * 4) return false; const int pk = g8::static_map(L, NMT, 4); Unit t; t.pm = pk & 0xffff; t.pn = pk >> 16; t.aux = i & 1; t.x0 = 0; t.x1 = 0; u = t; return true; }
    static constexpr bool GATHER = false;
    DI unsigned ldaB() const { return LDZ * 2u; }
    DI unsigned a_unit(const Unit& u) const { return (unsigned)WS_Z + (unsigned)u.pm * (256u * LDZ * 2u); }
    DI unsigned koffA(const Unit& u, int t) const { return (unsigned)((u.aux ? ZGR : ZQ) * 2 + t * 128); }
    DI int nt(const Unit& u) const { return u.aux ? 16 : 8; }
    DI bool keep(const Unit& u) const { return u.aux == 0; }
    DI const char* b_ptr(const Unit& u) const { return Abase + (size_t)offW + (size_t)u.pn * 256 * (1536 * 2) + (u.aux ? 1024 : 0); }
    DI void epi(Acc& acc, const Unit& u, int wr, int wc, int fr, int fq) const {
        if (u.aux == 0) {
#pragma unroll
            for (int ai = 0; ai < 2; ++ai)
#pragma unroll
                for (int m = 0; m < 4; ++m) { const bf16_t* rowp = Z + (size_t)ROW_OF(u.pm, ai, m) * LDZ + u.pn * 256 + wc * 32 + 8 * fq;
#pragma unroll
                    for (int bj = 0; bj < 2; ++bj) { const u32x4 sa = *(const u32x4*)(rowp + ZGA + bj * 128), sl = *(const u32x4*)(rowp + ZGL + bj * 128);
                        float a8[8], l8[8]; unpack8(sa, a8); unpack8(sl, l8);
#pragma unroll
                        for (int j = 0; j < 4; ++j) { acc[ai][bj][m][0][j] *= a8[j] * rcpf_(l8[j]); acc[ai][bj][m][1][j] *= a8[4 + j] * rcpf_(l8[4 + j]); } }
                    asm volatile("" ::: "memory"); }
        } else {
#pragma unroll
            for (int ai = 0; ai < 2; ++ai)
#pragma unroll
                for (int m = 0; m < 4; ++m) { bf16_t* rowp = Z + (size_t)ROW_OF(u.pm, ai, m) * LDZ + u.pn * 256 + wc * 32 + 8 * fq;
#pragma unroll
                    for (int bj = 0; bj < 2; ++bj) { const u32x4 sl = *(const u32x4*)(rowp + ZGL + bj * 128); float l8[8]; unpack8(sl, l8);
                        f32x4 v0 = acc[ai][bj][m][0], v1 = acc[ai][bj][m][1];
#pragma unroll
                        for (int j = 0; j < 4; ++j) { v0[j] *= l8[j]; v1[j] *= l8[4 + j]; }
                        *(u32x4*)(rowp + ZGA + bj * 128) = pack8(v0, v1); }
                    asm volatile("" ::: "memory"); }
        }
    }
};

template <int NT_, int LDB_>
struct ProbResid : ProbBase {
    static constexpr bool PERM = true; static constexpr int NT = NT_, LDB = LDB_;
    unsigned offA, lda2; unsigned offW; const bf16_t* H; bf16_t* Y;
    DI bool next(int i, Unit& u) const { const int L = i * G + c; if (L >= NMT * 4) return false; const int pk = g8::static_map(L, NMT, 4); Unit t; t.pm = pk & 0xffff; t.pn = pk >> 16; t.aux = 0; t.x0 = 0; t.x1 = 0; u = t; return true; }
    static constexpr bool GATHER = false;
    DI unsigned ldaB() const { return lda2; }
    DI unsigned a_unit(const Unit& u) const { return offA + (unsigned)u.pm * 256u * lda2; }
    DI unsigned koffA(const Unit&, int t) const { return (unsigned)t * 128u; }
    DI int nt(const Unit&) const { return NT; }
    DI bool keep(const Unit&) const { return false; }
    DI const char* b_ptr(const Unit& u) const { return Abase + (size_t)offW + (size_t)u.pn * 256 * (LDB_ * 2); }
    DI void epi(Acc& acc, const Unit& u, int wr, int wc, int fr, int fq) const {
#pragma unroll
        for (int ai = 0; ai < 2; ++ai)
#pragma unroll
            for (int m = 0; m < 4; ++m) { const size_t ro = (size_t)ROW_OF(u.pm, ai, m) * D + u.pn * 256 + wc * 32 + 8 * fq;
#pragma unroll
                for (int bj = 0; bj < 2; ++bj) { const u32x4 hv = *(const u32x4*)(H + ro + bj * 128); float h8[8]; unpack8(hv, h8);
                    f32x4 v0 = acc[ai][bj][m][0], v1 = acc[ai][bj][m][1];
#pragma unroll
                    for (int j = 0; j < 4; ++j) { v0[j] += ALPHA * h8[j]; v1[j] += ALPHA * h8[4 + j]; }
                    *(u32x4*)(Y + ro + bj * 128) = pack8(v0, v1); }
                asm volatile("" ::: "memory"); }
    }
};

struct ProbUpD : ProbBase {
    static constexpr bool PERM = false; static constexpr int NT = 16, LDB = 1024;
    unsigned offW; bf16_t* ACT;
    DI bool next(int i, Unit& u) const { const int L = i * G + c; if (L >= NMT * 22) return false; const int pk = g8::static_map(L, NMT, 22); Unit t; t.pm = pk & 0xffff; t.pn = pk >> 16; t.aux = 0; t.x0 = 0; t.x1 = 0; u = t; return true; }
    static constexpr bool GATHER = false;
    DI unsigned ldaB() const { return 2048u; }
    DI unsigned a_unit(const Unit& u) const { return (unsigned)WS_H + (unsigned)u.pm * (256u * 2048u); }
    DI unsigned koffA(const Unit&, int t) const { return (unsigned)t * 128u; }
    DI int nt(const Unit&) const { return NT; }
    DI bool keep(const Unit&) const { return false; }
    DI const char* b_ptr(const Unit& u) const { return Abase + (size_t)offW + (size_t)u.pn * 256 * 2048; }
    DI void epi(Acc& acc, const Unit& u, int wr, int wc, int fr, int fq) const {
#pragma unroll
        for (int ai = 0; ai < 2; ++ai)
#pragma unroll
            for (int m = 0; m < 4; ++m) { bf16_t* rowp = ACT + (size_t)ROW_OF(u.pm, ai, m) * DFF + u.pn * 128 + wc * 16 + 4 * fq;
#pragma unroll
                for (int bj = 0; bj < 2; ++bj) { const f32x4 g = acc[ai][bj][m][0], up = acc[ai][bj][m][1];
                    u32x2 w; w.x = cvt_pk_bf16(silu_(g[0]) * up[0], silu_(g[1]) * up[1]); w.y = cvt_pk_bf16(silu_(g[2]) * up[2], silu_(g[3]) * up[3]);
                    *(u32x2*)(rowp + bj * 64) = w; } }
    }
};

struct MoeTab {
    int cnt[8], tiles[8], ub[9], rb[8];
    DI void init(const unsigned* cw, int nN) {
        int u = 0, r = 0;
#pragma unroll
        for (int e = 0; e < 8; ++e) { int c = (int)__builtin_amdgcn_readfirstlane(cw[e]); c = c > MG ? MG : c; cnt[e] = c; tiles[e] = (c + 255) >> 8; ub[e] = u; rb[e] = r; u += tiles[e] * nN; r += tiles[e]; }
        ub[8] = u;
    }
    DI bool find(int L, Unit& u) const {
        if (L >= ub[8]) return false;
        int e = 0;
#pragma unroll
        for (int k = 1; k < 8; ++k) e += (L >= ub[k]) ? 1 : 0;
        int te = 1, ue = 0, re = 0, ce = 0;
#pragma unroll
        for (int k = 0; k < 8; ++k) if (e == k) { te = tiles[k]; ue = ub[k]; re = rb[k]; ce = cnt[k]; }
        const int r = L - ue; Unit t; t.pm = r % te; t.pn = r / te; t.aux = e; t.x0 = re; t.x1 = ce; u = t; return true;
    }
};

struct ProbUpM : ProbBase {
    static constexpr bool PERM = false; static constexpr int NT = 16, LDB = 1024;
    unsigned offW; bf16_t* ACT; const int* list; MoeTab tab;
    DI bool next(int i, Unit& u) const { return tab.find(i * G + c, u); }
    static constexpr bool GATHER = true;
    DI unsigned ldaB() const { return 2048u; }
    DI unsigned a_unit(const Unit&) const { return 0u; }
    DI void a_gather(const Unit& u, const int (&R)[2], const int (&C)[2], unsigned (&vo)[2][2]) const {
        const int* le = list + (size_t)u.aux * MG;
#pragma unroll
        for (int h = 0; h < 2; ++h)
#pragma unroll
            for (int i = 0; i < 2; ++i) { const int pos = u.pm * 256 + h * 128 + R[i]; const int tok = le[pos < u.x1 ? pos : 0];
                vo[h][i] = (unsigned)WS_H + (unsigned)tok * 2048u + (unsigned)C[i] * 2u; }
    }
    DI unsigned koffA(const Unit&, int t) const { return (unsigned)t * 128u; }
    DI int nt(const Unit&) const { return NT; }
    DI bool keep(const Unit&) const { return false; }
    DI const char* b_ptr(const Unit& u) const { return Abase + (size_t)offW + (size_t)u.aux * ((size_t)PROJW * D * 2) + (size_t)u.pn * 256 * 2048; }
    DI void epi(Acc& acc, const Unit& u, int wr, int wc, int fr, int fq) const {
#pragma unroll
        for (int ai = 0; ai < 2; ++ai)
#pragma unroll
            for (int m = 0; m < 4; ++m) { bf16_t* rowp = ACT + (size_t)ROW_OF(u.x0 + u.pm, ai, m) * DFF + u.pn * 128 + wc * 16 + 4 * fq;
#pragma unroll
                for (int bj = 0; bj < 2; ++bj) { const f32x4 g = acc[ai][bj][m][0], up = acc[ai][bj][m][1];
                    u32x2 w; w.x = cvt_pk_bf16(silu_(g[0]) * up[0], silu_(g[1]) * up[1]); w.y = cvt_pk_bf16(silu_(g[2]) * up[2], silu_(g[3]) * up[3]);
                    *(u32x2*)(rowp + bj * 64) = w; } }
    }
};
struct ProbDownM : ProbBase {
    static constexpr bool PERM = true; static constexpr int NT = 44, LDB = 2816;
    unsigned offW; bf16_t* YS; const float* wlist; MoeTab tab;
    DI bool next(int i, Unit& u) const { return tab.find(i * G + c, u); }
    static constexpr bool GATHER = false;
    DI unsigned ldaB() const { return DFF * 2u; }
    DI unsigned a_unit(const Unit& u) const { return (unsigned)WS_ACT + (unsigned)(u.x0 + u.pm) * (256u * DFF * 2u); }
    DI unsigned koffA(const Unit&, int t) const { return (unsigned)t * 128u; }
    DI int nt(const Unit&) const { return NT; }
    DI bool keep(const Unit&) const { return false; }
    DI const char* b_ptr(const Unit& u) const { return Abase + (size_t)offW + (size_t)u.aux * ((size_t)D * DFF * 2) + (size_t)u.pn * 256 * (DFF * 2); }
    DI void epi(Acc& acc, const Unit& u, int wr, int wc, int fr, int fq) const {
        const float* we = wlist + (size_t)u.aux * MG;
#pragma unroll
        for (int ai = 0; ai < 2; ++ai)
#pragma unroll
            for (int m = 0; m < 4; ++m) { const int pos = ROW_OF(u.pm, ai, m); const float w = pos < u.x1 ? we[pos] : 0.f;
                bf16_t* rowp = YS + (size_t)(u.x0 * 256 + pos) * D + u.pn * 256 + wc * 32 + 8 * fq;
#pragma unroll
                for (int bj = 0; bj < 2; ++bj) *(u32x4*)(rowp + bj * 128) = pack8(acc[ai][bj][m][0] * w, acc[ai][bj][m][1] * w); }
    }
};

struct Args { const float* in[27]; float* out; unsigned char* ws; };
struct Ctx {
    LAS unsigned char* lds; volatile LAS unsigned* MISC;
    unsigned char* ws; unsigned* ctl; float* out;
    int wave, G, gw, NGW;
};
DI int crow(int r, int hi) { return (r & 3) + 8 * (r >> 2) + 4 * hi; }

DI void transpose_item(const float* W, int N, bf16_t* WT, int ldt, int kofs, int row_off, int mode, LAS float* scr, int item, int lane) {
    const int nblk = N / 32, kb = item / nblk, nb = item % nblk, k0 = 64 * kb, n0 = 32 * nb;
#pragma unroll 8
    for (int i = 0; i < 32; ++i) { const int kk = 2 * i + (lane >> 5); scr[kk * 33 + (lane & 31)] = W[(size_t)(k0 + kk) * N + n0 + (lane & 31)]; }
    asm volatile("s_waitcnt lgkmcnt(0)" ::: "memory");
    const int c = lane & 7;
    const float sc = (mode == 1 && n0 < 512) ? QSCALE : 1.0f;
#pragma unroll
    for (int j = 0; j < 4; ++j) { const int n = (lane >> 3) + 8 * j; const LAS float* s = scr + (8 * c) * 33 + n;
        const int ns = n0 + n; int drow;
        if (mode == 0) drow = row_off + ns;
        else if (mode == 1) drow = ns < 1024 ? ns : (ns < 1536 ? 5120 + (ns - 1024) : ns - 512);
        else drow = 32 * (ns >> 4) + 16 * row_off + (ns & 15);
        u32x4 o; o.x = cvt_pk_bf16(s[0 * 33] * sc, s[1 * 33] * sc); o.y = cvt_pk_bf16(s[2 * 33] * sc, s[3 * 33] * sc); o.z = cvt_pk_bf16(s[4 * 33] * sc, s[5 * 33] * sc); o.w = cvt_pk_bf16(s[6 * 33] * sc, s[7 * 33] * sc);
        *(u32x4*)(WT + (size_t)drow * ldt + kofs + k0 + 8 * c) = o; }
    asm volatile("s_waitcnt lgkmcnt(0)" ::: "memory");
}
DI void prologue(Ctx& F, const Args& a) {
    const int tid = opaque(threadIdx.x), lane = tid & 63;
    LAS float* scr = (LAS float*)(F.lds + F.wave * 16384);
    unsigned char* ws = F.ws;
    constexpr int L_IN = 16 * 176, L_AO = 8 * 32, L_LO = 16 * 32, L_O = 16 * 32, L_G = 32;
    constexpr int L_ALL = L_IN + L_AO + L_LO + L_O + 2 * L_G;
    constexpr int F_G = 16 * 88, F_D = 44 * 32, F_ALL = 2 * F_G + F_D;
    constexpr int NITEMS = DEPTH * L_ALL + 18 * F_ALL;
    for (int it = F.gw; it < NITEMS; it += F.NGW) {
        if (it < DEPTH * L_ALL) {
            const int l = it / L_ALL; int r = it % L_ALL;
            if (r < L_IN) { transpose_item(a.in[4] + (size_t)l * D * PROJW, PROJW, (bf16_t*)(ws + WS_WIN) + (size_t)l * PROJW * D, D, 0, 0, 1, scr, r, lane); continue; } r -= L_IN;
            if (r < L_AO) { transpose_item(a.in[15] + (size_t)l * 512 * D, D, (bf16_t*)(ws + WS_WMIX) + (size_t)l * D * 1536, 1536, 0, 0, 0, scr, r, lane); continue; } r -= L_AO;
            if (r < L_LO) { transpose_item(a.in[16] + (size_t)l * D * D, D, (bf16_t*)(ws + WS_WMIX) + (size_t)l * D * 1536, 1536, 512, 0, 0, scr, r, lane); continue; } r -= L_LO;
            if (r < L_O) { transpose_item(a.in[17] + (size_t)l * D * D, D, (bf16_t*)(ws + WS_WO) + (size_t)l * D * D, D, 0, 0, 0, scr, r, lane); continue; } r -= L_O;
            const int which = r / L_G, hh = (r % L_G) >> 1, sub = r & 1;
            transpose_item(a.in[which ? 12 : 10] + ((size_t)l * 16 + hh) * 4096, 64, (bf16_t*)(ws + (which ? WS_WI : WS_WR)) + ((size_t)l * 16 + hh) * 4096, 64, 0, 0, 0, scr, sub, lane);
        } else {
            const int r0 = it - DEPTH * L_ALL, set = r0 / F_ALL; int r = r0 % F_ALL;
            const float *wg, *wu, *wd; bf16_t *dgu, *dd;
            if (set < 2) { wg = a.in[20] + (size_t)set * D * DFF; wu = a.in[21] + (size_t)set * D * DFF; wd = a.in[22] + (size_t)set * DFF * D;
                dgu = (bf16_t*)(ws + WS_WGUD) + (size_t)set * PROJW * D; dd = (bf16_t*)(ws + WS_WDD) + (size_t)set * D * DFF; }
            else { const int s2 = set - 2; wg = a.in[24] + (size_t)s2 * D * DFF; wu = a.in[25] + (size_t)s2 * D * DFF; wd = a.in[26] + (size_t)s2 * DFF * D;
                dgu = (bf16_t*)(ws + WS_WGUM) + (size_t)s2 * PROJW * D; dd = (bf16_t*)(ws + WS_WDM) + (size_t)s2 * D * DFF; }
            if (r < F_G) { transpose_item(wg, DFF, dgu, D, 0, 0, 2, scr, r, lane); continue; } r -= F_G;
            if (r < F_G) { transpose_item(wu, DFF, dgu, D, 0, 1, 2, scr, r, lane); continue; } r -= F_G;
            transpose_item(wd, D, dd, DFF, 0, 0, 0, scr, r, lane);
        }
    }
    float* tab = (float*)(ws + WS_TAB);
    for (int i = blockIdx.x * 512 + tid; i < DEPTH * D; i += F.G * 512) { const float x = a.in[14][i]; tab[i] = log1pf(expf(-x)); }
    if (blockIdx.x == 0 && tid < DEPTH) { const int l = tid; const float* dl = a.in[6] + l * 128; float s1 = 0.f, s2 = 0.f;
        for (int j = 0; j < 32; ++j) { s1 += dl[j] * dl[32 + j]; s2 += dl[64 + j] * dl[96 + j]; }
        const float lam_init = 0.8f - 0.6f * expf(-0.3f * (float)l);
        tab[DEPTH * D + 2 * l] = expf(s1) - expf(s2) + lam_init; tab[DEPTH * D + 2 * l + 1] = 1.0f - lam_init; }
}

DI void ln_in_phase(Ctx& F, const Args& a, int g) {
    const int tid = opaque(threadIdx.x), lane = tid & 63; (void)tid;
    bf16_t* H = (bf16_t*)(F.ws + WS_H);
    const float* gam = a.in[2]; const float* bet = a.in[3];
    for (int row = F.gw; row < MG; row += F.NGW) {
        const int bl = row / TP, r = row % TP;
        u32x4* o = (u32x4*)(H + (size_t)row * D) + lane;
        const bool padrow = r < PADR;
        const float* src = r < FRAME0 ? a.in[1] + (size_t)(padrow ? 0 : r - PADR) * D : a.in[0] + ((size_t)(g * GB + bl) * SEQ + (r - FRAME0)) * D;
        f32x4 v[4]; float s = 0.f;
#pragma unroll
        for (int j = 0; j < 4; ++j) { v[j] = *(const f32x4*)(src + (j >> 1) * 512 + lane * 8 + (j & 1) * 4); s += (v[j][0] + v[j][1]) + (v[j][2] + v[j][3]); }
        const float mean = wave_sum(s) * (1.f / D); float s2 = 0.f;
#pragma unroll
        for (int j = 0; j < 4; ++j) { v[j] = v[j] - mean; s2 += (v[j][0] * v[j][0] + v[j][1] * v[j][1]) + (v[j][2] * v[j][2] + v[j][3] * v[j][3]); }
        const float rstd = 1.f / sqrtf(wave_sum(s2) * (1.f / D) + 1e-5f);
#pragma unroll
        for (int j = 0; j < 4; ++j) { const int c0 = (j >> 1) * 512 + lane * 8 + (j & 1) * 4; const f32x4 gg = *(const f32x4*)(gam + c0), bb = *(const f32x4*)(bet + c0); v[j] = v[j] * rstd * gg + bb; }
        u32x4 w0 = pack8(v[0], v[1]), w1 = pack8(v[2], v[3]);
        if (padrow) { w0 = (u32x4){0u, 0u, 0u, 0u}; w1 = w0; }
        o[0] = w0; o[64] = w1;
    }
}

template <int MODE, bool FINAL>
DI void ln_phase(Ctx& F, const Args& a, int g, const float* gam, const float* bet, const float* router, unsigned* cntw) {
    const int tid = opaque(threadIdx.x), lane = tid & 63; (void)tid;
    bf16_t* H = (bf16_t*)(F.ws + WS_H);
    const bf16_t* Y = (const bf16_t*)((const unsigned char*)F.out + OUT_Y);
    const bf16_t* YS = (const bf16_t*)(F.ws + WS_YSLOT);
    unsigned* tokinfo = (unsigned*)(F.ws + WS_ROUTE);
    int* list = (int*)(F.ws + WS_ROUTE + (size_t)MG * 32);
    float* wlist = (float*)(F.ws + WS_ROUTE + (size_t)MG * 32 + (size_t)8 * MG * 4);
    LAS float* wrt = (LAS float*)F.lds;
    int rbase[8];
    if (MODE == 1) {
        for (int i = tid; i < 8 * D; i += 512) { const int c = i >> 3, e = i & 7; wrt[e * D + c] = router[i]; }
        __syncthreads();
    }
    if (MODE == 3) { int r = 0;
#pragma unroll
        for (int e = 0; e < 8; ++e) { int c = (int)__builtin_amdgcn_readfirstlane(cntw[e]); c = c > MG ? MG : c; rbase[e] = r; r += ((c + 255) >> 8) * 256; } }
    for (int row = F.gw; row < MG; row += F.NGW) {
        float v[16];
        if (MODE == 3) {
            const u32x4 ti = *(const u32x4*)(tokinfo + (size_t)row * 8);
            int s1 = 0, s2 = 0;
#pragma unroll
            for (int e = 0; e < 8; ++e) { if ((int)ti.x == e) s1 = rbase[e] + (int)ti.y; if ((int)ti.z == e) s2 = rbase[e] + (int)ti.w; }
#pragma unroll
            for (int hh = 0; hh < 2; ++hh) { const int c0 = hh * 512 + lane * 8;
                const u32x4 hv = *(const u32x4*)(H + (size_t)row * D + c0), y1 = *(const u32x4*)(YS + (size_t)s1 * D + c0), y2 = *(const u32x4*)(YS + (size_t)s2 * D + c0);
                float h8[8], a8[8], b8[8]; unpack8(hv, h8); unpack8(y1, a8); unpack8(y2, b8);
#pragma unroll
                for (int j = 0; j < 8; ++j) v[hh * 8 + j] = ALPHA * h8[j] + (a8[j] + b8[j]); }
        } else {
#pragma unroll
            for (int hh = 0; hh < 2; ++hh) { const u32x4 yv = *(const u32x4*)(Y + (size_t)row * D + hh * 512 + lane * 8); float y8[8]; unpack8(yv, y8);
#pragma unroll
                for (int j = 0; j < 8; ++j) v[hh * 8 + j] = y8[j]; }
        }
        float s = 0.f;
#pragma unroll
        for (int j = 0; j < 16; ++j) s += v[j];
        const float mean = wave_sum(s) * (1.f / D); float s2 = 0.f;
#pragma unroll
        for (int j = 0; j < 16; ++j) { v[j] -= mean; s2 += v[j] * v[j]; }
        const float rstd = 1.f / sqrtf(wave_sum(s2) * (1.f / D) + 1e-5f);
#pragma unroll
        for (int hh = 0; hh < 2; ++hh) { const int c0 = hh * 512 + lane * 8;
#pragma unroll
            for (int q = 0; q < 2; ++q) { const f32x4 gg = *(const f32x4*)(gam + c0 + 4 * q), bb = *(const f32x4*)(bet + c0 + 4 * q);
#pragma unroll
                for (int j = 0; j < 4; ++j) v[hh * 8 + q * 4 + j] = v[hh * 8 + q * 4 + j] * rstd * gg[j] + bb[j]; } }
#pragma unroll
        for (int hh = 0; hh < 2; ++hh) { u32x4 w; w.x = cvt_pk_bf16(v[hh * 8 + 0], v[hh * 8 + 1]); w.y = cvt_pk_bf16(v[hh * 8 + 2], v[hh * 8 + 3]); w.z = cvt_pk_bf16(v[hh * 8 + 4], v[hh * 8 + 5]); w.w = cvt_pk_bf16(v[hh * 8 + 6], v[hh * 8 + 7]);
            *(u32x4*)(H + (size_t)row * D + hh * 512 + lane * 8) = w; }
        if (FINAL) {
            const int bl = row / TP, r = row % TP;
            if (r >= FRAME0) { float* op = F.out + ((size_t)(g * GB + bl) * SEQ + (r - FRAME0)) * D;
#pragma unroll
                for (int hh = 0; hh < 2; ++hh)
#pragma unroll
                    for (int q = 0; q < 2; ++q) *(f32x4*)(op + hh * 512 + lane * 8 + 4 * q) = (f32x4){v[hh * 8 + q * 4], v[hh * 8 + q * 4 + 1], v[hh * 8 + q * 4 + 2], v[hh * 8 + q * 4 + 3]}; }
        }
        if (MODE == 1) {
            float lg[8];
#pragma unroll
            for (int e = 0; e < 8; ++e) { float acc = 0.f;
#pragma unroll
                for (int hh = 0; hh < 2; ++hh) { const LAS f32x4* wp = (const LAS f32x4*)(wrt + e * D + hh * 512 + lane * 8); const f32x4 w0 = wp[0], w1 = wp[1];
#pragma unroll
                    for (int j = 0; j < 4; ++j) acc += v[hh * 8 + j] * w0[j] + v[hh * 8 + 4 + j] * w1[j]; }
                lg[e] = wave_sum(acc); }
            int e1 = 0; float l1 = lg[0];
#pragma unroll
            for (int e = 1; e < 8; ++e) if (lg[e] > l1) { l1 = lg[e]; e1 = e; }
            int e2 = -1; float l2 = -INFINITY;
#pragma unroll
            for (int e = 0; e < 8; ++e) if (e != e1 && lg[e] > l2) { l2 = lg[e]; e2 = e; }
            const float w2 = rcpf_(1.0f + ex2(LOG2E * (l1 - l2))), w1 = 1.0f - w2;
            if (lane == 0) {
                const unsigned p1 = atomicAdd(cntw + e1, 1u), p2 = atomicAdd(cntw + e2, 1u);
                *(u32x4*)(tokinfo + (size_t)row * 8) = (u32x4){(unsigned)e1, p1, (unsigned)e2, p2};
                if (p1 < (unsigned)MG) { list[(size_t)e1 * MG + p1] = row; wlist[(size_t)e1 * MG + p1] = w1; }
                if (p2 < (unsigned)MG) { list[(size_t)e2 * MG + p2] = row; wlist[(size_t)e2 * MG + p2] = w2; }
            }
        }
    }
}

template <bool PASS2>
DI void lru_phase(Ctx& F, const Args& a, int l) {
    const int lane = opaque(threadIdx.x) & 63, r32 = lane & 31, hi = lane >> 5;
    bf16_t* Z = (bf16_t*)(F.ws + WS_Z);
    const bf16_t* WrT = (const bf16_t*)(F.ws + WS_WR) + (size_t)l * 16 * 4096;
    const bf16_t* WiT = (const bf16_t*)(F.ws + WS_WI) + (size_t)l * 16 * 4096;
    float* aggA = (float*)(F.ws + WS_AGG); float* aggH = aggA + (size_t)GB * NCHUNK * D;
    const float* spt = (const float*)(F.ws + WS_TAB) + l * D;
    const float* cw = a.in[8] + (size_t)l * 4 * D; const float* cbv = a.in[9] + (size_t)l * D;
    const float* brv = a.in[11] + (size_t)l * D; const float* biv = a.in[13] + (size_t)l * D;
    LAS bf16_t* xcb = (LAS bf16_t*)(F.lds + F.wave * 4608);
    for (int unit = F.gw; unit < GB * NCHUNK * 16; unit += F.NGW) {
        const int head = unit & 15, bc = unit >> 4, chunk = bc % NCHUNK, bl = bc / NCHUNK;
        bf16x8 wrf[2][4], wif[2][4];
#pragma unroll
        for (int ct = 0; ct < 2; ++ct)
#pragma unroll
            for (int ks = 0; ks < 4; ++ks) { const size_t o = (size_t)(head * 64 + ct * 32 + r32) * 64 + ks * 16 + hi * 8; wrf[ct][ks] = *(const bf16x8*)(WrT + o); wif[ct][ks] = *(const bf16x8*)(WiT + o); }
        float c0[2], c1[2], c2[2], c3[2], cb[2], br[2], bi[2], sp8[2], hst[2], apr[2];
#pragma unroll
        for (int ct = 0; ct < 2; ++ct) { const int ch = head * 64 + ct * 32 + r32;
            c0[ct] = cw[ch]; c1[ct] = cw[D + ch]; c2[ct] = cw[2 * D + ch]; c3[ct] = cw[3 * D + ch]; cb[ct] = cbv[ch]; br[ct] = brv[ch]; bi[ct] = biv[ch]; sp8[ct] = -8.0f * LOG2E * spt[ch];
            hst[ct] = 0.f; apr[ct] = 1.f;
            if (PASS2) { float hh = 0.f; for (int k = 0; k < chunk; ++k) { const size_t o = ((size_t)bl * NCHUNK + k) * D + ch; hh = aggA[o] * hh + aggH[o]; } hst[ct] = hh; } }
        for (int tile = 0; tile < 2; ++tile) {
            const int r0 = chunk * 64 + tile * 32;
            const size_t rowb = (size_t)bl * TP;
            f32x16 xc[2];
#pragma unroll
            for (int ct = 0; ct < 2; ++ct) { const int ch = head * 64 + ct * 32 + r32;
#pragma unroll
                for (int sg = 0; sg < 4; ++sg) { float xw[7];
#pragma unroll
                    for (int d = 0; d < 7; ++d) { const int rr = r0 + 8 * sg + 4 * hi - 3 + d; const int rc = rr < 0 ? 0 : rr;
                        const float xv = bf2f(Z[(rowb + rc) * LDZ + ZXR + ch]); xw[d] = rr < PADR ? 0.f : xv; }
#pragma unroll
                    for (int q = 0; q < 4; ++q) xc[ct][4 * sg + q] = cb[ct] + c0[ct] * xw[q] + c1[ct] * xw[q + 1] + c2[ct] * xw[q + 2] + c3[ct] * xw[q + 3]; } }
#pragma unroll
            for (int ct = 0; ct < 2; ++ct)
#pragma unroll
                for (int r = 0; r < 16; ++r) xcb[crow(r, hi) * 72 + ct * 32 + r32] = f2bf(xc[ct][r]);
            bf16x8 af[4];
#pragma unroll
            for (int ks = 0; ks < 4; ++ks) af[ks] = *(const LAS bf16x8*)(xcb + r32 * 72 + ks * 16 + hi * 8);
            f32x16 gr_[2], gi_[2];
#pragma unroll
            for (int ct = 0; ct < 2; ++ct) {
#pragma unroll
                for (int r = 0; r < 16; ++r) { gr_[ct][r] = 0.f; gi_[ct][r] = 0.f; }
#pragma unroll
                for (int ks = 0; ks < 4; ++ks) { gr_[ct] = __builtin_amdgcn_mfma_f32_32x32x16_bf16(af[ks], wrf[ct][ks], gr_[ct], 0, 0, 0); gi_[ct] = __builtin_amdgcn_mfma_f32_32x32x16_bf16(af[ks], wif[ct][ks], gi_[ct], 0, 0, 0); } }
            asm volatile("s_waitcnt lgkmcnt(0)" ::: "memory");
#pragma unroll
            for (int ct = 0; ct < 2; ++ct) { const int ch = head * 64 + ct * 32 + r32;
                f32x16 av, uv;
#pragma unroll
                for (int r = 0; r < 16; ++r) { const float rg = sigm(gr_[ct][r] + br[ct]), ig = sigm(gi_[ct][r] + bi[ct]);
                    const float aa = ex2(sp8[ct] * rg); const float m2 = 1.0f - aa * aa; const float mult = sqrtf(m2 > 0.f ? m2 : 0.f);
                    const bool pad = (r0 + crow(r, hi)) < PADR;
                    av[r] = pad ? 1.0f : aa; uv[r] = pad ? 0.f : mult * ig * xc[ct][r]; }
                float As[4], Us[4];
#pragma unroll
                for (int sg = 0; sg < 4; ++sg) { As[sg] = (av[4 * sg] * av[4 * sg + 1]) * (av[4 * sg + 2] * av[4 * sg + 3]);
                    Us[sg] = ((uv[4 * sg] * av[4 * sg + 1] + uv[4 * sg + 1]) * av[4 * sg + 2] + uv[4 * sg + 2]) * av[4 * sg + 3] + uv[4 * sg + 3]; }
                float h = hst[ct], hs[4];
#pragma unroll
                for (int sg = 0; sg < 4; ++sg) { const float he0 = As[sg] * h + Us[sg]; const float t = __shfl_xor(he0, 32);
                    const float he1 = As[sg] * t + Us[sg]; const float t2 = __shfl_xor(he1, 32);
                    hs[sg] = hi ? t : h; h = hi ? he1 : t2; }
                hst[ct] = h;
                if (!PASS2) { const float own = (As[0] * As[1]) * (As[2] * As[3]); apr[ct] *= own * __shfl_xor(own, 32); }
                else {
#pragma unroll
                    for (int sg = 0; sg < 4; ++sg) { float hh = hs[sg];
#pragma unroll
                        for (int q = 0; q < 4; ++q) { hh = av[4 * sg + q] * hh + uv[4 * sg + q];
                            bf16_t* p = Z + (rowb + r0 + 8 * sg + 4 * hi + q) * LDZ + ZGR + ch; *p = f2bf(hh * bf2f(*p)); } }
                }
            }
        }
        if (!PASS2 && hi == 0) {
#pragma unroll
            for (int ct = 0; ct < 2; ++ct) { const size_t o = ((size_t)bl * NCHUNK + chunk) * D + head * 64 + ct * 32 + r32; aggA[o] = apr[ct]; aggH[o] = hst[ct]; } }
    }
}

DI void attn_wave(Ctx& F, const Args& a, int l, int bl, int head, int qb) {
    const int lane = opaque(threadIdx.x) & 63, r32 = lane & 31, hi = lane >> 5;
    bf16_t* Z = (bf16_t*)(F.ws + WS_Z); const bf16_t* VT = (const bf16_t*)(F.ws + WS_VT);
    const float* tab = (const float*)(F.ws + WS_TAB) + DEPTH * D + 2 * l;
    const float lam = tab[0], omli = tab[1];
    const size_t rowq = (size_t)bl * TP + qb * 32 + r32;
    bf16_t* zq = Z + rowq * LDZ + ZQ + head * 64;
    bf16x8 qf[2][2];
#pragma unroll
    for (int m = 0; m < 2; ++m)
#pragma unroll
        for (int s = 0; s < 2; ++s) qf[m][s] = *(const bf16x8*)(zq + m * 32 + s * 16 + hi * 8);
    f32x16 O[2][2];
#pragma unroll
    for (int m = 0; m < 2; ++m)
#pragma unroll
        for (int vh = 0; vh < 2; ++vh)
#pragma unroll
            for (int r = 0; r < 16; ++r) O[m][vh][r] = 0.f;
    float mrun[2] = {-INFINITY, -INFINITY}, lrun[2] = {0.f, 0.f};
    const int ktmax = 2 * (qb >> 1) + 1;
    const int pr = (r32 & ~12) | ((r32 & 4) << 1) | ((r32 & 8) >> 1);
    const bf16_t* kbase = Z + ((size_t)bl * TP + pr) * LDZ + ZK + head * 64 + hi * 8;
    const bf16_t* vbase = VT + (size_t)(head * 64 + r32) * MG + (size_t)bl * TP + hi * 8;
    for (int kt = 1; kt <= ktmax; ++kt) {
        const bf16_t* kp = kbase + (size_t)kt * 32 * LDZ;
        bf16x8 kf[2][2], vf[2][2];
#pragma unroll
        for (int m = 0; m < 2; ++m)
#pragma unroll
            for (int s = 0; s < 2; ++s) kf[m][s] = *(const bf16x8*)(kp + m * 32 + s * 16);
#pragma unroll
        for (int vh = 0; vh < 2; ++vh)
#pragma unroll
            for (int s = 0; s < 2; ++s) vf[vh][s] = *(const bf16x8*)(vbase + (size_t)vh * 32 * MG + kt * 32 + s * 16);
#pragma unroll
        for (int m = 0; m < 2; ++m) {
            f32x16 S;
#pragma unroll
            for (int r = 0; r < 16; ++r) S[r] = 0.f;
            S = __builtin_amdgcn_mfma_f32_32x32x16_bf16(kf[m][0], qf[m][0], S, 0, 0, 0);
            S = __builtin_amdgcn_mfma_f32_32x32x16_bf16(kf[m][1], qf[m][1], S, 0, 0, 0);
            if (kt == 1) {
#pragma unroll
                for (int r = 0; r < 8; ++r) S[r] = -INFINITY; }
            float mx = S[0];
#pragma unroll
            for (int r = 1; r < 16; ++r) mx = fmaxf(mx, S[r]);
            mx = fmaxf(mx, __shfl_xor(mx, 32));
            const float mnew = fmaxf(mrun[m], mx); const float alpha = ex2(mrun[m] - mnew); mrun[m] = mnew;
            float ps = 0.f;
#pragma unroll
            for (int r = 0; r < 16; ++r) { S[r] = ex2(S[r] - mnew); ps += S[r]; }
            lrun[m] = lrun[m] * alpha + ps;
#pragma unroll
            for (int vh = 0; vh < 2; ++vh)
#pragma unroll
                for (int r = 0; r < 16; ++r) O[m][vh][r] *= alpha;
            bf16x8 pf[2];
#pragma unroll
            for (int s = 0; s < 2; ++s) { u32x4 w; w.x = cvt_pk_bf16(S[8 * s], S[8 * s + 1]); w.y = cvt_pk_bf16(S[8 * s + 2], S[8 * s + 3]); w.z = cvt_pk_bf16(S[8 * s + 4], S[8 * s + 5]); w.w = cvt_pk_bf16(S[8 * s + 6], S[8 * s + 7]);
                pf[s] = __builtin_bit_cast(bf16x8, w); }
#pragma unroll
            for (int vh = 0; vh < 2; ++vh)
#pragma unroll
                for (int s = 0; s < 2; ++s) O[m][vh] = __builtin_amdgcn_mfma_f32_32x32x16_bf16(vf[vh][s], pf[s], O[m][vh], 0, 0, 0);
        }
    }
    const float l1 = lrun[0] + __shfl_xor(lrun[0], 32), l2 = lrun[1] + __shfl_xor(lrun[1], 32);
    const float c1 = 1.0f / l1, c2 = lam / l2;
    float ss = 0.f;
#pragma unroll
    for (int vh = 0; vh < 2; ++vh)
#pragma unroll
        for (int r = 0; r < 16; ++r) { const float o = O[0][vh][r] * c1 - O[1][vh][r] * c2; O[0][vh][r] = o; ss += o * o; }
    ss += __shfl_xor(ss, 32);
    const float rms = omli / sqrtf(ss * (1.0f / 64.0f) + 1e-5f);
    const float* sg = a.in[7] + l * 64;
#pragma unroll
    for (int vh = 0; vh < 2; ++vh)
#pragma unroll
        for (int g4 = 0; g4 < 4; ++g4) { const int vd = vh * 32 + 8 * g4 + 4 * hi; const f32x4 gv = *(const f32x4*)(sg + vd);
            u32x2 w; w.x = cvt_pk_bf16(O[0][vh][4 * g4] * rms * gv[0], O[0][vh][4 * g4 + 1] * rms * gv[1]); w.y = cvt_pk_bf16(O[0][vh][4 * g4 + 2] * rms * gv[2], O[0][vh][4 * g4 + 3] * rms * gv[3]);
            *(u32x2*)(zq + vd) = w; }
}
DI void attn_phase(Ctx& F, const Args& a, int l, unsigned* qhead) {
    const int tid = opaque(threadIdx.x);
    for (;;) {
        if (tid == 0) F.MISC[0] = atomicAdd(qhead, 1u);
        __syncthreads();
        const unsigned u = F.MISC[0];
        __syncthreads();
        if (u >= 17u * 64u) break;
        const int j = (int)(u >> 6), bh = (int)(u & 63), qb = NQB - 1 - 8 * j - F.wave;
        if (qb >= 0) attn_wave(F, a, l, bh >> 3, bh & 7, qb);
    }
}

__global__ void __launch_bounds__(512, 2) fwd_kernel(Args a) {
    extern __shared__ __attribute__((aligned(16))) unsigned char lds_raw[];
    Ctx F;
    F.lds = (LAS unsigned char*)lds_raw; F.MISC = (volatile LAS unsigned*)(F.lds + MISC_OFF);
    F.wave = __builtin_amdgcn_readfirstlane(threadIdx.x >> 6);
    F.G = gridDim.x; F.gw = blockIdx.x * 8 + F.wave; F.NGW = F.G * 8;
    F.ws = a.ws; F.ctl = (unsigned*)(a.ws + WS_CTL); F.out = a.out;
    if (threadIdx.x < 64) F.MISC[threadIdx.x] = 0u;
    __syncthreads();
    XcdBarrier bar = xcd_barrier_post(F.ctl + CW_BAR, F.MISC + 8);
    const char* wsb = (const char*)a.ws;
    bf16_t* Zp = (bf16_t*)(a.ws + WS_Z); bf16_t* Hp = (bf16_t*)(a.ws + WS_H); bf16_t* Yp = (bf16_t*)((unsigned char*)a.out + OUT_Y);
    bf16_t* ACTp = (bf16_t*)(a.ws + WS_ACT);

#ifndef PH_MASK
#define PH_MASK 0xffff
#endif
    if (PH_MASK & 1) prologue(F, a);
#pragma unroll 1
    for (int g = 0; g < NGRP; ++g) {
        if (PH_MASK & 2) ln_in_phase(F, a, g);
        xcd_barrier(bar);
#pragma unroll 1
        for (int l = 0; l < DEPTH; ++l) {
            const int mi = l >> 1;
            { ProbInProj P; P.Abase = wsb; P.G = F.G; P.c = blockIdx.x; P.offW = (unsigned)(WS_WIN + (size_t)l * PROJW * D * 2); P.bg0 = a.in[5] + (size_t)l * 2 * D; P.bg1 = P.bg0 + D; P.Z = Zp; P.VT = (bf16_t*)(a.ws + WS_VT);
              if (PH_MASK & 4) g8::gemm_phase(F.lds, P); }
            xcd_barrier(bar);
            if (PH_MASK & 8) lru_phase<false>(F, a, l);
            if (PH_MASK & 16) attn_phase(F, a, l, F.ctl + CW_Q + 64 * (g * 4 + l));
            xcd_barrier(bar);
            if (PH_MASK & 32) lru_phase<true>(F, a, l);
            xcd_barrier(bar);
            { ProbMix P; P.Abase = wsb; P.G = F.G; P.c = blockIdx.x; P.offW = (unsigned)(WS_WMIX + (size_t)l * D * 1536 * 2); P.Z = Zp;
              if (PH_MASK & 64) g8::gemm_phase(F.lds, P); }
            xcd_barrier(bar);
            { ProbResid<16, 1024> P; P.Abase = wsb; P.G = F.G; P.c = blockIdx.x; P.offA = (unsigned)(WS_Z + ZGA * 2); P.lda2 = LDZ * 2; P.offW = (unsigned)(WS_WO + (size_t)l * D * D * 2); P.H = Hp; P.Y = Yp;
              if (PH_MASK & 128) g8::gemm_phase(F.lds, P); }
            xcd_barrier(bar);
            const float* g1 = a.in[18] + (size_t)(l * 2) * D; const float* b1 = a.in[19] + (size_t)(l * 2) * D;
            unsigned* cntw = F.ctl + CW_CNT + 64 * (g * 2 + mi);
            if ((l & 1) == 0) {
                if (PH_MASK & 256) ln_phase<0, false>(F, a, g, g1, b1, nullptr, nullptr);
                xcd_barrier(bar);
                { ProbUpD P; P.Abase = wsb; P.G = F.G; P.c = blockIdx.x; P.offW = (unsigned)(WS_WGUD + (size_t)mi * PROJW * D * 2); P.ACT = ACTp;
                  if (PH_MASK & 512) g8::gemm_phase(F.lds, P); }
                xcd_barrier(bar);
                { ProbResid<44, 2816> P; P.Abase = wsb; P.G = F.G; P.c = blockIdx.x; P.offA = (unsigned)WS_ACT; P.lda2 = DFF * 2; P.offW = (unsigned)(WS_WDD + (size_t)mi * D * DFF * 2); P.H = Hp; P.Y = Yp;
                  if (PH_MASK & 1024) g8::gemm_phase(F.lds, P); }
                xcd_barrier(bar);
                if (PH_MASK & 256) ln_phase<0, false>(F, a, g, g1 + D, b1 + D, nullptr, nullptr);
                xcd_barrier(bar);
            } else {
                if (PH_MASK & 2048) ln_phase<1, false>(F, a, g, g1, b1, a.in[23] + (size_t)mi * D * 8, cntw);
                xcd_barrier(bar);
                { ProbUpM P; P.Abase = wsb; P.G = F.G; P.c = blockIdx.x; P.offW = (unsigned)(WS_WGUM + (size_t)mi * 8 * PROJW * D * 2); P.ACT = ACTp;
                  P.list = (const int*)(a.ws + WS_ROUTE + (size_t)MG * 32); P.tab.init(cntw, 22);
                  if (PH_MASK & 4096) g8::gemm_phase(F.lds, P); }
                xcd_barrier(bar);
                { ProbDownM P; P.Abase = wsb; P.G = F.G; P.c = blockIdx.x; P.offW = (unsigned)(WS_WDM + (size_t)mi * 8 * D * DFF * 2); P.YS = (bf16_t*)(a.ws + WS_YSLOT);
                  P.wlist = (const float*)(a.ws + WS_ROUTE + (size_t)MG * 32 + (size_t)8 * MG * 4); P.tab.init(cntw, 4);
                  if (PH_MASK & 8192) g8::gemm_phase(F.lds, P); }
                xcd_barrier(bar);
                if (PH_MASK & 16384) { if (l == DEPTH - 1) ln_phase<3, true>(F, a, g, g1 + D, b1 + D, nullptr, cntw);
                else ln_phase<3, false>(F, a, g, g1 + D, b1 + D, nullptr, cntw); }
                xcd_barrier(bar);
            }
        }
    }
}

extern "C" void kernel_launch(void* const* d_in, const int* in_sizes, int n_in, void* d_out, int out_size, void* d_ws, size_t ws_size, hipStream_t stream) {
    static int grid = 0;
    if (grid == 0) {
        if (n_in != 27 || out_size != NBATCH * SEQ * D || ws_size < WS_END) { fprintf(stderr, "kernel_launch: unexpected problem (n_in %d, out %d, ws %zu)\n", n_in, out_size, ws_size); grid = -1; return; }
        int dev = 0, cus = 0;
        if (hipGetDevice(&dev) != hipSuccess || hipDeviceGetAttribute(&cus, hipDeviceAttributeMultiprocessorCount, dev) != hipSuccess) { grid = -1; return; }
        if (hipFuncSetAttribute((const void*)fwd_kernel, hipFuncAttributeMaxDynamicSharedMemorySize, LDS_BYTES) != hipSuccess) { fprintf(stderr, "kernel_launch: hipFuncSetAttribute failed\n"); grid = -1; return; }
        int per_cu = 0;
        if (hipOccupancyMaxActiveBlocksPerMultiprocessor(&per_cu, (const void*)fwd_kernel, 512, LDS_BYTES) != hipSuccess || per_cu < 1) fprintf(stderr, "kernel_launch: occupancy query says %d\n", per_cu);
        (void)hipGetLastError();
        grid = cus;
    }
    if (grid < 0) return;
    (void)hipMemsetAsync((char*)d_ws + WS_CTL, 0, CTL_BYTES, stream);
    Args a{};
    for (int i = 0; i < 27; ++i) a.in[i] = (const float*)d_in[i];
    a.out = (float*)d_out; a.ws = (unsigned char*)d_ws;
    hipLaunchKernelGGL(fwd_kernel, dim3(grid), dim3(512), LDS_BYTES, stream, a);
}
```

```cpp
#include <hip/hip_runtime.h>
#include <cstdio>
#include <cstdint>

#ifndef PROBE_DUP
#define PROBE_DUP 0
#endif
#define DI __device__ __forceinline__
#define LAS __attribute__((address_space(3)))
typedef unsigned short bf16_t;
typedef short bf16x8 __attribute__((ext_vector_type(8)));
typedef float f32x4 __attribute__((ext_vector_type(4)));
typedef float f32x16 __attribute__((ext_vector_type(16)));
typedef unsigned u32x4 __attribute__((ext_vector_type(4)));
typedef unsigned u32x2 __attribute__((ext_vector_type(2)));

constexpr int D = 1024, NBATCH = 16, SEQ = 4096, DEPTH = 4;
constexpr int TP = 4160;
constexpr int PADR = 48, FRAME0 = 64;
constexpr int GB = 8, NGRP = NBATCH / GB;
constexpr int MG = GB * TP;
constexpr int NMT = MG / 256;
constexpr int LDZ = 5120;
constexpr int ZQ = 0, ZK = 512, ZXR = 1024, ZGR = 2048, ZGA = 3072, ZGL = 4096;
constexpr int DFF = 2816, NEXP = 8, PROJW = 5632;
constexpr int NCHUNK = TP / 64;
constexpr int NQB = TP / 32;
constexpr float ALPHA = 1.681792830507429f;
constexpr float LOG2E = 1.4426950408889634f;
constexpr float QSCALE = 0.17677669529663687f * LOG2E;
constexpr int SLOT_ROWS = 2 * MG + 8 * 256;

constexpr size_t MiB = 1u << 20;
constexpr size_t WS_CTL = 0, CTL_BYTES = 1 * MiB;
constexpr size_t WS_TAB = 1 * MiB;
constexpr size_t WS_WIN = 2 * MiB;
constexpr size_t WS_WMIX = 46 * MiB;
constexpr size_t WS_WO = 58 * MiB;
constexpr size_t WS_WR = 66 * MiB;
constexpr size_t WS_WI = 66 * MiB + 512 * 1024;
constexpr size_t WS_WGUD = 67 * MiB;
constexpr size_t WS_WDD = 89 * MiB;
constexpr size_t WS_WGUM = 100 * MiB;
constexpr size_t WS_WDM = 276 * MiB;
constexpr size_t WS_H = 364 * MiB;
constexpr size_t WS_AGG = 429 * MiB;
constexpr size_t WS_ROUTE = 434 * MiB;
constexpr size_t WS_YSLOT = 438 * MiB;
constexpr size_t WS_Z = 572 * MiB;
constexpr size_t WS_VT = 897 * MiB;
constexpr size_t WS_ACT = WS_Z;
constexpr size_t WS_END = 941 * MiB;
constexpr size_t OUT_Y = 128 * MiB;
static_assert(WS_WIN + (size_t)DEPTH * PROJW * D * 2 <= WS_WMIX, "map");
static_assert(WS_WMIX + (size_t)DEPTH * D * 1536 * 2 <= WS_WO, "map");
static_assert(WS_WGUD + (size_t)2 * PROJW * D * 2 <= WS_WDD && WS_WDD + (size_t)2 * D * DFF * 2 <= WS_WGUM, "map");
static_assert(WS_WGUM + (size_t)16 * PROJW * D * 2 <= WS_WDM && WS_WDM + (size_t)16 * D * DFF * 2 <= WS_H, "map");
static_assert(WS_H + (size_t)MG * D * 2 <= WS_AGG && WS_AGG + (size_t)2 * GB * NCHUNK * D * 4 <= WS_ROUTE, "map");
static_assert(WS_ROUTE + (size_t)MG * 32 + (size_t)2 * 8 * MG * 4 <= WS_YSLOT && WS_YSLOT + (size_t)SLOT_ROWS * D * 2 <= WS_Z, "map");
static_assert(WS_Z + (size_t)MG * LDZ * 2 <= WS_VT && WS_VT + (size_t)512 * MG * 2 <= WS_END && WS_ACT + (size_t)SLOT_ROWS * DFF * 2 <= WS_END, "map");

constexpr int CW_BAR = 4096;
constexpr int CW_Q = 8192;
constexpr int CW_CNT = 12288;

constexpr int LDS_STAGE = 131072;
constexpr int MISC_OFF = LDS_STAGE;
constexpr int LDS_BYTES = LDS_STAGE + 1024;

DI float bf_lo(unsigned w) { return __uint_as_float(w << 16); }
DI float bf_hi(unsigned w) { return __uint_as_float(w & 0xffff0000u); }
DI float bf2f(bf16_t b) { return __uint_as_float((unsigned)b << 16); }
DI unsigned cvt_pk_bf16(float lo, float hi) { unsigned r; asm volatile("v_cvt_pk_bf16_f32 %0, %1, %2" : "=v"(r) : "v"(lo), "v"(hi)); return r; }
DI bf16_t f2bf(float f) { return (bf16_t)(cvt_pk_bf16(f, 0.f) & 0xffffu); }
DI float ex2(float x) { return __builtin_amdgcn_exp2f(x); }
DI float rcpf_(float x) { return __builtin_amdgcn_rcpf(x); }
DI float sigm(float x) { return rcpf_(1.0f + ex2(-LOG2E * x)); }
DI float silu_(float x) { return x * sigm(x); }
DI float gelu_tanh(float x) { const float u = 0.7978845608028654f * (x + 0.044715f * x * x * x); return x * sigm(2.0f * u); }
DI int opaque(int x) { asm volatile("" : "+v"(x)); return x; }
DI int opaque_s(int x) { asm volatile("" : "+s"(x)); return x; }
DI float wave_sum(float v) {
#pragma unroll
    for (int o = 1; o < 64; o <<= 1) v += __shfl_xor(v, o);
    return v;
}
DI void unpack8(const u32x4 w, float (&f)[8]) { f[0] = bf_lo(w.x); f[1] = bf_hi(w.x); f[2] = bf_lo(w.y); f[3] = bf_hi(w.y); f[4] = bf_lo(w.z); f[5] = bf_hi(w.z); f[6] = bf_lo(w.w); f[7] = bf_hi(w.w); }
DI u32x4 pack8(const f32x4 a, const f32x4 b) { u32x4 w; w.x = cvt_pk_bf16(a[0], a[1]); w.y = cvt_pk_bf16(a[2], a[3]); w.z = cvt_pk_bf16(b[0], b[1]); w.w = cvt_pk_bf16(b[2], b[3]); return w; }

#define XB_TMO      128
#define XB_XCNT(j)  (256  + 64 * (j))
#define XB_XSUB(j)  (1280 + 64 * (j))
#define XB_XGEN(j)  (2304 + 64 * (j))
#define XB_TOP      3328
#define XB_TOPGEN   3392
#define XCD_BAR_WORDS 3456
#define XB_SPIN_CAP (1u << 18)
DI unsigned xb_ld(unsigned* p)              { return __hip_atomic_load(p, __ATOMIC_RELAXED, __HIP_MEMORY_SCOPE_AGENT); }
DI unsigned xb_add(unsigned* p, unsigned v) { return __hip_atomic_fetch_add(p, v, __ATOMIC_RELAXED, __HIP_MEMORY_SCOPE_AGENT); }
DI unsigned xb_xcc_id() { return (unsigned)__builtin_amdgcn_s_getreg((3 << 11) | 20) & 0xFu; }
#define XB_SPIN(cond, bar) do { unsigned _sp = 0; while (cond) { __builtin_amdgcn_s_sleep(1); \
    if ((++_sp & 255u) == 0u) { if (xb_ld(&(bar)[XB_TMO])) break; if (_sp > XB_SPIN_CAP) { atomicAdd(&(bar)[XB_TMO], 1u); break; } } } } while (0)
struct XcdBarrier { unsigned* bar; unsigned x; volatile LAS unsigned* st; };
DI XcdBarrier xcd_barrier_post(unsigned* bar, volatile LAS unsigned* st) {
    XcdBarrier b; b.bar = bar; b.x = xb_xcc_id(); b.st = st;
    if (threadIdx.x == 0) (void)xb_add(&bar[XB_XCNT(b.x)], 1u);
    return b;
}
DI void xcd_barrier_complete(unsigned* bar, unsigned x, unsigned& nloc, unsigned& nx) {
    const unsigned G = gridDim.x * gridDim.y * gridDim.z;
    unsigned sum, cnt, mine, sp = 0u;
    for (;;) {
        sum = 0u; cnt = 0u; mine = 0u;
#pragma unroll
        for (unsigned j = 0; j < 16; ++j) { const unsigned c = xb_ld(&bar[XB_XCNT(j)]); sum += c; cnt += (c > 0u) ? 1u : 0u; mine = (j == x) ? c : mine; }
        if (sum == G) break;
        __builtin_amdgcn_s_sleep(1);
        if ((++sp & 255u) == 0u) { if (xb_ld(&bar[XB_TMO])) break; if (sp > XB_SPIN_CAP) { atomicAdd(&bar[XB_TMO], 1u); break; } }
    }
    nloc = mine > 0u ? mine : 1u; nx = cnt > 0u ? cnt : 1u;
}
DI void xcd_barrier(const XcdBarrier& b) {
    asm volatile("s_waitcnt vmcnt(0)" ::: "memory");
    __syncthreads();
    if (threadIdx.x == 0) {
        unsigned* bar = b.bar;
        __builtin_amdgcn_s_waitcnt(0);
        unsigned nloc = b.st[0], nx = b.st[1];
        if (nloc == 0u) { xcd_barrier_complete(bar, b.x, nloc, nx); b.st[0] = nloc; b.st[1] = nx; }
        const unsigned old = xb_add(&bar[XB_XSUB(b.x)], 1u);
        const unsigned gen = old / nloc;
        if (old + 1u == (gen + 1u) * nloc) {
            __builtin_amdgcn_fence(__ATOMIC_RELEASE, "agent");
            asm volatile("s_waitcnt vmcnt(0)" ::: "memory");
            const unsigned og = xb_add(&bar[XB_TOP], 1u);
            const unsigned tg = og / nx;
            if (og + 1u == (tg + 1u) * nx) xb_add(&bar[XB_TOPGEN], 1u);
            else XB_SPIN(xb_ld(&bar[XB_TOPGEN]) == tg, bar);
            __builtin_amdgcn_fence(__ATOMIC_ACQUIRE, "agent");
            xb_add(&bar[XB_XGEN(b.x)], 1u);
            asm volatile("s_waitcnt vmcnt(0)" ::: "memory");
        } else {
            XB_SPIN(xb_ld(&bar[XB_XGEN(b.x)]) == gen, bar);
            __builtin_amdgcn_fence(__ATOMIC_ACQUIRE, "agent");
            asm volatile("s_waitcnt vmcnt(0)" ::: "memory");
        }
    }
    __syncthreads();
}

namespace g8 {
constexpr int BM = 256, BK = 64, HALF = 128, HTB = HALF * BK * 2, STAGE_BYTES = 8 * HTB, NXCD = 8, WGM = 8;
static_assert(STAGE_BYTES == LDS_STAGE, "stage");
__host__ __device__ __forceinline__ int lds_byte(int r, int c) { const int st = (r >> 4) * 2 + (c >> 5), rr = r & 15, cc = c & 31, ob = rr * 64 + cc * 2; return st * 1024 + (ob ^ (((ob >> 9) & 1) << 5)); }
__host__ __device__ __forceinline__ void stage_rc(int b, int& R, int& C) { const int st = b / 1024, sb = b % 1024, swz = sb ^ (((sb >> 9) & 1) << 5); R = (st >> 1) * 16 + swz / 64; C = (st & 1) * 32 + (swz % 64) / 2; }
__host__ __device__ __forceinline__ int perm32(int rho) { const int n = rho >> 4, i = rho & 15; return 8 * (i >> 2) + 4 * n + (i & 3); }
struct Unit { int pm, pn, aux, x0, x1; };
DI int static_map(int L, int nM, int nN) {
    const int nwg = nM * nN; int wgid = L;
    { const int q = nwg / NXCD, r = nwg % NXCD, xcd = wgid % NXCD, off = wgid / NXCD; wgid = (xcd < r ? xcd * (q + 1) : r * (q + 1) + (xcd - r) * q) + off; }
    const int nig = WGM * nN, gid = wgid / nig, fm = gid * WGM, gsz = (nM - fm) < WGM ? (nM - fm) : WGM;
    return (fm + ((wgid % nig) % gsz)) | (((wgid % nig) / gsz) << 16);
}
typedef f32x4 Acc[2][2][4][2];

template <class P>
DI void gemm_phase(LAS unsigned char* lds, const P& prob) {
    const int tid = opaque(threadIdx.x), wid = __builtin_amdgcn_readfirstlane(tid >> 6), lane = tid & 63, wr = wid >> 2, wc = wid & 3, fr = lane & 15, fq = lane >> 4;
    int R[2], C[2]; unsigned voffB[2], voffA[2];
#pragma unroll
    for (int i = 0; i < 2; ++i) { stage_rc(tid * 16 + i * 8192, R[i], C[i]); const int Rb = P::PERM ? ((R[i] & ~31) + perm32(R[i] & 31)) : R[i]; voffB[i] = (unsigned)(Rb * P::LDB + C[i]) * 2u;
        voffA[i] = (unsigned)R[i] * prob.ldaB() + (unsigned)C[i] * 2u; }
    constexpr unsigned hstepB = (unsigned)HALF * P::LDB * 2u;
    const unsigned hstepA = (unsigned)HALF * prob.ldaB();
    const unsigned ldsw = (unsigned)wid * 1024u;
    const int aoff = lds_byte(wr * 64 + fr, fq * 8), boff = lds_byte(wc * 32 + fr, fq * 8);
#define G8_SA(b, h) (((b) * 2 + (h)) * HTB)
#define G8_SB(b, h) ((4 + (b) * 2 + (h)) * HTB)
#define G8_STAGE_B(bufoff, gbase) do { _Pragma("unroll") for (int _i = 0; _i < 2; ++_i) \
        __builtin_amdgcn_global_load_lds((const unsigned*)((const char*)(gbase) + voffB[_i]), (LAS unsigned*)(lds + (bufoff) + ldsw + _i * 8192), 16, 0, 0); } while (0)
#define G8_STAGE_A(bufoff, h, ub, gv, koff) do { if constexpr (P::GATHER) { const char* _kb = Ab + (koff); _Pragma("unroll") for (int _i = 0; _i < 2; ++_i) \
            __builtin_amdgcn_global_load_lds((const unsigned*)(_kb + (gv)[h][_i]), (LAS unsigned*)(lds + (bufoff) + ldsw + _i * 8192), 16, 0, 0); } \
        else { const char* _kb = Ab + ((ub) + (h) * hstepA + (koff)); _Pragma("unroll") for (int _i = 0; _i < 2; ++_i) \
            __builtin_amdgcn_global_load_lds((const unsigned*)(_kb + voffA[_i]), (LAS unsigned*)(lds + (bufoff) + ldsw + _i * 8192), 16, 0, 0); } } while (0)
#define G8_LDA(dst, b, h) do { _Pragma("unroll") for (int m = 0; m < 4; ++m) _Pragma("unroll") for (int k = 0; k < 2; ++k) dst[m][k] = *(const LAS bf16x8*)(lds + G8_SA(b, h) + aoff + m * 2048 + k * 1024); } while (0)
#define G8_LDB(dst, b, h) do { _Pragma("unroll") for (int n = 0; n < 2; ++n) _Pragma("unroll") for (int k = 0; k < 2; ++k) dst[n][k] = *(const LAS bf16x8*)(lds + G8_SB(b, h) + boff + n * 2048 + k * 1024); } while (0)
#define G8_MMA(ai, bj, At, Bt) do { __builtin_amdgcn_s_setprio(1); _Pragma("unroll") for (int m = 0; m < 4; ++m) _Pragma("unroll") for (int n = 0; n < 2; ++n) _Pragma("unroll") for (int k = 0; k < 2; ++k) \
        acc[ai][bj][m][n] = __builtin_amdgcn_mfma_f32_16x16x32_bf16(Bt[n][k], At[m][k], acc[ai][bj][m][n], 0, 0, 0); __builtin_amdgcn_s_setprio(0); } while (0)
#define G8_WAIT_V(n) asm volatile("s_waitcnt vmcnt(" #n ")" ::: "memory")
#define G8_WAIT_L(n) asm volatile("s_waitcnt lgkmcnt(" #n ")" ::: "memory")
#define G8_BAR __builtin_amdgcn_s_barrier()
#define G8_SCHED __builtin_amdgcn_sched_barrier(0)
    Unit cur, nxt; int ui = 0;
    if (!prob.next(0, cur)) return;
    Acc acc;
#pragma unroll
    for (int a = 0; a < 2; ++a)
#pragma unroll
        for (int b = 0; b < 2; ++b)
#pragma unroll
            for (int m = 0; m < 4; ++m)
#pragma unroll
                for (int n = 0; n < 2; ++n) acc[a][b][m][n] = (f32x4){0.f, 0.f, 0.f, 0.f};
    bf16x8 At[4][2], B0[2][2], B1[2][2];
    unsigned gvA[2][2], gvN[2][2];
    unsigned cU = 0, nU = 0;
    if constexpr (P::GATHER) prob.a_gather(cur, R, C, gvA); else cU = prob.a_unit(cur);
    const char* const Ab = prob.Abase;
    const char* cB = prob.b_ptr(cur);
    G8_STAGE_B(G8_SB(0, 0), cB); G8_STAGE_B(G8_SB(0, 1), cB + hstepB); G8_STAGE_A(G8_SA(0, 0), 0, cU, gvA, prob.koffA(cur, 0)); G8_STAGE_A(G8_SA(0, 1), 1, cU, gvA, prob.koffA(cur, 0));
    if (wr == 1) G8_BAR;
    G8_WAIT_V(2); G8_BAR;
    G8_STAGE_B(G8_SB(1, 0), cB + 128); G8_STAGE_A(G8_SA(1, 0), 0, cU, gvA, prob.koffA(cur, 1)); G8_STAGE_B(G8_SB(1, 1), cB + hstepB + 128);
    G8_WAIT_V(6); G8_BAR;
    for (;;) {
        const bool has_next = prob.next(ui + 1, nxt);
        if (!has_next) nxt = cur;
        if constexpr (P::GATHER) { if (has_next) prob.a_gather(nxt, R, C, gvN); else {
#pragma unroll
            for (int h = 0; h < 2; ++h)
#pragma unroll
                for (int i = 0; i < 2; ++i) gvN[h][i] = gvA[h][i]; } }
        else nU = has_next ? prob.a_unit(nxt) : cU;
        const char* nB = has_next ? prob.b_ptr(nxt) : cB;
        const int nt = prob.nt(cur);
        for (int t = 0; t < nt; t += 2) {
            const bool last = (t == nt - 2);
            const unsigned k1 = prob.koffA(cur, t + 1), k2 = last ? prob.koffA(nxt, 0) : prob.koffA(cur, t + 2), k3 = last ? prob.koffA(nxt, 1) : prob.koffA(cur, t + 3);
            unsigned v2[2][2]; unsigned u2 = 0;
            if constexpr (P::GATHER) {
#pragma unroll
                for (int h = 0; h < 2; ++h)
#pragma unroll
                    for (int i = 0; i < 2; ++i) v2[h][i] = last ? gvN[h][i] : gvA[h][i];
            } else u2 = last ? nU : cU;
            const char* b2 = last ? nB : cB + (size_t)(t + 2) * 128; const char* b3 = b2 + 128;
            G8_LDB(B0, 0, 0); G8_LDB(B1, 0, 1); G8_SCHED; G8_LDA(At, 0, 0); G8_STAGE_A(G8_SA(1, 1), 1, cU, gvA, k1);
            G8_WAIT_V(8); G8_WAIT_L(0); G8_BAR; G8_MMA(0, 0, At, B0); G8_MMA(0, 1, At, B1); G8_BAR; G8_SCHED;
            G8_LDA(At, 0, 1); G8_STAGE_B(G8_SB(0, 0), b2); G8_STAGE_B(G8_SB(0, 1), b2 + hstepB); G8_STAGE_A(G8_SA(0, 0), 0, u2, v2, k2);
            G8_WAIT_V(8); G8_WAIT_L(0); G8_BAR; G8_MMA(1, 0, At, B0); G8_MMA(1, 1, At, B1); G8_BAR; G8_SCHED;
            G8_LDB(B0, 1, 0); G8_LDB(B1, 1, 1); G8_SCHED; G8_LDA(At, 1, 0); G8_STAGE_A(G8_SA(0, 1), 1, u2, v2, k2);
            G8_WAIT_V(8); G8_WAIT_L(0); G8_BAR; G8_MMA(0, 0, At, B0); G8_MMA(0, 1, At, B1); G8_BAR; G8_SCHED;
            G8_LDA(At, 1, 1); G8_STAGE_B(G8_SB(1, 0), b3); G8_STAGE_B(G8_SB(1, 1), b3 + hstepB); G8_STAGE_A(G8_SA(1, 0), 0, u2, v2, k3);
            G8_WAIT_V(8); G8_WAIT_L(0); G8_BAR; G8_MMA(1, 0, At, B0); G8_MMA(1, 1, At, B1); G8_BAR; G8_SCHED;
        }
        if (wr == 0) G8_BAR;
        prob.epi(acc, cur, wr, wc, fr, fq);
        if (!has_next) break;
        if (!prob.keep(cur)) {
#pragma unroll
            for (int a = 0; a < 2; ++a)
#pragma unroll
                for (int b = 0; b < 2; ++b)
#pragma unroll
                    for (int m = 0; m < 4; ++m)
#pragma unroll
                        for (int n = 0; n < 2; ++n) acc[a][b][m][n] = (f32x4){0.f, 0.f, 0.f, 0.f};
        }
        cur = nxt; cB = nB; cU = nU; ++ui;
        if constexpr (P::GATHER) {
#pragma unroll
            for (int h = 0; h < 2; ++h)
#pragma unroll
                for (int i = 0; i < 2; ++i) gvA[h][i] = gvN[h][i];
        }
        if (wr == 1) G8_BAR;
    }
    G8_WAIT_V(0);
    G8_BAR;
#undef G8_SA
#undef G8_SB
#undef G8_STAGE_A
#undef G8_STAGE_B
#undef G8_LDA
#undef G8_LDB
#undef G8_MMA
#undef G8_WAIT_V
#undef G8_WAIT_L
#undef G8_BAR
#undef G8_SCHED
}
}
using g8::Unit; using g8::Acc;

#define ROW_OF(pm, ai, m) ((pm) * 256 + (ai) * 128 + wr * 64 + (m) * 16 + fr)

struct ProbBase { const char* Abase; int G, c; };

struct ProbInProj : ProbBase {
    static constexpr bool PERM = true; static constexpr int NT = 16, LDB = 1024;
    unsigned offW; const float* bg0; const float* bg1; bf16_t* Z; bf16_t* VT;
    static constexpr int U1 = NMT * 20, U2 = 2 * NMT;
    DI bool next(int i, Unit& u) const {
        const int L = i * G + c; if (L >= U1 + U2) return false;
        const int L2 = L - U1; const bool second = L2 >= 0;
        const int pk = g8::static_map(second ? 0 : L, NMT, 20);
        Unit t; t.aux = second ? 1 : 0; t.pm = second ? L2 / NMT : (pk & 0xffff); t.pn = second ? L2 % NMT : (pk >> 16); t.x0 = 0; t.x1 = 0; u = t; return true;
    }
    static constexpr bool GATHER = false;
    DI unsigned ldaB() const { return 2048u; }
    DI unsigned a_unit(const Unit& u) const { return (u.aux ? offW + 5120u * 2048u : (unsigned)WS_H) + (unsigned)u.pm * (256u * 2048u); }
    DI unsigned koffA(const Unit&, int t) const { return (unsigned)t * 128u; }
    DI int nt(const Unit&) const { return NT; }
    DI bool keep(const Unit&) const { return false; }
    DI const char* b_ptr(const Unit& u) const { return Abase + (u.aux ? (size_t)WS_H : (size_t)offW) + (size_t)u.pn * 256 * 2048; }
    DI void epi(Acc& acc, const Unit& u, int wr, int wc, int fr, int fq) const {
        if (u.aux == 0) {
            const int colt = u.pn * 256;
            const int kind = colt < ZGR ? 0 : (colt < ZGA ? 1 : (colt < ZGL ? 2 : 3));
            f32x4 bv[2][2];
#pragma unroll
            for (int bj = 0; bj < 2; ++bj)
#pragma unroll
                for (int n = 0; n < 2; ++n) bv[bj][n] = (f32x4){0.f, 0.f, 0.f, 0.f};
            if (kind >= 2) { const float* bp = (kind == 2 ? bg0 + (colt - ZGA) : bg1 + (colt - ZGL)) + wc * 32 + 8 * fq;
#pragma unroll
                for (int bj = 0; bj < 2; ++bj)
#pragma unroll
                    for (int n = 0; n < 2; ++n) bv[bj][n] = *(const f32x4*)(bp + bj * 128 + 4 * n); }
#pragma unroll
            for (int ai = 0; ai < 2; ++ai)
#pragma unroll
                for (int m = 0; m < 4; ++m) { bf16_t* rowp = Z + (size_t)ROW_OF(u.pm, ai, m) * LDZ + colt + wc * 32 + 8 * fq;
#pragma unroll
                    for (int bj = 0; bj < 2; ++bj) { f32x4 v0 = acc[ai][bj][m][0] + bv[bj][0], v1 = acc[ai][bj][m][1] + bv[bj][1];
                        if (kind == 1) {
#pragma unroll
                            for (int j = 0; j < 4; ++j) { v0[j] = gelu_tanh(v0[j]); v1[j] = gelu_tanh(v1[j]); } }
                        else if (kind >= 2) {
#pragma unroll
                            for (int j = 0; j < 4; ++j) { v0[j] = sigm(v0[j]); v1[j] = sigm(v1[j]); } }
                        *(u32x4*)(rowp + bj * 128) = pack8(v0, v1); } }
        } else {
#pragma unroll
            for (int ai = 0; ai < 2; ++ai)
#pragma unroll
                for (int m = 0; m < 4; ++m) { bf16_t* rowp = VT + (size_t)ROW_OF(u.pm, ai, m) * MG + u.pn * 256 + wc * 32 + 8 * fq;
#pragma unroll
                    for (int bj = 0; bj < 2; ++bj) *(u32x4*)(rowp + bj * 128) = pack8(acc[ai][bj][m][0], acc[ai][bj][m][1]); }
        }
    }
};

struct ProbMix : ProbBase {
    static constexpr bool PERM = true; static constexpr int LDB = 1536;
    unsigned offW; bf16_t* Z;
    DI bool next(int i, Unit& u) const { const int L = (i >> 1) * G + c; if (L >= NMT * 4) return false; const int pk = g8::static_map(L, NMT, 4); Unit t; t.pm = pk & 0xffff; t.pn = pk >> 16; t.aux = i & 1; t.x0 = 0; t.x1 = 0; u = t; return true; }
    static constexpr bool GATHER = false;
    DI unsigned ldaB() const { return LDZ * 2u; }
    DI unsigned a_unit(const Unit& u) const { return (unsigned)WS_Z + (unsigned)u.pm * (256u * LDZ * 2u); }
    DI unsigned koffA(const Unit& u, int t) const { return (unsigned)((u.aux ? ZGR : ZQ) * 2 + t * 128); }
    DI int nt(const Unit& u) const { return u.aux ? 16 : 8; }
    DI bool keep(const Unit& u) const { return u.aux == 0; }
    DI const char* b_ptr(const Unit& u) const { return Abase + (size_t)offW + (size_t)u.pn * 256 * (1536 * 2) + (u.aux ? 1024 : 0); }
    DI void epi(Acc& acc, const Unit& u, int wr, int wc, int fr, int fq) const {
        if (u.aux == 0) {
#pragma unroll
            for (int ai = 0; ai < 2; ++ai)
#pragma unroll
                for (int m = 0; m < 4; ++m) { const bf16_t* rowp = Z + (size_t)ROW_OF(u.pm, ai, m) * LDZ + u.pn * 256 + wc * 32 + 8 * fq;
#pragma unroll
                    for (int bj = 0; bj < 2; ++bj) { const u32x4 sa = *(const u32x4*)(rowp + ZGA + bj * 128), sl = *(const u32x4*)(rowp + ZGL + bj * 128);
                        float a8[8], l8[8]; unpack8(sa, a8); unpack8(sl, l8);
#pragma unroll
                        for (int j = 0; j < 4; ++j) { acc[ai][bj][m][0][j] *= a8[j] * rcpf_(l8[j]); acc[ai][bj][m][1][j] *= a8[4 + j] * rcpf_(l8[4 + j]); } }
                    asm volatile("" ::: "memory"); }
        } else {
#pragma unroll
            for (int ai = 0; ai < 2; ++ai)
#pragma unroll
                for (int m = 0; m < 4; ++m) { bf16_t* rowp = Z + (size_t)ROW_OF(u.pm, ai, m) * LDZ + u.pn * 256 + wc * 32 + 8 * fq;
#pragma unroll
                    for (int bj = 0; bj < 2; ++bj) { const u32x4 sl = *(const u32x4*)(rowp + ZGL + bj * 128); float l8[8]; unpack8(sl, l8);
                        f32x4 v0 = acc[ai][bj][m][0], v1 = acc[ai][bj][m][1];
#pragma unroll
                        for (int j = 0; j < 4; ++j) { v0[j] *= l8[j]; v1[j] *= l8[4 + j]; }
                        *(u32x4*)(rowp + ZGA + bj * 128) = pack8(v0, v1); }
                    asm volatile("" ::: "memory"); }
        }
    }
};

template <int NT_, int LDB_>
struct ProbResid : ProbBase {
    static constexpr bool PERM = true; static constexpr int NT = NT_, LDB = LDB_;
    unsigned offA, lda2; unsigned offW; const bf16_t* H; bf16_t* Y;
    DI bool next(int i, Unit& u) const { const int L = i * G + c; if (L >= NMT * 4) return false; const int pk = g8::static_map(L, NMT, 4); Unit t; t.pm = pk & 0xffff; t.pn = pk >> 16; t.aux = 0; t.x0 = 0; t.x1 = 0; u = t; return true; }
    static constexpr bool GATHER = false;
    DI unsigned ldaB() const { return lda2; }
    DI unsigned a_unit(const Unit& u) const { return offA + (unsigned)u.pm * 256u * lda2; }
    DI unsigned koffA(const Unit&, int t) const { return (unsigned)t * 128u; }
    DI int nt(const Unit&) const { return NT; }
    DI bool keep(const Unit&) const { return false; }
    DI const char* b_ptr(const Unit& u) const { return Abase + (size_t)offW + (size_t)u.pn * 256 * (LDB_ * 2); }
    DI void epi(Acc& acc, const Unit& u, int wr, int wc, int fr, int fq) const {
#pragma unroll
        for (int ai = 0; ai < 2; ++ai)
#pragma unroll
            for (int m = 0; m < 4; ++m) { const size_t ro = (size_t)ROW_OF(u.pm, ai, m) * D + u.pn * 256 + wc * 32 + 8 * fq;
#pragma unroll
                for (int bj = 0; bj < 2; ++bj) { const u32x4 hv = *(const u32x4*)(H + ro + bj * 128); float h8[8]; unpack8(hv, h8);
                    f32x4 v0 = acc[ai][bj][m][0], v1 = acc[ai][bj][m][1];
#pragma unroll
                    for (int j = 0; j < 4; ++j) { v0[j] += ALPHA * h8[j]; v1[j] += ALPHA * h8[4 + j]; }
                    *(u32x4*)(Y + ro + bj * 128) = pack8(v0, v1); }
                asm volatile("" ::: "memory"); }
    }
};

struct ProbUpD : ProbBase {
    static constexpr bool PERM = false; static constexpr int NT = 16, LDB = 1024;
    unsigned offW; bf16_t* ACT;
    DI bool next(int i, Unit& u) const { const int L = i * G + c; if (L >= NMT * 22) return false; const int pk = g8::static_map(L, NMT, 22); Unit t; t.pm = pk & 0xffff; t.pn = pk >> 16; t.aux = 0; t.x0 = 0; t.x1 = 0; u = t; return true; }
    static constexpr bool GATHER = false;
    DI unsigned ldaB() const { return 2048u; }
    DI unsigned a_unit(const Unit& u) const { return (unsigned)WS_H + (unsigned)u.pm * (256u * 2048u); }
    DI unsigned koffA(const Unit&, int t) const { return (unsigned)t * 128u; }
    DI int nt(const Unit&) const { return NT; }
    DI bool keep(const Unit&) const { return false; }
    DI const char* b_ptr(const Unit& u) const { return Abase + (size_t)offW + (size_t)u.pn * 256 * 2048; }
    DI void epi(Acc& acc, const Unit& u, int wr, int wc, int fr, int fq) const {
#pragma unroll
        for (int ai = 0; ai < 2; ++ai)
#pragma unroll
            for (int m = 0; m < 4; ++m) { bf16_t* rowp = ACT + (size_t)ROW_OF(u.pm, ai, m) * DFF + u.pn * 128 + wc * 16 + 4 * fq;
#pragma unroll
                for (int bj = 0; bj < 2; ++bj) { const f32x4 g = acc[ai][bj][m][0], up = acc[ai][bj][m][1];
                    u32x2 w; w.x = cvt_pk_bf16(silu_(g[0]) * up[0], silu_(g[1]) * up[1]); w.y = cvt_pk_bf16(silu_(g[2]) * up[2], silu_(g[3]) * up[3]);
                    *(u32x2*)(rowp + bj * 64) = w; } }
    }
};

struct MoeTab {
    int cnt[8], tiles[8], ub[9], rb[8];
    DI void init(const unsigned* cw, int nN) {
        int u = 0, r = 0;
#pragma unroll
        for (int e = 0; e < 8; ++e) { int c = (int)__builtin_amdgcn_readfirstlane(cw[e]); c = c > MG ? MG : c; cnt[e] = c; tiles[e] = (c + 255) >> 8; ub[e] = u; rb[e] = r; u += tiles[e] * nN; r += tiles[e]; }
        ub[8] = u;
    }
    DI bool find(int L, Unit& u) const {
        if (L >= ub[8]) return false;
        int e = 0;
#pragma unroll
        for (int k = 1; k < 8; ++k) e += (L >= ub[k]) ? 1 : 0;
        int te = 1, ue = 0, re = 0, ce = 0;
#pragma unroll
        for (int k = 0; k < 8; ++k) if (e == k) { te = tiles[k]; ue = ub[k]; re = rb[k]; ce = cnt[k]; }
        const int r = L - ue; Unit t; t.pm = r % te; t.pn = r / te; t.aux = e; t.x0 = re; t.x1 = ce; u = t; return true;
    }
};

struct ProbUpM : ProbBase {
    static constexpr bool PERM = false; static constexpr int NT = 16, LDB = 1024;
    unsigned offW; bf16_t* ACT; const int* list; MoeTab tab;
    DI bool next(int i, Unit& u) const { return tab.find(i * G + c, u); }
    static constexpr bool GATHER = true;
    DI unsigned ldaB() const { return 2048u; }
    DI unsigned a_unit(const Unit&) const { return 0u; }
    DI void a_gather(const Unit& u, const int (&R)[2], const int (&C)[2], unsigned (&vo)[2][2]) const {
        const int* le = list + (size_t)u.aux * MG;
#pragma unroll
        for (int h = 0; h < 2; ++h)
#pragma unroll
            for (int i = 0; i < 2; ++i) { const int pos = u.pm * 256 + h * 128 + R[i]; const int tok = le[pos < u.x1 ? pos : 0];
                vo[h][i] = (unsigned)WS_H + (unsigned)tok * 2048u + (unsigned)C[i] * 2u; }
    }
    DI unsigned koffA(const Unit&, int t) const { return (unsigned)t * 128u; }
    DI int nt(const Unit&) const { return NT; }
    DI bool keep(const Unit&) const { return false; }
    DI const char* b_ptr(const Unit& u) const { return Abase + (size_t)offW + (size_t)u.aux * ((size_t)PROJW * D * 2) + (size_t)u.pn * 256 * 2048; }
    DI void epi(Acc& acc, const Unit& u, int wr, int wc, int fr, int fq) const {
#pragma unroll
        for (int ai = 0; ai < 2; ++ai)
#pragma unroll
            for (int m = 0; m < 4; ++m) { bf16_t* rowp = ACT + (size_t)ROW_OF(u.x0 + u.pm, ai, m) * DFF + u.pn * 128 + wc * 16 + 4 * fq;
#pragma unroll
                for (int bj = 0; bj < 2; ++bj) { const f32x4 g = acc[ai][bj][m][0], up = acc[ai][bj][m][1];
                    u32x2 w; w.x = cvt_pk_bf16(silu_(g[0]) * up[0], silu_(g[1]) * up[1]); w.y = cvt_pk_bf16(silu_(g[2]) * up[2], silu_(g[3]) * up[3]);
                    *(u32x2*)(rowp + bj * 64) = w; } }
    }
};
struct ProbDownM : ProbBase {
    static constexpr bool PERM = true; static constexpr int NT = 44, LDB = 2816;
    unsigned offW; bf16_t* YS; const float* wlist; MoeTab tab;
    DI bool next(int i, Unit& u) const { return tab.find(i * G + c, u); }
    static constexpr bool GATHER = false;
    DI unsigned ldaB() const { return DFF * 2u; }
    DI unsigned a_unit(const Unit& u) const { return (unsigned)WS_ACT + (unsigned)(u.x0 + u.pm) * (256u * DFF * 2u); }
    DI unsigned koffA(const Unit&, int t) const { return (unsigned)t * 128u; }
    DI int nt(const Unit&) const { return NT; }
    DI bool keep(const Unit&) const { return false; }
    DI const char* b_ptr(const Unit& u) const { return Abase + (size_t)offW + (size_t)u.aux * ((size_t)D * DFF * 2) + (size_t)u.pn * 256 * (DFF * 2); }
    DI void epi(Acc& acc, const Unit& u, int wr, int wc, int fr, int fq) const {
        const float* we = wlist + (size_t)u.aux * MG;
#pragma unroll
        for (int ai = 0; ai < 2; ++ai)
#pragma unroll
            for (int m = 0; m < 4; ++m) { const int pos = ROW_OF(u.pm, ai, m); const float w = pos < u.x1 ? we[pos] : 0.f;
                bf16_t* rowp = YS + (size_t)(u.x0 * 256 + pos) * D + u.pn * 256 + wc * 32 + 8 * fq;
#pragma unroll
                for (int bj = 0; bj < 2; ++bj) *(u32x4*)(rowp + bj * 128) = pack8(acc[ai][bj][m][0] * w, acc[ai][bj][m][1] * w); }
    }
};

struct Args { const float* in[27]; float* out; unsigned char* ws; };
struct Ctx {
    LAS unsigned char* lds; volatile LAS unsigned* MISC;
    unsigned char* ws; unsigned* ctl; float* out;
    int wave, G, gw, NGW;
};
DI int crow(int r, int hi) { return (r & 3) + 8 * (r >> 2) + 4 * hi; }

DI void transpose_item(const float* W, int N, bf16_t* WT, int ldt, int kofs, int row_off, int mode, LAS float* scr, int item, int lane) {
    const int nblk = N / 32, kb = item / nblk, nb = item % nblk, k0 = 64 * kb, n0 = 32 * nb;
#pragma unroll 8
    for (int i = 0; i < 32; ++i) { const int kk = 2 * i + (lane >> 5); scr[kk * 33 + (lane & 31)] = W[(size_t)(k0 + kk) * N + n0 + (lane & 31)]; }
    asm volatile("s_waitcnt lgkmcnt(0)" ::: "memory");
    const int c = lane & 7;
    const float sc = (mode == 1 && n0 < 512) ? QSCALE : 1.0f;
#pragma unroll
    for (int j = 0; j < 4; ++j) { const int n = (lane >> 3) + 8 * j; const LAS float* s = scr + (8 * c) * 33 + n;
        const int ns = n0 + n; int drow;
        if (mode == 0) drow = row_off + ns;
        else if (mode == 1) drow = ns < 1024 ? ns : (ns < 1536 ? 5120 + (ns - 1024) : ns - 512);
        else drow = 32 * (ns >> 4) + 16 * row_off + (ns & 15);
        u32x4 o; o.x = cvt_pk_bf16(s[0 * 33] * sc, s[1 * 33] * sc); o.y = cvt_pk_bf16(s[2 * 33] * sc, s[3 * 33] * sc); o.z = cvt_pk_bf16(s[4 * 33] * sc, s[5 * 33] * sc); o.w = cvt_pk_bf16(s[6 * 33] * sc, s[7 * 33] * sc);
        *(u32x4*)(WT + (size_t)drow * ldt + kofs + k0 + 8 * c) = o; }
    asm volatile("s_waitcnt lgkmcnt(0)" ::: "memory");
}
DI void prologue(Ctx& F, const Args& a) {
    const int tid = opaque(threadIdx.x), lane = tid & 63;
    LAS float* scr = (LAS float*)(F.lds + F.wave * 16384);
    unsigned char* ws = F.ws;
    constexpr int L_IN = 16 * 176, L_AO = 8 * 32, L_LO = 16 * 32, L_O = 16 * 32, L_G = 32;
    constexpr int L_ALL = L_IN + L_AO + L_LO + L_O + 2 * L_G;
    constexpr int F_G = 16 * 88, F_D = 44 * 32, F_ALL = 2 * F_G + F_D;
    constexpr int NITEMS = DEPTH * L_ALL + 18 * F_ALL;
    for (int it = opaque_s(F.gw); it < NITEMS; it += F.NGW) {
        if (it < DEPTH * L_ALL) {
            const int l = it / L_ALL; int r = it % L_ALL;
            if (r < L_IN) { transpose_item(a.in[4] + (size_t)l * D * PROJW, PROJW, (bf16_t*)(ws + WS_WIN) + (size_t)l * PROJW * D, D, 0, 0, 1, scr, r, lane); continue; } r -= L_IN;
            if (r < L_AO) { transpose_item(a.in[15] + (size_t)l * 512 * D, D, (bf16_t*)(ws + WS_WMIX) + (size_t)l * D * 1536, 1536, 0, 0, 0, scr, r, lane); continue; } r -= L_AO;
            if (r < L_LO) { transpose_item(a.in[16] + (size_t)l * D * D, D, (bf16_t*)(ws + WS_WMIX) + (size_t)l * D * 1536, 1536, 512, 0, 0, scr, r, lane); continue; } r -= L_LO;
            if (r < L_O) { transpose_item(a.in[17] + (size_t)l * D * D, D, (bf16_t*)(ws + WS_WO) + (size_t)l * D * D, D, 0, 0, 0, scr, r, lane); continue; } r -= L_O;
            const int which = r / L_G, hh = (r % L_G) >> 1, sub = r & 1;
            transpose_item(a.in[which ? 12 : 10] + ((size_t)l * 16 + hh) * 4096, 64, (bf16_t*)(ws + (which ? WS_WI : WS_WR)) + ((size_t)l * 16 + hh) * 4096, 64, 0, 0, 0, scr, sub, lane);
        } else {
            const int r0 = it - DEPTH * L_ALL, set = r0 / F_ALL; int r = r0 % F_ALL;
            const float *wg, *wu, *wd; bf16_t *dgu, *dd;
            if (set < 2) { wg = a.in[20] + (size_t)set * D * DFF; wu = a.in[21] + (size_t)set * D * DFF; wd = a.in[22] + (size_t)set * DFF * D;
                dgu = (bf16_t*)(ws + WS_WGUD) + (size_t)set * PROJW * D; dd = (bf16_t*)(ws + WS_WDD) + (size_t)set * D * DFF; }
            else { const int s2 = set - 2; wg = a.in[24] + (size_t)s2 * D * DFF; wu = a.in[25] + (size_t)s2 * D * DFF; wd = a.in[26] + (size_t)s2 * DFF * D;
                dgu = (bf16_t*)(ws + WS_WGUM) + (size_t)s2 * PROJW * D; dd = (bf16_t*)(ws + WS_WDM) + (size_t)s2 * D * DFF; }
            if (r < F_G) { transpose_item(wg, DFF, dgu, D, 0, 0, 2, scr, r, lane); continue; } r -= F_G;
            if (r < F_G) { transpose_item(wu, DFF, dgu, D, 0, 1, 2, scr, r, lane); continue; } r -= F_G;
            transpose_item(wd, D, dd, DFF, 0, 0, 0, scr, r, lane);
        }
    }
    float* tab = (float*)(ws + WS_TAB);
    for (int i = blockIdx.x * 512 + tid; i < DEPTH * D; i += F.G * 512) { const float x = a.in[14][i]; tab[i] = log1pf(expf(-x)); }
    if (blockIdx.x == 0 && tid < DEPTH) { const int l = tid; const float* dl = a.in[6] + l * 128; float s1 = 0.f, s2 = 0.f;
        for (int j = 0; j < 32; ++j) { s1 += dl[j] * dl[32 + j]; s2 += dl[64 + j] * dl[96 + j]; }
        const float lam_init = 0.8f - 0.6f * expf(-0.3f * (float)l);
        tab[DEPTH * D + 2 * l] = expf(s1) - expf(s2) + lam_init; tab[DEPTH * D + 2 * l + 1] = 1.0f - lam_init; }
}

DI void ln_in_phase(Ctx& F, const Args& a, int g) {
    const int tid = opaque(threadIdx.x), lane = tid & 63; (void)tid;
    bf16_t* H = (bf16_t*)(F.ws + WS_H);
    const float* gam = a.in[2]; const float* bet = a.in[3];
    for (int row = opaque_s(F.gw); row < MG; row += F.NGW) {
        const int bl = row / TP, r = row % TP;
        u32x4* o = (u32x4*)(H + (size_t)row * D) + lane;
        const bool padrow = r < PADR;
        const float* src = r < FRAME0 ? a.in[1] + (size_t)(padrow ? 0 : r - PADR) * D : a.in[0] + ((size_t)(g * GB + bl) * SEQ + (r - FRAME0)) * D;
        f32x4 v[4]; float s = 0.f;
#pragma unroll
        for (int j = 0; j < 4; ++j) { v[j] = *(const f32x4*)(src + (j >> 1) * 512 + lane * 8 + (j & 1) * 4); s += (v[j][0] + v[j][1]) + (v[j][2] + v[j][3]); }
        const float mean = wave_sum(s) * (1.f / D); float s2 = 0.f;
#pragma unroll
        for (int j = 0; j < 4; ++j) { v[j] = v[j] - mean; s2 += (v[j][0] * v[j][0] + v[j][1] * v[j][1]) + (v[j][2] * v[j][2] + v[j][3] * v[j][3]); }
        const float rstd = 1.f / sqrtf(wave_sum(s2) * (1.f / D) + 1e-5f);
#pragma unroll
        for (int j = 0; j < 4; ++j) { const int c0 = (j >> 1) * 512 + lane * 8 + (j & 1) * 4; const f32x4 gg = *(const f32x4*)(gam + c0), bb = *(const f32x4*)(bet + c0); v[j] = v[j] * rstd * gg + bb; }
        u32x4 w0 = pack8(v[0], v[1]), w1 = pack8(v[2], v[3]);
        if (padrow) { w0 = (u32x4){0u, 0u, 0u, 0u}; w1 = w0; }
        o[0] = w0; o[64] = w1;
    }
}

template <int MODE, bool FINAL>
DI void ln_phase(Ctx& F, const Args& a, int g, const float* gam, const float* bet, const float* router, unsigned* cntw) {
    const int tid = opaque(threadIdx.x), lane = tid & 63; (void)tid;
    bf16_t* H = (bf16_t*)(F.ws + WS_H);
    const bf16_t* Y = (const bf16_t*)((const unsigned char*)F.out + OUT_Y);
    const bf16_t* YS = (const bf16_t*)(F.ws + WS_YSLOT);
    unsigned* tokinfo = (unsigned*)(F.ws + WS_ROUTE);
    int* list = (int*)(F.ws + WS_ROUTE + (size_t)MG * 32);
    float* wlist = (float*)(F.ws + WS_ROUTE + (size_t)MG * 32 + (size_t)8 * MG * 4);
    LAS float* wrt = (LAS float*)F.lds;
    int rbase[8];
    if (MODE == 1) {
        for (int i = tid; i < 8 * D; i += 512) { const int c = i >> 3, e = i & 7; wrt[e * D + c] = router[i]; }
        __syncthreads();
    }
    if (MODE == 3) { int r = 0;
#pragma unroll
        for (int e = 0; e < 8; ++e) { int c = (int)__builtin_amdgcn_readfirstlane(cntw[e]); c = c > MG ? MG : c; rbase[e] = r; r += ((c + 255) >> 8) * 256; } }
    for (int row = opaque_s(F.gw); row < MG; row += F.NGW) {
        float v[16];
        if (MODE == 3) {
            const u32x4 ti = *(const u32x4*)(tokinfo + (size_t)row * 8);
            int s1 = 0, s2 = 0;
#pragma unroll
            for (int e = 0; e < 8; ++e) { if ((int)ti.x == e) s1 = rbase[e] + (int)ti.y; if ((int)ti.z == e) s2 = rbase[e] + (int)ti.w; }
#pragma unroll
            for (int hh = 0; hh < 2; ++hh) { const int c0 = hh * 512 + lane * 8;
                const u32x4 hv = *(const u32x4*)(H + (size_t)row * D + c0), y1 = *(const u32x4*)(YS + (size_t)s1 * D + c0), y2 = *(const u32x4*)(YS + (size_t)s2 * D + c0);
                float h8[8], a8[8], b8[8]; unpack8(hv, h8); unpack8(y1, a8); unpack8(y2, b8);
#pragma unroll
                for (int j = 0; j < 8; ++j) v[hh * 8 + j] = ALPHA * h8[j] + (a8[j] + b8[j]); }
        } else {
#pragma unroll
            for (int hh = 0; hh < 2; ++hh) { const u32x4 yv = *(const u32x4*)(Y + (size_t)row * D + hh * 512 + lane * 8); float y8[8]; unpack8(yv, y8);
#pragma unroll
                for (int j = 0; j < 8; ++j) v[hh * 8 + j] = y8[j]; }
        }
        float s = 0.f;
#pragma unroll
        for (int j = 0; j < 16; ++j) s += v[j];
        const float mean = wave_sum(s) * (1.f / D); float s2 = 0.f;
#pragma unroll
        for (int j = 0; j < 16; ++j) { v[j] -= mean; s2 += v[j] * v[j]; }
        const float rstd = 1.f / sqrtf(wave_sum(s2) * (1.f / D) + 1e-5f);
#pragma unroll
        for (int hh = 0; hh < 2; ++hh) { const int c0 = hh * 512 + lane * 8;
#pragma unroll
            for (int q = 0; q < 2; ++q) { const f32x4 gg = *(const f32x4*)(gam + c0 + 4 * q), bb = *(const f32x4*)(bet + c0 + 4 * q);
#pragma unroll
                for (int j = 0; j < 4; ++j) v[hh * 8 + q * 4 + j] = v[hh * 8 + q * 4 + j] * rstd * gg[j] + bb[j]; } }
#pragma unroll
        for (int hh = 0; hh < 2; ++hh) { u32x4 w; w.x = cvt_pk_bf16(v[hh * 8 + 0], v[hh * 8 + 1]); w.y = cvt_pk_bf16(v[hh * 8 + 2], v[hh * 8 + 3]); w.z = cvt_pk_bf16(v[hh * 8 + 4], v[hh * 8 + 5]); w.w = cvt_pk_bf16(v[hh * 8 + 6], v[hh * 8 + 7]);
            *(u32x4*)(H + (size_t)row * D + hh * 512 + lane * 8) = w; }
        if (FINAL) {
            const int bl = row / TP, r = row % TP;
            if (r >= FRAME0) { float* op = F.out + ((size_t)(g * GB + bl) * SEQ + (r - FRAME0)) * D;
#pragma unroll
                for (int hh = 0; hh < 2; ++hh)
#pragma unroll
                    for (int q = 0; q < 2; ++q) *(f32x4*)(op + hh * 512 + lane * 8 + 4 * q) = (f32x4){v[hh * 8 + q * 4], v[hh * 8 + q * 4 + 1], v[hh * 8 + q * 4 + 2], v[hh * 8 + q * 4 + 3]}; }
        }
        if (MODE == 1) {
            float lg[8];
#pragma unroll
            for (int e = 0; e < 8; ++e) { float acc = 0.f;
#pragma unroll
                for (int hh = 0; hh < 2; ++hh) { const LAS f32x4* wp = (const LAS f32x4*)(wrt + e * D + hh * 512 + lane * 8); const f32x4 w0 = wp[0], w1 = wp[1];
#pragma unroll
                    for (int j = 0; j < 4; ++j) acc += v[hh * 8 + j] * w0[j] + v[hh * 8 + 4 + j] * w1[j]; }
                lg[e] = wave_sum(acc); }
            int e1 = 0; float l1 = lg[0];
#pragma unroll
            for (int e = 1; e < 8; ++e) if (lg[e] > l1) { l1 = lg[e]; e1 = e; }
            int e2 = -1; float l2 = -INFINITY;
#pragma unroll
            for (int e = 0; e < 8; ++e) if (e != e1 && lg[e] > l2) { l2 = lg[e]; e2 = e; }
            const float w2 = rcpf_(1.0f + ex2(LOG2E * (l1 - l2))), w1 = 1.0f - w2;
            if (lane == 0) {
                if (PROBE_DUP == 14) { atomicAdd(cntw + 16 + e1, 1u); atomicAdd(cntw + 16 + e2, 1u); }
                const unsigned p1 = atomicAdd(cntw + e1, 1u), p2 = atomicAdd(cntw + e2, 1u);
                *(u32x4*)(tokinfo + (size_t)row * 8) = (u32x4){(unsigned)e1, p1, (unsigned)e2, p2};
                if (p1 < (unsigned)MG) { list[(size_t)e1 * MG + p1] = row; wlist[(size_t)e1 * MG + p1] = w1; }
                if (p2 < (unsigned)MG) { list[(size_t)e2 * MG + p2] = row; wlist[(size_t)e2 * MG + p2] = w2; }
            }
        }
    }
}

constexpr int NSC = 16;
constexpr int LRU_WAVE_LDS = 14336;
template <bool PASS2>
DI void lru_phase(Ctx& F, const Args& a, int l, bool dummy = false) {
    const int lane = opaque(threadIdx.x) & 63, r32 = lane & 31, hi = lane >> 5;
    bf16_t* Z = (bf16_t*)(F.ws + WS_Z);
    const bf16_t* WrT = (const bf16_t*)(F.ws + WS_WR) + (size_t)l * 16 * 4096;
    const bf16_t* WiT = (const bf16_t*)(F.ws + WS_WI) + (size_t)l * 16 * 4096;
    float* aggA = (float*)(F.ws + WS_AGG); float* aggH = aggA + (size_t)GB * NSC * D;
    const float* spt = (const float*)(F.ws + WS_TAB) + l * D;
    const float* cw = a.in[8] + (size_t)l * 4 * D; const float* cbv = a.in[9] + (size_t)l * D;
    const float* brv = a.in[11] + (size_t)l * D; const float* biv = a.in[13] + (size_t)l * D;
    LAS bf16_t* xraw = (LAS bf16_t*)(F.lds + F.wave * LRU_WAVE_LDS);
    LAS bf16_t* xcb = xraw + 2560;
    LAS bf16_t* gbf = xcb + 2304;
    for (int unit = opaque_s(F.gw); unit < GB * 16 * NSC; unit += F.NGW) {
        const int head = unit & 15, sc = (unit >> 4) & 15, bl = unit >> 8;
        const int t0 = sc < 2 ? 9 * sc : 18 + 8 * (sc - 2), ntile = sc < 2 ? 9 : 8;
        const size_t rowb = (size_t)bl * TP;
        bf16x8 wrf[2][4], wif[2][4];
#pragma unroll
        for (int ct = 0; ct < 2; ++ct)
#pragma unroll
            for (int ks = 0; ks < 4; ++ks) { const size_t o = (size_t)(head * 64 + ct * 32 + r32) * 64 + ks * 16 + hi * 8; wrf[ct][ks] = *(const bf16x8*)(WrT + o); wif[ct][ks] = *(const bf16x8*)(WiT + o); }
        float c0[2], c1[2], c2[2], c3[2], cb[2], br[2], bi[2], sp8[2], hst[2], apr[2];
#pragma unroll
        for (int ct = 0; ct < 2; ++ct) { const int ch = head * 64 + ct * 32 + r32;
            c0[ct] = cw[ch]; c1[ct] = cw[D + ch]; c2[ct] = cw[2 * D + ch]; c3[ct] = cw[3 * D + ch]; cb[ct] = cbv[ch]; br[ct] = brv[ch]; bi[ct] = biv[ch]; sp8[ct] = -8.0f * LOG2E * spt[ch];
            hst[ct] = 0.f; apr[ct] = 1.f; }
        if (PASS2) {
#pragma unroll
            for (int kb = 0; kb < 2; ++kb) { float fa[2][8], fh[2][8];
#pragma unroll
                for (int k = 0; k < 8; ++k)
#pragma unroll
                    for (int ct = 0; ct < 2; ++ct) { const int kk = kb * 8 + k; const bool on = kk < sc; const size_t o = ((size_t)bl * NSC + (on ? kk : 0)) * D + head * 64 + ct * 32 + r32;
                        const float av = aggA[o], hv = aggH[o]; fa[ct][k] = on ? av : 1.0f; fh[ct][k] = on ? hv : 0.f; }
#pragma unroll
                for (int k = 0; k < 8; ++k)
#pragma unroll
                    for (int ct = 0; ct < 2; ++ct) hst[ct] = fa[ct][k] * hst[ct] + fh[ct][k]; }
        }
        u32x4 px[5], pg[4];
#define LRU_LOAD(tile) do { const int _r0 = (tile) * 32; \
            _Pragma("unroll") for (int k = 0; k < 5; ++k) { const int p = lane + 64 * k; const int j = p >> 3, c8 = p & 7; const int rr = _r0 - 3 + j; const int rc = rr < 0 ? 0 : rr; \
                u32x4 v = (u32x4){0u, 0u, 0u, 0u}; if (p < 280) v = *(const u32x4*)(Z + (rowb + rc) * LDZ + ZXR + head * 64 + c8 * 8); if (rr < PADR) v = (u32x4){0u, 0u, 0u, 0u}; px[k] = v; } \
            if (PASS2) { _Pragma("unroll") for (int k = 0; k < 4; ++k) { const int p = lane + 64 * k; pg[k] = *(const u32x4*)(Z + (rowb + _r0 + (p >> 3)) * LDZ + ZGR + head * 64 + (p & 7) * 8); } } } while (0)
        LRU_LOAD(t0);
        for (int ti = 0; ti < ntile; ++ti) {
            const int r0 = (t0 + ti) * 32;
#pragma unroll
            for (int k = 0; k < 5; ++k) { const int p = lane + 64 * k; if (p < 280) *(LAS u32x4*)(xraw + (p >> 3) * 72 + (p & 7) * 8) = px[k]; }
            if (PASS2) {
#pragma unroll
                for (int k = 0; k < 4; ++k) { const int p = lane + 64 * k; *(LAS u32x4*)(gbf + (p >> 3) * 72 + (p & 7) * 8) = pg[k]; } }
            if (ti + 1 < ntile) LRU_LOAD(t0 + ti + 1);
            f32x16 xc[2];
#pragma unroll
            for (int ct = 0; ct < 2; ++ct) {
#pragma unroll
                for (int sg = 0; sg < 4; ++sg) { float xw[7];
#pragma unroll
                    for (int d = 0; d < 7; ++d) xw[d] = bf2f(xraw[(8 * sg + 4 * hi + d) * 72 + ct * 32 + r32]);
#pragma unroll
                    for (int q = 0; q < 4; ++q) xc[ct][4 * sg + q] = cb[ct] + c0[ct] * xw[q] + c1[ct] * xw[q + 1] + c2[ct] * xw[q + 2] + c3[ct] * xw[q + 3]; } }
#pragma unroll
            for (int ct = 0; ct < 2; ++ct)
#pragma unroll
                for (int r = 0; r < 16; ++r) xcb[crow(r, hi) * 72 + ct * 32 + r32] = f2bf(xc[ct][r]);
            bf16x8 af[4];
#pragma unroll
            for (int ks = 0; ks < 4; ++ks) af[ks] = *(const LAS bf16x8*)(xcb + r32 * 72 + ks * 16 + hi * 8);
#pragma unroll
            for (int ct = 0; ct < 2; ++ct) {
                f32x16 grx, gix;
#pragma unroll
                for (int r = 0; r < 16; ++r) { grx[r] = 0.f; gix[r] = 0.f; }
#pragma unroll
                for (int ks = 0; ks < 4; ++ks) { grx = __builtin_amdgcn_mfma_f32_32x32x16_bf16(af[ks], wrf[ct][ks], grx, 0, 0, 0); gix = __builtin_amdgcn_mfma_f32_32x32x16_bf16(af[ks], wif[ct][ks], gix, 0, 0, 0); }
                f32x16 av, uv;
#pragma unroll
                for (int r = 0; r < 16; ++r) { const float rg = sigm(grx[r] + br[ct]), ig = sigm(gix[r] + bi[ct]);
                    const float aa = ex2(sp8[ct] * rg); const float m2 = 1.0f - aa * aa; const float mult = sqrtf(m2 > 0.f ? m2 : 0.f);
                    const bool pad = (r0 + crow(r, hi)) < PADR;
                    av[r] = pad ? 1.0f : aa; uv[r] = pad ? 0.f : mult * ig * xc[ct][r]; }
                float As[4], Us[4];
#pragma unroll
                for (int sg = 0; sg < 4; ++sg) { As[sg] = (av[4 * sg] * av[4 * sg + 1]) * (av[4 * sg + 2] * av[4 * sg + 3]);
                    Us[sg] = ((uv[4 * sg] * av[4 * sg + 1] + uv[4 * sg + 1]) * av[4 * sg + 2] + uv[4 * sg + 2]) * av[4 * sg + 3] + uv[4 * sg + 3]; }
                float h = hst[ct], hs[4];
#pragma unroll
                for (int sg = 0; sg < 4; ++sg) { const float he0 = As[sg] * h + Us[sg]; const float t = __shfl_xor(he0, 32);
                    const float he1 = As[sg] * t + Us[sg]; const float t2 = __shfl_xor(he1, 32);
                    hs[sg] = hi ? t : h; h = hi ? he1 : t2; }
                hst[ct] = h;
                if (!PASS2) { const float own = (As[0] * As[1]) * (As[2] * As[3]); apr[ct] *= own * __shfl_xor(own, 32); }
                else {
#pragma unroll
                    for (int sg = 0; sg < 4; ++sg) { float hh = hs[sg];
#pragma unroll
                        for (int q = 0; q < 4; ++q) { hh = av[4 * sg + q] * hh + uv[4 * sg + q];
                            LAS bf16_t* p = gbf + (8 * sg + 4 * hi + q) * 72 + ct * 32 + r32; *p = f2bf(hh * bf2f(*p)); } }
                }
            }
            if (PASS2) {
#pragma unroll
                for (int k = 0; k < 4; ++k) { const int p = lane + 64 * k; const u32x4 v = *(const LAS u32x4*)(gbf + (p >> 3) * 72 + (p & 7) * 8);
                    bf16_t* dst = dummy ? (bf16_t*)(F.ws + WS_YSLOT) + (rowb + r0 + (p >> 3)) * 1024 + head * 64 + (p & 7) * 8 : Z + (rowb + r0 + (p >> 3)) * LDZ + ZGR + head * 64 + (p & 7) * 8;
                    *(u32x4*)dst = v; } }
        }
#undef LRU_LOAD
        if (!PASS2 && hi == 0) {
#pragma unroll
            for (int ct = 0; ct < 2; ++ct) { const size_t o = ((size_t)bl * NSC + sc) * D + head * 64 + ct * 32 + r32; aggA[o] = apr[ct]; aggH[o] = hst[ct]; } }
    }
}

DI void attn_wave(Ctx& F, const Args& a, int l, int bl, int head, int qb, bool dummy) {
    const int lane = opaque(threadIdx.x) & 63, r32 = lane & 31, hi = lane >> 5;
    bf16_t* Z = (bf16_t*)(F.ws + WS_Z); const bf16_t* VT = (const bf16_t*)(F.ws + WS_VT);
    const float* tab = (const float*)(F.ws + WS_TAB) + DEPTH * D + 2 * l;
    const float lam = tab[0], omli = tab[1];
    const size_t rowq = (size_t)bl * TP + qb * 32 + r32;
    bf16_t* zq = Z + rowq * LDZ + ZQ + head * 64;
    bf16x8 qf[2][2];
#pragma unroll
    for (int m = 0; m < 2; ++m)
#pragma unroll
        for (int s = 0; s < 2; ++s) qf[m][s] = *(const bf16x8*)(zq + m * 32 + s * 16 + hi * 8);
    f32x16 O[2][2];
#pragma unroll
    for (int m = 0; m < 2; ++m)
#pragma unroll
        for (int vh = 0; vh < 2; ++vh)
#pragma unroll
            for (int r = 0; r < 16; ++r) O[m][vh][r] = 0.f;
    float mrun[2] = {-INFINITY, -INFINITY}, lrun[2] = {0.f, 0.f};
    const int ktmax = 2 * (qb >> 1) + 1;
    const int pr = (r32 & ~12) | ((r32 & 4) << 1) | ((r32 & 8) >> 1);
    const bf16_t* kbase = Z + ((size_t)bl * TP + pr) * LDZ + ZK + head * 64 + hi * 8;
    const bf16_t* vbase = VT + (size_t)(head * 64 + r32) * MG + (size_t)bl * TP + hi * 8;
    for (int kt = 1; kt <= ktmax; ++kt) {
        const bf16_t* kp = kbase + (size_t)kt * 32 * LDZ;
        bf16x8 kf[2][2], vf[2][2];
#pragma unroll
        for (int m = 0; m < 2; ++m)
#pragma unroll
            for (int s = 0; s < 2; ++s) kf[m][s] = *(const bf16x8*)(kp + m * 32 + s * 16);
#pragma unroll
        for (int vh = 0; vh < 2; ++vh)
#pragma unroll
            for (int s = 0; s < 2; ++s) vf[vh][s] = *(const bf16x8*)(vbase + (size_t)vh * 32 * MG + kt * 32 + s * 16);
#pragma unroll
        for (int m = 0; m < 2; ++m) {
            f32x16 S;
#pragma unroll
            for (int r = 0; r < 16; ++r) S[r] = 0.f;
            S = __builtin_amdgcn_mfma_f32_32x32x16_bf16(kf[m][0], qf[m][0], S, 0, 0, 0);
            S = __builtin_amdgcn_mfma_f32_32x32x16_bf16(kf[m][1], qf[m][1], S, 0, 0, 0);
            if (kt == 1) {
#pragma unroll
                for (int r = 0; r < 8; ++r) S[r] = -INFINITY; }
            float mx = S[0];
#pragma unroll
            for (int r = 1; r < 16; ++r) mx = fmaxf(mx, S[r]);
            mx = fmaxf(mx, __shfl_xor(mx, 32));
            const float mnew = fmaxf(mrun[m], mx); const float alpha = ex2(mrun[m] - mnew); mrun[m] = mnew;
            float ps = 0.f;
#pragma unroll
            for (int r = 0; r < 16; ++r) { S[r] = ex2(S[r] - mnew); ps += S[r]; }
            lrun[m] = lrun[m] * alpha + ps;
#pragma unroll
            for (int vh = 0; vh < 2; ++vh)
#pragma unroll
                for (int r = 0; r < 16; ++r) O[m][vh][r] *= alpha;
            bf16x8 pf[2];
#pragma unroll
            for (int s = 0; s < 2; ++s) { u32x4 w; w.x = cvt_pk_bf16(S[8 * s], S[8 * s + 1]); w.y = cvt_pk_bf16(S[8 * s + 2], S[8 * s + 3]); w.z = cvt_pk_bf16(S[8 * s + 4], S[8 * s + 5]); w.w = cvt_pk_bf16(S[8 * s + 6], S[8 * s + 7]);
                pf[s] = __builtin_bit_cast(bf16x8, w); }
#pragma unroll
            for (int vh = 0; vh < 2; ++vh)
#pragma unroll
                for (int s = 0; s < 2; ++s) O[m][vh] = __builtin_amdgcn_mfma_f32_32x32x16_bf16(vf[vh][s], pf[s], O[m][vh], 0, 0, 0);
        }
    }
    const float l1 = lrun[0] + __shfl_xor(lrun[0], 32), l2 = lrun[1] + __shfl_xor(lrun[1], 32);
    const float c1 = 1.0f / l1, c2 = lam / l2;
    float ss = 0.f;
#pragma unroll
    for (int vh = 0; vh < 2; ++vh)
#pragma unroll
        for (int r = 0; r < 16; ++r) { const float o = O[0][vh][r] * c1 - O[1][vh][r] * c2; O[0][vh][r] = o; ss += o * o; }
    ss += __shfl_xor(ss, 32);
    const float rms = omli / sqrtf(ss * (1.0f / 64.0f) + 1e-5f);
    const float* sg = a.in[7] + l * 64;
#pragma unroll
    for (int vh = 0; vh < 2; ++vh)
#pragma unroll
        for (int g4 = 0; g4 < 4; ++g4) { const int vd = vh * 32 + 8 * g4 + 4 * hi; const f32x4 gv = *(const f32x4*)(sg + vd);
            u32x2 w; w.x = cvt_pk_bf16(O[0][vh][4 * g4] * rms * gv[0], O[0][vh][4 * g4 + 1] * rms * gv[1]); w.y = cvt_pk_bf16(O[0][vh][4 * g4 + 2] * rms * gv[2], O[0][vh][4 * g4 + 3] * rms * gv[3]);
            bf16_t* zo = dummy ? (bf16_t*)(F.ws + WS_YSLOT) + rowq * 512 + head * 64 : zq;
            *(u32x2*)(zo + vd) = w; }
}
DI void attn_phase(Ctx& F, const Args& a, int l, unsigned* qhead, bool dummy) {
    const int tid = opaque(threadIdx.x);
    for (;;) {
        if (tid == 0) F.MISC[0] = atomicAdd(qhead, 1u);
        __syncthreads();
        const unsigned u = F.MISC[0];
        __syncthreads();
        if (u >= 17u * 64u) break;
        const int j = (int)(u >> 6), bh = (int)(u & 63), qb = NQB - 1 - 8 * j - F.wave;
        if (qb >= 0) attn_wave(F, a, l, bh >> 3, bh & 7, qb, dummy);
    }
}

__global__ void __launch_bounds__(512, 2) fwd_kernel(Args a) {
    extern __shared__ __attribute__((aligned(16))) unsigned char lds_raw[];
    Ctx F;
    F.lds = (LAS unsigned char*)lds_raw; F.MISC = (volatile LAS unsigned*)(F.lds + MISC_OFF);
    F.wave = __builtin_amdgcn_readfirstlane(threadIdx.x >> 6);
    F.G = gridDim.x; F.gw = blockIdx.x * 8 + F.wave; F.NGW = F.G * 8;
    F.ws = a.ws; F.ctl = (unsigned*)(a.ws + WS_CTL); F.out = a.out;
    if (threadIdx.x < 64) F.MISC[threadIdx.x] = 0u;
    __syncthreads();
    XcdBarrier bar = xcd_barrier_post(F.ctl + CW_BAR, F.MISC + 8);
    const char* wsb = (const char*)a.ws;
    bf16_t* Zp = (bf16_t*)(a.ws + WS_Z); bf16_t* Hp = (bf16_t*)(a.ws + WS_H); bf16_t* Yp = (bf16_t*)((unsigned char*)a.out + OUT_Y);
    bf16_t* ACTp = (bf16_t*)(a.ws + WS_ACT);

#ifndef PH_MASK
#define PH_MASK 0xffff
#endif
#define GRIDBAR() do { xcd_barrier(bar); if (PROBE_DUP == 13) xcd_barrier(bar); } while (0)
    if (PROBE_DUP == 12) prologue(F, a);
    if (PH_MASK & 1) prologue(F, a);
#pragma unroll 1
    for (int g = 0; g < NGRP; ++g) {
        if (PH_MASK & 2) ln_in_phase(F, a, g);
        GRIDBAR();
#pragma unroll 1
        for (int l = 0; l < DEPTH; ++l) {
            const int mi = l >> 1;
            { ProbInProj P; P.Abase = wsb; P.G = F.G; P.c = opaque_s(blockIdx.x); P.offW = (unsigned)(WS_WIN + (size_t)l * PROJW * D * 2); P.bg0 = a.in[5] + (size_t)l * 2 * D; P.bg1 = P.bg0 + D; P.Z = Zp; P.VT = (bf16_t*)(a.ws + WS_VT);
              if (PROBE_DUP == 1) g8::gemm_phase(F.lds, P);
              if (PH_MASK & 4) g8::gemm_phase(F.lds, P); }
            GRIDBAR();
            if (PROBE_DUP == 3) lru_phase<false>(F, a, l);
            if (PH_MASK & 8) lru_phase<false>(F, a, l);
            if (PROBE_DUP == 2) attn_phase(F, a, l, F.ctl + CW_Q + 64 * (8 + g * 4 + l), true);
            if (PH_MASK & 16) attn_phase(F, a, l, F.ctl + CW_Q + 64 * (g * 4 + l), false);
            GRIDBAR();
            if (PROBE_DUP == 4) lru_phase<true>(F, a, l, true);
            if (PH_MASK & 32) lru_phase<true>(F, a, l);
            GRIDBAR();
            { ProbMix P; P.Abase = wsb; P.G = F.G; P.c = opaque_s(blockIdx.x); P.offW = (unsigned)(WS_WMIX + (size_t)l * D * 1536 * 2); P.Z = Zp;
              if (PH_MASK & 64) g8::gemm_phase(F.lds, P); }
            GRIDBAR();
            { ProbResid<16, 1024> P; P.Abase = wsb; P.G = F.G; P.c = opaque_s(blockIdx.x); P.offA = (unsigned)(WS_Z + ZGA * 2); P.lda2 = LDZ * 2; P.offW = (unsigned)(WS_WO + (size_t)l * D * D * 2); P.H = Hp; P.Y = Yp;
              if (PROBE_DUP == 6) g8::gemm_phase(F.lds, P);
              if (PH_MASK & 128) g8::gemm_phase(F.lds, P); }
            GRIDBAR();
            const float* g1 = a.in[18] + (size_t)(l * 2) * D; const float* b1 = a.in[19] + (size_t)(l * 2) * D;
            unsigned* cntw = F.ctl + CW_CNT + 64 * (g * 2 + mi);
            if ((l & 1) == 0) {
                if (PROBE_DUP == 7) ln_phase<0, false>(F, a, g, g1, b1, nullptr, nullptr);
                if (PH_MASK & 256) ln_phase<0, false>(F, a, g, g1, b1, nullptr, nullptr);
                GRIDBAR();
                { ProbUpD P; P.Abase = wsb; P.G = F.G; P.c = opaque_s(blockIdx.x); P.offW = (unsigned)(WS_WGUD + (size_t)mi * PROJW * D * 2); P.ACT = ACTp;
                  if (PROBE_DUP == 8) g8::gemm_phase(F.lds, P);
                  if (PH_MASK & 512) g8::gemm_phase(F.lds, P); }
                GRIDBAR();
                { ProbResid<44, 2816> P; P.Abase = wsb; P.G = F.G; P.c = opaque_s(blockIdx.x); P.offA = (unsigned)WS_ACT; P.lda2 = DFF * 2; P.offW = (unsigned)(WS_WDD + (size_t)mi * D * DFF * 2); P.H = Hp; P.Y = Yp;
                  if (PROBE_DUP == 9) g8::gemm_phase(F.lds, P);
                  if (PH_MASK & 1024) g8::gemm_phase(F.lds, P); }
                GRIDBAR();
                if (PH_MASK & 256) ln_phase<0, false>(F, a, g, g1 + D, b1 + D, nullptr, nullptr);
                GRIDBAR();
            } else {
                if (PH_MASK & 2048) ln_phase<1, false>(F, a, g, g1, b1, a.in[23] + (size_t)mi * D * 8, cntw);
                GRIDBAR();
                { ProbUpM P; P.Abase = wsb; P.G = F.G; P.c = opaque_s(blockIdx.x); P.offW = (unsigned)(WS_WGUM + (size_t)mi * 8 * PROJW * D * 2); P.ACT = ACTp;
                  P.list = (const int*)(a.ws + WS_ROUTE + (size_t)MG * 32); P.tab.init(cntw, 22);
                  if (PROBE_DUP == 10) g8::gemm_phase(F.lds, P);
                  if (PH_MASK & 4096) g8::gemm_phase(F.lds, P); }
                GRIDBAR();
                { ProbDownM P; P.Abase = wsb; P.G = F.G; P.c = opaque_s(blockIdx.x); P.offW = (unsigned)(WS_WDM + (size_t)mi * 8 * D * DFF * 2); P.YS = (bf16_t*)(a.ws + WS_YSLOT);
                  P.wlist = (const float*)(a.ws + WS_ROUTE + (size_t)MG * 32 + (size_t)8 * MG * 4); P.tab.init(cntw, 4);
                  if (PROBE_DUP == 11) g8::gemm_phase(F.lds, P);
                  if (PH_MASK & 8192) g8::gemm_phase(F.lds, P); }
                GRIDBAR();
                if (PH_MASK & 16384) { if (l == DEPTH - 1) ln_phase<3, true>(F, a, g, g1 + D, b1 + D, nullptr, cntw);
                else ln_phase<3, false>(F, a, g, g1 + D, b1 + D, nullptr, cntw); }
                GRIDBAR();
            }
        }
    }
}

extern "C" void kernel_launch(void* const* d_in, const int* in_sizes, int n_in, void* d_out, int out_size, void* d_ws, size_t ws_size, hipStream_t stream) {
    static int grid = 0;
    if (grid == 0) {
        if (n_in != 27 || out_size != NBATCH * SEQ * D || ws_size < WS_END) { fprintf(stderr, "kernel_launch: unexpected problem (n_in %d, out %d, ws %zu)\n", n_in, out_size, ws_size); grid = -1; return; }
        int dev = 0, cus = 0;
        if (hipGetDevice(&dev) != hipSuccess || hipDeviceGetAttribute(&cus, hipDeviceAttributeMultiprocessorCount, dev) != hipSuccess) { grid = -1; return; }
        if (hipFuncSetAttribute((const void*)fwd_kernel, hipFuncAttributeMaxDynamicSharedMemorySize, LDS_BYTES) != hipSuccess) { fprintf(stderr, "kernel_launch: hipFuncSetAttribute failed\n"); grid = -1; return; }
        int per_cu = 0;
        if (hipOccupancyMaxActiveBlocksPerMultiprocessor(&per_cu, (const void*)fwd_kernel, 512, LDS_BYTES) != hipSuccess || per_cu < 1) fprintf(stderr, "kernel_launch: occupancy query says %d\n", per_cu);
        (void)hipGetLastError();
        grid = cus;
    }
    if (grid < 0) return;
    (void)hipMemsetAsync((char*)d_ws + WS_CTL, 0, CTL_BYTES, stream);
    Args a{};
    for (int i = 0; i < 27; ++i) a.in[i] = (const float*)d_in[i];
    a.out = (float*)d_out; a.ws = (unsigned char*)d_ws;
    hipLaunchKernelGGL(fwd_kernel, dim3(grid), dim3(512), LDS_BYTES, stream, a);
}
```

```cpp
#include <hip/hip_runtime.h>
#include <cstdio>
#include <cstdint>

#ifndef PROBE_DUP
#define PROBE_DUP 0
#endif
#define DI __device__ __forceinline__
#define LAS __attribute__((address_space(3)))
typedef unsigned short bf16_t;
typedef short bf16x8 __attribute__((ext_vector_type(8)));
typedef float f32x4 __attribute__((ext_vector_type(4)));
typedef float f32x16 __attribute__((ext_vector_type(16)));
typedef unsigned u32x4 __attribute__((ext_vector_type(4)));
typedef unsigned u32x2 __attribute__((ext_vector_type(2)));

constexpr int D = 1024, NBATCH = 16, SEQ = 4096, DEPTH = 4;
constexpr int TP = 4160;
constexpr int PADR = 48, FRAME0 = 64;
constexpr int GB = 8, NGRP = NBATCH / GB;
constexpr int MG = GB * TP;
constexpr int NMT = MG / 256;
constexpr int LDZ = 5120;
constexpr int ZQ = 0, ZK = 512, ZXR = 1024, ZGR = 2048, ZGA = 3072, ZGL = 4096;
constexpr int DFF = 2816, NEXP = 8, PROJW = 5632;
constexpr int NCHUNK = TP / 64;
constexpr int NQB = TP / 32;
constexpr float ALPHA = 1.681792830507429f;
constexpr float LOG2E = 1.4426950408889634f;
constexpr float QSCALE = 0.17677669529663687f * LOG2E;
constexpr int SLOT_ROWS = 2 * MG + 8 * 256;

constexpr size_t MiB = 1u << 20;
constexpr size_t WS_CTL = 0, CTL_BYTES = 1 * MiB;
constexpr size_t WS_TAB = 1 * MiB;
constexpr size_t WS_WIN = 2 * MiB;
constexpr size_t WS_WMIX = 46 * MiB;
constexpr size_t WS_WO = 58 * MiB;
constexpr size_t WS_WR = 66 * MiB;
constexpr size_t WS_WI = 66 * MiB + 512 * 1024;
constexpr size_t WS_WGUD = 67 * MiB;
constexpr size_t WS_WDD = 89 * MiB;
constexpr size_t WS_WGUM = 100 * MiB;
constexpr size_t WS_WDM = 276 * MiB;
constexpr size_t WS_H = 364 * MiB;
constexpr size_t WS_AGG = 429 * MiB;
constexpr size_t WS_ROUTE = 434 * MiB;
constexpr size_t WS_YSLOT = 438 * MiB;
constexpr size_t WS_Z = 572 * MiB;
constexpr size_t WS_VT = 897 * MiB;
constexpr size_t WS_ACT = WS_Z;
constexpr size_t WS_END = 941 * MiB;
constexpr size_t OUT_Y = 128 * MiB;
static_assert(WS_WIN + (size_t)DEPTH * PROJW * D * 2 <= WS_WMIX, "map");
static_assert(WS_WMIX + (size_t)DEPTH * D * 1536 * 2 <= WS_WO, "map");
static_assert(WS_WGUD + (size_t)2 * PROJW * D * 2 <= WS_WDD && WS_WDD + (size_t)2 * D * DFF * 2 <= WS_WGUM, "map");
static_assert(WS_WGUM + (size_t)16 * PROJW * D * 2 <= WS_WDM && WS_WDM + (size_t)16 * D * DFF * 2 <= WS_H, "map");
static_assert(WS_H + (size_t)MG * D * 2 <= WS_AGG && WS_AGG + (size_t)2 * GB * NCHUNK * D * 4 <= WS_ROUTE, "map");
static_assert(WS_ROUTE + (size_t)MG * 32 + (size_t)2 * 8 * MG * 4 <= WS_YSLOT && WS_YSLOT + (size_t)SLOT_ROWS * D * 2 <= WS_Z, "map");
static_assert(WS_Z + (size_t)MG * LDZ * 2 <= WS_VT && WS_VT + (size_t)512 * MG * 2 <= WS_END && WS_ACT + (size_t)SLOT_ROWS * DFF * 2 <= WS_END, "map");

constexpr int CW_BAR = 4096;
constexpr int CW_Q = 8192;
constexpr int CW_CNT = 12288;

constexpr int LDS_STAGE = 131072;
constexpr int MISC_OFF = LDS_STAGE;
constexpr int LDS_BYTES = LDS_STAGE + 1024;

DI float bf_lo(unsigned w) { return __uint_as_float(w << 16); }
DI float bf_hi(unsigned w) { return __uint_as_float(w & 0xffff0000u); }
DI float bf2f(bf16_t b) { return __uint_as_float((unsigned)b << 16); }
DI unsigned cvt_pk_bf16(float lo, float hi) { unsigned r; asm volatile("v_cvt_pk_bf16_f32 %0, %1, %2" : "=v"(r) : "v"(lo), "v"(hi)); return r; }
DI bf16_t f2bf(float f) { return (bf16_t)(cvt_pk_bf16(f, 0.f) & 0xffffu); }
DI float ex2(float x) { return __builtin_amdgcn_exp2f(x); }
DI float rcpf_(float x) { return __builtin_amdgcn_rcpf(x); }
DI float sigm(float x) { return rcpf_(1.0f + ex2(-LOG2E * x)); }
DI float silu_(float x) { return x * sigm(x); }
DI float gelu_tanh(float x) { const float u = 0.7978845608028654f * (x + 0.044715f * x * x * x); return x * sigm(2.0f * u); }
DI int opaque(int x) { asm volatile("" : "+v"(x)); return x; }
DI int opaque_s(int x) { asm volatile("" : "+s"(x)); return x; }
DI float wave_sum(float v) {
#pragma unroll
    for (int o = 1; o < 64; o <<= 1) v += __shfl_xor(v, o);
    return v;
}
DI void unpack8(const u32x4 w, float (&f)[8]) { f[0] = bf_lo(w.x); f[1] = bf_hi(w.x); f[2] = bf_lo(w.y); f[3] = bf_hi(w.y); f[4] = bf_lo(w.z); f[5] = bf_hi(w.z); f[6] = bf_lo(w.w); f[7] = bf_hi(w.w); }
DI u32x4 pack8(const f32x4 a, const f32x4 b) { u32x4 w; w.x = cvt_pk_bf16(a[0], a[1]); w.y = cvt_pk_bf16(a[2], a[3]); w.z = cvt_pk_bf16(b[0], b[1]); w.w = cvt_pk_bf16(b[2], b[3]); return w; }

#define XB_TMO      128
#define XB_XCNT(j)  (256  + 64 * (j))
#define XB_XSUB(j)  (1280 + 64 * (j))
#define XB_XGEN(j)  (2304 + 64 * (j))
#define XB_TOP      3328
#define XB_TOPGEN   3392
#define XCD_BAR_WORDS 3456
#define XB_SPIN_CAP (1u << 18)
DI unsigned xb_ld(unsigned* p)              { return __hip_atomic_load(p, __ATOMIC_RELAXED, __HIP_MEMORY_SCOPE_AGENT); }
DI unsigned xb_add(unsigned* p, unsigned v) { return __hip_atomic_fetch_add(p, v, __ATOMIC_RELAXED, __HIP_MEMORY_SCOPE_AGENT); }
DI unsigned xb_xcc_id() { return (unsigned)__builtin_amdgcn_s_getreg((3 << 11) | 20) & 0xFu; }
#define XB_SPIN(cond, bar) do { unsigned _sp = 0; while (cond) { __builtin_amdgcn_s_sleep(1); \
    if ((++_sp & 255u) == 0u) { if (xb_ld(&(bar)[XB_TMO])) break; if (_sp > XB_SPIN_CAP) { atomicAdd(&(bar)[XB_TMO], 1u); break; } } } } while (0)
struct XcdBarrier { unsigned* bar; unsigned x; volatile LAS unsigned* st; };
DI XcdBarrier xcd_barrier_post(unsigned* bar, volatile LAS unsigned* st) {
    XcdBarrier b; b.bar = bar; b.x = xb_xcc_id(); b.st = st;
    if (threadIdx.x == 0) (void)xb_add(&bar[XB_XCNT(b.x)], 1u);
    return b;
}
DI void xcd_barrier_complete(unsigned* bar, unsigned x, unsigned& nloc, unsigned& nx) {
    const unsigned G = gridDim.x * gridDim.y * gridDim.z;
    unsigned sum, cnt, mine, sp = 0u;
    for (;;) {
        sum = 0u; cnt = 0u; mine = 0u;
#pragma unroll
        for (unsigned j = 0; j < 16; ++j) { const unsigned c = xb_ld(&bar[XB_XCNT(j)]); sum += c; cnt += (c > 0u) ? 1u : 0u; mine = (j == x) ? c : mine; }
        if (sum == G) break;
        __builtin_amdgcn_s_sleep(1);
        if ((++sp & 255u) == 0u) { if (xb_ld(&bar[XB_TMO])) break; if (sp > XB_SPIN_CAP) { atomicAdd(&bar[XB_TMO], 1u); break; } }
    }
    nloc = mine > 0u ? mine : 1u; nx = cnt > 0u ? cnt : 1u;
}
DI void xcd_barrier(const XcdBarrier& b) {
    asm volatile("s_waitcnt vmcnt(0)" ::: "memory");
    __syncthreads();
    if (threadIdx.x == 0) {
        unsigned* bar = b.bar;
        __builtin_amdgcn_s_waitcnt(0);
        unsigned nloc = b.st[0], nx = b.st[1];
        if (nloc == 0u) { xcd_barrier_complete(bar, b.x, nloc, nx); b.st[0] = nloc; b.st[1] = nx; }
        const unsigned old = xb_add(&bar[XB_XSUB(b.x)], 1u);
        const unsigned gen = old / nloc;
        if (old + 1u == (gen + 1u) * nloc) {
            __builtin_amdgcn_fence(__ATOMIC_RELEASE, "agent");
            asm volatile("s_waitcnt vmcnt(0)" ::: "memory");
            const unsigned og = xb_add(&bar[XB_TOP], 1u);
            const unsigned tg = og / nx;
            if (og + 1u == (tg + 1u) * nx) xb_add(&bar[XB_TOPGEN], 1u);
            else XB_SPIN(xb_ld(&bar[XB_TOPGEN]) == tg, bar);
            __builtin_amdgcn_fence(__ATOMIC_ACQUIRE, "agent");
            xb_add(&bar[XB_XGEN(b.x)], 1u);
            asm volatile("s_waitcnt vmcnt(0)" ::: "memory");
        } else {
            XB_SPIN(xb_ld(&bar[XB_XGEN(b.x)]) == gen, bar);
            __builtin_amdgcn_fence(__ATOMIC_ACQUIRE, "agent");
            asm volatile("s_waitcnt vmcnt(0)" ::: "memory");
        }
    }
    __syncthreads();
}

namespace g8 {
constexpr int BM = 256, BK = 64, HALF = 128, HTB = HALF * BK * 2, STAGE_BYTES = 8 * HTB, NXCD = 8, WGM = 8;
static_assert(STAGE_BYTES == LDS_STAGE, "stage");
__host__ __device__ __forceinline__ int lds_byte(int r, int c) { const int st = (r >> 4) * 2 + (c >> 5), rr = r & 15, cc = c & 31, ob = rr * 64 + cc * 2; return st * 1024 + (ob ^ (((ob >> 9) & 1) << 5)); }
__host__ __device__ __forceinline__ void stage_rc(int b, int& R, int& C) { const int st = b / 1024, sb = b % 1024, swz = sb ^ (((sb >> 9) & 1) << 5); R = (st >> 1) * 16 + swz / 64; C = (st & 1) * 32 + (swz % 64) / 2; }
__host__ __device__ __forceinline__ int perm32(int rho) { const int n = rho >> 4, i = rho & 15; return 8 * (i >> 2) + 4 * n + (i & 3); }
struct Unit { int pm, pn, aux, x0, x1; };
DI int static_map(int L, int nM, int nN) {
    const int nwg = nM * nN; int wgid = L;
    { const int q = nwg / NXCD, r = nwg % NXCD, xcd = wgid % NXCD, off = wgid / NXCD; wgid = (xcd < r ? xcd * (q + 1) : r * (q + 1) + (xcd - r) * q) + off; }
    const int nig = WGM * nN, gid = wgid / nig, fm = gid * WGM, gsz = (nM - fm) < WGM ? (nM - fm) : WGM;
    return (fm + ((wgid % nig) % gsz)) | (((wgid % nig) / gsz) << 16);
}
typedef f32x4 Acc[2][2][4][2];

template <class P>
DI void gemm_phase(LAS unsigned char* lds, const P& prob) {
    const int tid = opaque(threadIdx.x), wid = __builtin_amdgcn_readfirstlane(tid >> 6), lane = tid & 63, wr = wid >> 2, wc = wid & 3, fr = lane & 15, fq = lane >> 4;
    int R[2], C[2]; unsigned voffB[2], voffA[2];
#pragma unroll
    for (int i = 0; i < 2; ++i) { stage_rc(tid * 16 + i * 8192, R[i], C[i]); const int Rb = P::PERM ? ((R[i] & ~31) + perm32(R[i] & 31)) : R[i]; voffB[i] = (unsigned)(Rb * P::LDB + C[i]) * 2u;
        voffA[i] = (unsigned)R[i] * prob.ldaB() + (unsigned)C[i] * 2u; }
    constexpr unsigned hstepB = (unsigned)HALF * P::LDB * 2u;
    const unsigned hstepA = (unsigned)HALF * prob.ldaB();
    const unsigned ldsw = (unsigned)wid * 1024u;
    const int aoff = lds_byte(wr * 64 + fr, fq * 8), boff = lds_byte(wc * 32 + fr, fq * 8);
#define G8_SA(b, h) (((b) * 2 + (h)) * HTB)
#define G8_SB(b, h) ((4 + (b) * 2 + (h)) * HTB)
#define G8_STAGE_B(bufoff, gbase) do { _Pragma("unroll") for (int _i = 0; _i < 2; ++_i) \
        __builtin_amdgcn_global_load_lds((const unsigned*)((const char*)(gbase) + voffB[_i]), (LAS unsigned*)(lds + (bufoff) + ldsw + _i * 8192), 16, 0, 0); } while (0)
#define G8_STAGE_A(bufoff, h, ub, gv, koff) do { if constexpr (P::GATHER) { const char* _kb = Ab + (koff); _Pragma("unroll") for (int _i = 0; _i < 2; ++_i) \
            __builtin_amdgcn_global_load_lds((const unsigned*)(_kb + (gv)[h][_i]), (LAS unsigned*)(lds + (bufoff) + ldsw + _i * 8192), 16, 0, 0); } \
        else { const char* _kb = Ab + ((ub) + (h) * hstepA + (koff)); _Pragma("unroll") for (int _i = 0; _i < 2; ++_i) \
            __builtin_amdgcn_global_load_lds((const unsigned*)(_kb + voffA[_i]), (LAS unsigned*)(lds + (bufoff) + ldsw + _i * 8192), 16, 0, 0); } } while (0)
#define G8_LDA(dst, b, h) do { _Pragma("unroll") for (int m = 0; m < 4; ++m) _Pragma("unroll") for (int k = 0; k < 2; ++k) dst[m][k] = *(const LAS bf16x8*)(lds + G8_SA(b, h) + aoff + m * 2048 + k * 1024); } while (0)
#define G8_LDB(dst, b, h) do { _Pragma("unroll") for (int n = 0; n < 2; ++n) _Pragma("unroll") for (int k = 0; k < 2; ++k) dst[n][k] = *(const LAS bf16x8*)(lds + G8_SB(b, h) + boff + n * 2048 + k * 1024); } while (0)
#define G8_MMA(ai, bj, At, Bt) do { __builtin_amdgcn_s_setprio(1); _Pragma("unroll") for (int m = 0; m < 4; ++m) _Pragma("unroll") for (int n = 0; n < 2; ++n) _Pragma("unroll") for (int k = 0; k < 2; ++k) \
        acc[ai][bj][m][n] = __builtin_amdgcn_mfma_f32_16x16x32_bf16(Bt[n][k], At[m][k], acc[ai][bj][m][n], 0, 0, 0); __builtin_amdgcn_s_setprio(0); } while (0)
#define G8_WAIT_V(n) asm volatile("s_waitcnt vmcnt(" #n ")" ::: "memory")
#define G8_WAIT_L(n) asm volatile("s_waitcnt lgkmcnt(" #n ")" ::: "memory")
#define G8_BAR __builtin_amdgcn_s_barrier()
#define G8_SCHED __builtin_amdgcn_sched_barrier(0)
    Unit cur, nxt; int ui = 0;
    if (!prob.next(0, cur)) return;
    Acc acc;
#pragma unroll
    for (int a = 0; a < 2; ++a)
#pragma unroll
        for (int b = 0; b < 2; ++b)
#pragma unroll
            for (int m = 0; m < 4; ++m)
#pragma unroll
                for (int n = 0; n < 2; ++n) acc[a][b][m][n] = (f32x4){0.f, 0.f, 0.f, 0.f};
    bf16x8 At[4][2], B0[2][2], B1[2][2];
    unsigned gvA[2][2], gvN[2][2];
    unsigned cU = 0, nU = 0;
    if constexpr (P::GATHER) prob.a_gather(cur, R, C, gvA); else cU = prob.a_unit(cur);
    const char* const Ab = prob.Abase;
    const char* cB = prob.b_ptr(cur);
    G8_STAGE_B(G8_SB(0, 0), cB); G8_STAGE_B(G8_SB(0, 1), cB + hstepB); G8_STAGE_A(G8_SA(0, 0), 0, cU, gvA, prob.koffA(cur, 0)); G8_STAGE_A(G8_SA(0, 1), 1, cU, gvA, prob.koffA(cur, 0));
    if (wr == 1) G8_BAR;
    G8_WAIT_V(2); G8_BAR;
    G8_STAGE_B(G8_SB(1, 0), cB + 128); G8_STAGE_A(G8_SA(1, 0), 0, cU, gvA, prob.koffA(cur, 1)); G8_STAGE_B(G8_SB(1, 1), cB + hstepB + 128);
    G8_WAIT_V(6); G8_BAR;
    for (;;) {
        const bool has_next = prob.next(ui + 1, nxt);
        if (!has_next) nxt = cur;
        if constexpr (P::GATHER) { if (has_next) prob.a_gather(nxt, R, C, gvN); else {
#pragma unroll
            for (int h = 0; h < 2; ++h)
#pragma unroll
                for (int i = 0; i < 2; ++i) gvN[h][i] = gvA[h][i]; } }
        else nU = has_next ? prob.a_unit(nxt) : cU;
        const char* nB = has_next ? prob.b_ptr(nxt) : cB;
        const int nt = prob.nt(cur);
        for (int t = 0; t < nt; t += 2) {
            const bool last = (t == nt - 2);
            const unsigned k1 = prob.koffA(cur, t + 1), k2 = last ? prob.koffA(nxt, 0) : prob.koffA(cur, t + 2), k3 = last ? prob.koffA(nxt, 1) : prob.koffA(cur, t + 3);
            unsigned v2[2][2]; unsigned u2 = 0;
            if constexpr (P::GATHER) {
#pragma unroll
                for (int h = 0; h < 2; ++h)
#pragma unroll
                    for (int i = 0; i < 2; ++i) v2[h][i] = last ? gvN[h][i] : gvA[h][i];
            } else u2 = last ? nU : cU;
            const char* b2 = last ? nB : cB + (size_t)(t + 2) * 128; const char* b3 = b2 + 128;
            G8_LDB(B0, 0, 0); G8_LDB(B1, 0, 1); G8_SCHED; G8_LDA(At, 0, 0); G8_STAGE_A(G8_SA(1, 1), 1, cU, gvA, k1);
            G8_WAIT_V(8); G8_WAIT_L(0); G8_BAR; G8_MMA(0, 0, At, B0); G8_MMA(0, 1, At, B1); G8_BAR; G8_SCHED;
            G8_LDA(At, 0, 1); G8_STAGE_B(G8_SB(0, 0), b2); G8_STAGE_B(G8_SB(0, 1), b2 + hstepB); G8_STAGE_A(G8_SA(0, 0), 0, u2, v2, k2);
            G8_WAIT_V(8); G8_WAIT_L(0); G8_BAR; G8_MMA(1, 0, At, B0); G8_MMA(1, 1, At, B1); G8_BAR; G8_SCHED;
            G8_LDB(B0, 1, 0); G8_LDB(B1, 1, 1); G8_SCHED; G8_LDA(At, 1, 0); G8_STAGE_A(G8_SA(0, 1), 1, u2, v2, k2);
            G8_WAIT_V(8); G8_WAIT_L(0); G8_BAR; G8_MMA(0, 0, At, B0); G8_MMA(0, 1, At, B1); G8_BAR; G8_SCHED;
            G8_LDA(At, 1, 1); G8_STAGE_B(G8_SB(1, 0), b3); G8_STAGE_B(G8_SB(1, 1), b3 + hstepB); G8_STAGE_A(G8_SA(1, 0), 0, u2, v2, k3);
            G8_WAIT_V(8); G8_WAIT_L(0); G8_BAR; G8_MMA(1, 0, At, B0); G8_MMA(1, 1, At, B1); G8_BAR; G8_SCHED;
        }
        if (wr == 0) G8_BAR;
        prob.epi(acc, cur, wr, wc, fr, fq);
        if (!has_next) break;
        if (!prob.keep(cur)) {
#pragma unroll
            for (int a = 0; a < 2; ++a)
#pragma unroll
                for (int b = 0; b < 2; ++b)
#pragma unroll
                    for (int m = 0; m < 4; ++m)
#pragma unroll
                        for (int n = 0; n < 2; ++n) acc[a][b][m][n] = (f32x4){0.f, 0.f, 0.f, 0.f};
        }
        cur = nxt; cB = nB; cU = nU; ++ui;
        if constexpr (P::GATHER) {
#pragma unroll
            for (int h = 0; h < 2; ++h)
#pragma unroll
                for (int i = 0; i < 2; ++i) gvA[h][i] = gvN[h][i];
        }
        if (wr == 1) G8_BAR;
    }
    G8_WAIT_V(0);
    G8_BAR;
#undef G8_SA
#undef G8_SB
#undef G8_STAGE_A
#undef G8_STAGE_B
#undef G8_LDA
#undef G8_LDB
#undef G8_MMA
#undef G8_WAIT_V
#undef G8_WAIT_L
#undef G8_BAR
#undef G8_SCHED
}
}
using g8::Unit; using g8::Acc;

#define ROW_OF(pm, ai, m) ((pm) * 256 + (ai) * 128 + wr * 64 + (m) * 16 + fr)

struct ProbBase { const char* Abase; int G, c; };

struct ProbInProj : ProbBase {
    static constexpr bool PERM = true; static constexpr int NT = 16, LDB = 1024;
    unsigned offW; const float* bg0; const float* bg1; bf16_t* Z; bf16_t* VT;
    static constexpr int U1 = NMT * 20, U2 = 2 * NMT;
    DI bool next(int i, Unit& u) const {
        const int L = i * G + c; if (L >= U1 + U2) return false;
        const int L2 = L - U1; const bool second = L2 >= 0;
        const int pk = g8::static_map(second ? 0 : L, NMT, 20);
        Unit t; t.aux = second ? 1 : 0; t.pm = second ? L2 / NMT : (pk & 0xffff); t.pn = second ? L2 % NMT : (pk >> 16); t.x0 = 0; t.x1 = 0; u = t; return true;
    }
    static constexpr bool GATHER = false;
    DI unsigned ldaB() const { return 2048u; }
    DI unsigned a_unit(const Unit& u) const { return (u.aux ? offW + 5120u * 2048u : (unsigned)WS_H) + (unsigned)u.pm * (256u * 2048u); }
    DI unsigned koffA(const Unit&, int t) const { return (unsigned)t * 128u; }
    DI int nt(const Unit&) const { return NT; }
    DI bool keep(const Unit&) const { return false; }
    DI const char* b_ptr(const Unit& u) const { return Abase + (u.aux ? (size_t)WS_H : (size_t)offW) + (size_t)u.pn * 256 * 2048; }
    DI void epi(Acc& acc, const Unit& u, int wr, int wc, int fr, int fq) const {
        if (u.aux == 0) {
            const int colt = u.pn * 256;
            const int kind = colt < ZGR ? 0 : (colt < ZGA ? 1 : (colt < ZGL ? 2 : 3));
            f32x4 bv[2][2];
#pragma unroll
            for (int bj = 0; bj < 2; ++bj)
#pragma unroll
                for (int n = 0; n < 2; ++n) bv[bj][n] = (f32x4){0.f, 0.f, 0.f, 0.f};
            if (kind >= 2) { const float* bp = (kind == 2 ? bg0 + (colt - ZGA) : bg1 + (colt - ZGL)) + wc * 32 + 8 * fq;
#pragma unroll
                for (int bj = 0; bj < 2; ++bj)
#pragma unroll
                    for (int n = 0; n < 2; ++n) bv[bj][n] = *(const f32x4*)(bp + bj * 128 + 4 * n); }
#pragma unroll
            for (int ai = 0; ai < 2; ++ai)
#pragma unroll
                for (int m = 0; m < 4; ++m) { bf16_t* rowp = Z + (size_t)ROW_OF(u.pm, ai, m) * LDZ + colt + wc * 32 + 8 * fq;
#pragma unroll
                    for (int bj = 0; bj < 2; ++bj) { f32x4 v0 = acc[ai][bj][m][0] + bv[bj][0], v1 = acc[ai][bj][m][1] + bv[bj][1];
                        if (kind == 1) {
#pragma unroll
                            for (int j = 0; j < 4; ++j) { v0[j] = gelu_tanh(v0[j]); v1[j] = gelu_tanh(v1[j]); } }
                        else if (kind >= 2) {
#pragma unroll
                            for (int j = 0; j < 4; ++j) { v0[j] = sigm(v0[j]); v1[j] = sigm(v1[j]); } }
                        *(u32x4*)(rowp + bj * 128) = pack8(v0, v1); } }
        } else {
#pragma unroll
            for (int ai = 0; ai < 2; ++ai)
#pragma unroll
                for (int m = 0; m < 4; ++m) { bf16_t* rowp = VT + (size_t)ROW_OF(u.pm, ai, m) * MG + u.pn * 256 + wc * 32 + 8 * fq;
#pragma unroll
                    for (int bj = 0; bj < 2; ++bj) *(u32x4*)(rowp + bj * 128) = pack8(acc[ai][bj][m][0], acc[ai][bj][m][1]); }
        }
    }
};

struct ProbMix : ProbBase {
    static constexpr bool PERM = true; static constexpr int LDB = 1536;
    unsigned offW; bf16_t* Z;
    DI bool next(int i, Unit& u) const { const int L = (i >> 1) * G + c; if (L >= NMT * 4) return false; const int pk = g8::static_map(L, NMT, 4); Unit t; t.pm = pk & 0xffff; t.pn = pk >> 16; t.aux = i & 1; t.x0 = 0; t.x1 = 0; u = t; return true; }
    static constexpr bool GATHER = false;
    DI unsigned ldaB() const { return LDZ * 2u; }
    DI unsigned a_unit(const Unit& u) const { return (unsigned)WS_Z + (unsigned)u.pm * (256u * LDZ * 2u); }
    DI unsigned koffA(const Unit& u, int t) const { return (unsigned)((u.aux ? ZGR : ZQ) * 2 + t * 128); }
    DI int nt(const Unit& u) const { return u.aux ? 16 : 8; }
    DI bool keep(const Unit& u) const { return u.aux == 0; }
    DI const char* b_ptr(const Unit& u) const { return Abase + (size_t)offW + (size_t)u.pn * 256 * (1536 * 2) + (u.aux ? 1024 : 0); }
    DI void epi(Acc& acc, const Unit& u, int wr, int wc, int fr, int fq) const {
        if (u.aux == 0) {
#pragma unroll
            for (int ai = 0; ai < 2; ++ai)
#pragma unroll
                for (int m = 0; m < 4; ++m) { const bf16_t* rowp = Z + (size_t)ROW_OF(u.pm, ai, m) * LDZ + u.pn * 256 + wc * 32 + 8 * fq;
#pragma unroll
                    for (int bj = 0; bj < 2; ++bj) { const u32x4 sa = *(const u32x4*)(rowp + ZGA + bj * 128), sl = *(const u32x4*)(rowp + ZGL + bj * 128);
                        float a8[8], l8[8]; unpack8(sa, a8); unpack8(sl, l8);
#pragma unroll
                        for (int j = 0; j < 4; ++j) { acc[ai][bj][m][0][j] *= a8[j] * rcpf_(l8[j]); acc[ai][bj][m][1][j] *= a8[4 + j] * rcpf_(l8[4 + j]); } }
                    asm volatile("" ::: "memory"); }
        } else {
#pragma unroll
            for (int ai = 0; ai < 2; ++ai)
#pragma unroll
                for (int m = 0; m < 4; ++m) { bf16_t* rowp = Z + (size_t)ROW_OF(u.pm, ai, m) * LDZ + u.pn * 256 + wc * 32 + 8 * fq;
#pragma unroll
                    for (int bj = 0; bj < 2; ++bj) { const u32x4 sl = *(const u32x4*)(rowp + ZGL + bj * 128); float l8[8]; unpack8(sl, l8);
                        f32x4 v0 = acc[ai][bj][m][0], v1 = acc[ai][bj][m][1];
#pragma unroll
                        for (int j = 0; j < 4; ++j) { v0[j] *= l8[j]; v1[j] *= l8[4 + j]; }
                        *(u32x4*)(rowp + ZGA + bj * 128) = pack8(v0, v1); }
                    asm volatile("" ::: "memory"); }
        }
    }
};

template <int NT_, int LDB_>
struct ProbResid : ProbBase {
    static constexpr bool PERM = true; static constexpr int NT = NT_, LDB = LDB_;
    unsigned offA, lda2; unsigned offW; const bf16_t* H; bf16_t* Y;
    DI bool next(int i, Unit& u) const { const int L = i * G + c; if (L >= NMT * 4) return false; const int pk = g8::static_map(L, NMT, 4); Unit t; t.pm = pk & 0xffff; t.pn = pk >> 16; t.aux = 0; t.x0 = 0; t.x1 = 0; u = t; return true; }
    static constexpr bool GATHER = false;
    DI unsigned ldaB() const { return lda2; }
    DI unsigned a_unit(const Unit& u) const { return offA + (unsigned)u.pm * 256u * lda2; }
    DI unsigned koffA(const Unit&, int t) const { return (unsigned)t * 128u; }
    DI int nt(const Unit&) const { return NT; }
    DI bool keep(const Unit&) const { return false; }
    DI const char* b_ptr(const Unit& u) const { return Abase + (size_t)offW + (size_t)u.pn * 256 * (LDB_ * 2); }
    DI void epi(Acc& acc, const Unit& u, int wr, int wc, int fr, int fq) const {
#pragma unroll
        for (int ai = 0; ai < 2; ++ai)
#pragma unroll
            for (int m = 0; m < 4; ++m) { const size_t ro = (size_t)ROW_OF(u.pm, ai, m) * D + u.pn * 256 + wc * 32 + 8 * fq;
#pragma unroll
                for (int bj = 0; bj < 2; ++bj) { const u32x4 hv = *(const u32x4*)(H + ro + bj * 128); float h8[8]; unpack8(hv, h8);
                    f32x4 v0 = acc[ai][bj][m][0], v1 = acc[ai][bj][m][1];
#pragma unroll
                    for (int j = 0; j < 4; ++j) { v0[j] += ALPHA * h8[j]; v1[j] += ALPHA * h8[4 + j]; }
                    *(u32x4*)(Y + ro + bj * 128) = pack8(v0, v1); }
                asm volatile("" ::: "memory"); }
    }
};

struct ProbUpD : ProbBase {
    static constexpr bool PERM = false; static constexpr int NT = 16, LDB = 1024;
    unsigned offW; bf16_t* ACT;
    DI bool next(int i, Unit& u) const { const int L = i * G + c; if (L >= NMT * 22) return false; const int pk = g8::static_map(L, NMT, 22); Unit t; t.pm = pk & 0xffff; t.pn = pk >> 16; t.aux = 0; t.x0 = 0; t.x1 = 0; u = t; return true; }
    static constexpr bool GATHER = false;
    DI unsigned ldaB() const { return 2048u; }
    DI unsigned a_unit(const Unit& u) const { return (unsigned)WS_H + (unsigned)u.pm * (256u * 2048u); }
    DI unsigned koffA(const Unit&, int t) const { return (unsigned)t * 128u; }
    DI int nt(const Unit&) const { return NT; }
    DI bool keep(const Unit&) const { return false; }
    DI const char* b_ptr(const Unit& u) const { return Abase + (size_t)offW + (size_t)u.pn * 256 * 2048; }
    DI void epi(Acc& acc, const Unit& u, int wr, int wc, int fr, int fq) const {
#pragma unroll
        for (int ai = 0; ai < 2; ++ai)
#pragma unroll
            for (int m = 0; m < 4; ++m) { bf16_t* rowp = ACT + (size_t)ROW_OF(u.pm, ai, m) * DFF + u.pn * 128 + wc * 16 + 4 * fq;
#pragma unroll
                for (int bj = 0; bj < 2; ++bj) { const f32x4 g = acc[ai][bj][m][0], up = acc[ai][bj][m][1];
                    u32x2 w; w.x = cvt_pk_bf16(silu_(g[0]) * up[0], silu_(g[1]) * up[1]); w.y = cvt_pk_bf16(silu_(g[2]) * up[2], silu_(g[3]) * up[3]);
                    *(u32x2*)(rowp + bj * 64) = w; } }
    }
};

struct MoeTab {
    int cnt[8], tiles[8], ub[9], rb[8];
    DI void init(const unsigned* cw, int nN) {
        int u = 0, r = 0;
#pragma unroll
        for (int e = 0; e < 8; ++e) { int c = (int)__builtin_amdgcn_readfirstlane(cw[e]); c = c > MG ? MG : c; cnt[e] = c; tiles[e] = (c + 255) >> 8; ub[e] = u; rb[e] = r; u += tiles[e] * nN; r += tiles[e]; }
        ub[8] = u;
    }
    DI bool find(int L, Unit& u) const {
        if (L >= ub[8]) return false;
        int e = 0;
#pragma unroll
        for (int k = 1; k < 8; ++k) e += (L >= ub[k]) ? 1 : 0;
        int te = 1, ue = 0, re = 0, ce = 0;
#pragma unroll
        for (int k = 0; k < 8; ++k) if (e == k) { te = tiles[k]; ue = ub[k]; re = rb[k]; ce = cnt[k]; }
        const int r = L - ue; Unit t; t.pm = r % te; t.pn = r / te; t.aux = e; t.x0 = re; t.x1 = ce; u = t; return true;
    }
};

struct ProbUpM : ProbBase {
    static constexpr bool PERM = false; static constexpr int NT = 16, LDB = 1024;
    unsigned offW; bf16_t* ACT; const int* list; MoeTab tab;
    DI bool next(int i, Unit& u) const { return tab.find(i * G + c, u); }
    static constexpr bool GATHER = true;
    DI unsigned ldaB() const { return 2048u; }
    DI unsigned a_unit(const Unit&) const { return 0u; }
    DI void a_gather(const Unit& u, const int (&R)[2], const int (&C)[2], unsigned (&vo)[2][2]) const {
        const int* le = list + (size_t)u.aux * MG;
#pragma unroll
        for (int h = 0; h < 2; ++h)
#pragma unroll
            for (int i = 0; i < 2; ++i) { const int pos = u.pm * 256 + h * 128 + R[i]; const int tok = le[pos < u.x1 ? pos : 0];
                vo[h][i] = (unsigned)WS_H + (unsigned)tok * 2048u + (unsigned)C[i] * 2u; }
    }
    DI unsigned koffA(const Unit&, int t) const { return (unsigned)t * 128u; }
    DI int nt(const Unit&) const { return NT; }
    DI bool keep(const Unit&) const { return false; }
    DI const char* b_ptr(const Unit& u) const { return Abase + (size_t)offW + (size_t)u.aux * ((size_t)PROJW * D * 2) + (size_t)u.pn * 256 * 2048; }
    DI void epi(Acc& acc, const Unit& u, int wr, int wc, int fr, int fq) const {
#pragma unroll
        for (int ai = 0; ai < 2; ++ai)
#pragma unroll
            for (int m = 0; m < 4; ++m) { bf16_t* rowp = ACT + (size_t)ROW_OF(u.x0 + u.pm, ai, m) * DFF + u.pn * 128 + wc * 16 + 4 * fq;
#pragma unroll
                for (int bj = 0; bj < 2; ++bj) { const f32x4 g = acc[ai][bj][m][0], up = acc[ai][bj][m][1];
                    u32x2 w; w.x = cvt_pk_bf16(silu_(g[0]) * up[0], silu_(g[1]) * up[1]); w.y = cvt_pk_bf16(silu_(g[2]) * up[2], silu_(g[3]) * up[3]);
                    *(u32x2*)(rowp + bj * 64) = w; } }
    }
};
struct ProbDownM : ProbBase {
    static constexpr bool PERM = true; static constexpr int NT = 44, LDB = 2816;
    unsigned offW; bf16_t* YS; const float* wlist; MoeTab tab;
    DI bool next(int i, Unit& u) const { return tab.find(i * G + c, u); }
    static constexpr bool GATHER = false;
    DI unsigned ldaB() const { return DFF * 2u; }
    DI unsigned a_unit(const Unit& u) const { return (unsigned)WS_ACT + (unsigned)(u.x0 + u.pm) * (256u * DFF * 2u); }
    DI unsigned koffA(const Unit&, int t) const { return (unsigned)t * 128u; }
    DI int nt(const Unit&) const { return NT; }
    DI bool keep(const Unit&) const { return false; }
    DI const char* b_ptr(const Unit& u) const { return Abase + (size_t)offW + (size_t)u.aux * ((size_t)D * DFF * 2) + (size_t)u.pn * 256 * (DFF * 2); }
    DI void epi(Acc& acc, const Unit& u, int wr, int wc, int fr, int fq) const {
        const float* we = wlist + (size_t)u.aux * MG;
#pragma unroll
        for (int ai = 0; ai < 2; ++ai)
#pragma unroll
            for (int m = 0; m < 4; ++m) { const int pos = ROW_OF(u.pm, ai, m); const float w = pos < u.x1 ? we[pos] : 0.f;
                bf16_t* rowp = YS + (size_t)(u.x0 * 256 + pos) * D + u.pn * 256 + wc * 32 + 8 * fq;
#pragma unroll
                for (int bj = 0; bj < 2; ++bj) *(u32x4*)(rowp + bj * 128) = pack8(acc[ai][bj][m][0] * w, acc[ai][bj][m][1] * w); }
    }
};

struct Args { const float* in[27]; float* out; unsigned char* ws; };
struct Ctx {
    LAS unsigned char* lds; volatile LAS unsigned* MISC;
    unsigned char* ws; unsigned* ctl; float* out;
    int wave, G, gw, NGW;
};
DI int crow(int r, int hi) { return (r & 3) + 8 * (r >> 2) + 4 * hi; }

DI void transpose_item(const float* W, int N, bf16_t* WT, int ldt, int kofs, int row_off, int mode, LAS float* scr, int item, int lane) {
    const int nblk = N / 32, kb = item / nblk, nb = item % nblk, k0 = 64 * kb, n0 = 32 * nb;
#pragma unroll 8
    for (int i = 0; i < 32; ++i) { const int kk = 2 * i + (lane >> 5); scr[kk * 33 + (lane & 31)] = W[(size_t)(k0 + kk) * N + n0 + (lane & 31)]; }
    asm volatile("s_waitcnt lgkmcnt(0)" ::: "memory");
    const int c = lane & 7;
    const float sc = (mode == 1 && n0 < 512) ? QSCALE : 1.0f;
#pragma unroll
    for (int j = 0; j < 4; ++j) { const int n = (lane >> 3) + 8 * j; const LAS float* s = scr + (8 * c) * 33 + n;
        const int ns = n0 + n; int drow;
        if (mode == 0) drow = row_off + ns;
        else if (mode == 1) drow = ns < 1024 ? ns : (ns < 1536 ? 5120 + (ns - 1024) : ns - 512);
        else drow = 32 * (ns >> 4) + 16 * row_off + (ns & 15);
        u32x4 o; o.x = cvt_pk_bf16(s[0 * 33] * sc, s[1 * 33] * sc); o.y = cvt_pk_bf16(s[2 * 33] * sc, s[3 * 33] * sc); o.z = cvt_pk_bf16(s[4 * 33] * sc, s[5 * 33] * sc); o.w = cvt_pk_bf16(s[6 * 33] * sc, s[7 * 33] * sc);
        *(u32x4*)(WT + (size_t)drow * ldt + kofs + k0 + 8 * c) = o; }
    asm volatile("s_waitcnt lgkmcnt(0)" ::: "memory");
}
DI void prologue(Ctx& F, const Args& a) {
    const int tid = opaque(threadIdx.x), lane = tid & 63;
    LAS float* scr = (LAS float*)(F.lds + F.wave * 16384);
    unsigned char* ws = F.ws;
    constexpr int L_IN = 16 * 176, L_AO = 8 * 32, L_LO = 16 * 32, L_O = 16 * 32, L_G = 32;
    constexpr int L_ALL = L_IN + L_AO + L_LO + L_O + 2 * L_G;
    constexpr int F_G = 16 * 88, F_D = 44 * 32, F_ALL = 2 * F_G + F_D;
    constexpr int NITEMS = DEPTH * L_ALL + 18 * F_ALL;
    for (int it = opaque_s(F.gw); it < NITEMS; it += F.NGW) {
        if (it < DEPTH * L_ALL) {
            const int l = it / L_ALL; int r = it % L_ALL;
            if (r < L_IN) { transpose_item(a.in[4] + (size_t)l * D * PROJW, PROJW, (bf16_t*)(ws + WS_WIN) + (size_t)l * PROJW * D, D, 0, 0, 1, scr, r, lane); continue; } r -= L_IN;
            if (r < L_AO) { transpose_item(a.in[15] + (size_t)l * 512 * D, D, (bf16_t*)(ws + WS_WMIX) + (size_t)l * D * 1536, 1536, 0, 0, 0, scr, r, lane); continue; } r -= L_AO;
            if (r < L_LO) { transpose_item(a.in[16] + (size_t)l * D * D, D, (bf16_t*)(ws + WS_WMIX) + (size_t)l * D * 1536, 1536, 512, 0, 0, scr, r, lane); continue; } r -= L_LO;
            if (r < L_O) { transpose_item(a.in[17] + (size_t)l * D * D, D, (bf16_t*)(ws + WS_WO) + (size_t)l * D * D, D, 0, 0, 0, scr, r, lane); continue; } r -= L_O;
            const int which = r / L_G, hh = (r % L_G) >> 1, sub = r & 1;
            transpose_item(a.in[which ? 12 : 10] + ((size_t)l * 16 + hh) * 4096, 64, (bf16_t*)(ws + (which ? WS_WI : WS_WR)) + ((size_t)l * 16 + hh) * 4096, 64, 0, 0, 0, scr, sub, lane);
        } else {
            const int r0 = it - DEPTH * L_ALL, set = r0 / F_ALL; int r = r0 % F_ALL;
            const float *wg, *wu, *wd; bf16_t *dgu, *dd;
            if (set < 2) { wg = a.in[20] + (size_t)set * D * DFF; wu = a.in[21] + (size_t)set * D * DFF; wd = a.in[22] + (size_t)set * DFF * D;
                dgu = (bf16_t*)(ws + WS_WGUD) + (size_t)set * PROJW * D; dd = (bf16_t*)(ws + WS_WDD) + (size_t)set * D * DFF; }
            else { const int s2 = set - 2; wg = a.in[24] + (size_t)s2 * D * DFF; wu = a.in[25] + (size_t)s2 * D * DFF; wd = a.in[26] + (size_t)s2 * DFF * D;
                dgu = (bf16_t*)(ws + WS_WGUM) + (size_t)s2 * PROJW * D; dd = (bf16_t*)(ws + WS_WDM) + (size_t)s2 * D * DFF; }
            if (r < F_G) { transpose_item(wg, DFF, dgu, D, 0, 0, 2, scr, r, lane); continue; } r -= F_G;
            if (r < F_G) { transpose_item(wu, DFF, dgu, D, 0, 1, 2, scr, r, lane); continue; } r -= F_G;
            transpose_item(wd, D, dd, DFF, 0, 0, 0, scr, r, lane);
        }
    }
    float* tab = (float*)(ws + WS_TAB);
    for (int i = blockIdx.x * 512 + tid; i < DEPTH * D; i += F.G * 512) { const float x = a.in[14][i]; tab[i] = log1pf(expf(-x)); }
    if (blockIdx.x == 0 && tid < DEPTH) { const int l = tid; const float* dl = a.in[6] + l * 128; float s1 = 0.f, s2 = 0.f;
        for (int j = 0; j < 32; ++j) { s1 += dl[j] * dl[32 + j]; s2 += dl[64 + j] * dl[96 + j]; }
        const float lam_init = 0.8f - 0.6f * expf(-0.3f * (float)l);
        tab[DEPTH * D + 2 * l] = expf(s1) - expf(s2) + lam_init; tab[DEPTH * D + 2 * l + 1] = 1.0f - lam_init; }
}

DI void ln_in_phase(Ctx& F, const Args& a, int g) {
    const int tid = opaque(threadIdx.x), lane = tid & 63; (void)tid;
    bf16_t* H = (bf16_t*)(F.ws + WS_H);
    const float* gam = a.in[2]; const float* bet = a.in[3];
    for (int row = opaque_s(F.gw); row < MG; row += F.NGW) {
        const int bl = row / TP, r = row % TP;
        u32x4* o = (u32x4*)(H + (size_t)row * D) + lane;
        const bool padrow = r < PADR;
        const float* src = r < FRAME0 ? a.in[1] + (size_t)(padrow ? 0 : r - PADR) * D : a.in[0] + ((size_t)(g * GB + bl) * SEQ + (r - FRAME0)) * D;
        f32x4 v[4]; float s = 0.f;
#pragma unroll
        for (int j = 0; j < 4; ++j) { v[j] = *(const f32x4*)(src + (j >> 1) * 512 + lane * 8 + (j & 1) * 4); s += (v[j][0] + v[j][1]) + (v[j][2] + v[j][3]); }
        const float mean = wave_sum(s) * (1.f / D); float s2 = 0.f;
#pragma unroll
        for (int j = 0; j < 4; ++j) { v[j] = v[j] - mean; s2 += (v[j][0] * v[j][0] + v[j][1] * v[j][1]) + (v[j][2] * v[j][2] + v[j][3] * v[j][3]); }
        const float rstd = 1.f / sqrtf(wave_sum(s2) * (1.f / D) + 1e-5f);
#pragma unroll
        for (int j = 0; j < 4; ++j) { const int c0 = (j >> 1) * 512 + lane * 8 + (j & 1) * 4; const f32x4 gg = *(const f32x4*)(gam + c0), bb = *(const f32x4*)(bet + c0); v[j] = v[j] * rstd * gg + bb; }
        u32x4 w0 = pack8(v[0], v[1]), w1 = pack8(v[2], v[3]);
        if (padrow) { w0 = (u32x4){0u, 0u, 0u, 0u}; w1 = w0; }
        o[0] = w0; o[64] = w1;
    }
}

template <int MODE, bool FINAL>
DI void ln_phase(Ctx& F, const Args& a, int g, const float* gam, const float* bet, const float* router, unsigned* cntw) {
    const int tid = opaque(threadIdx.x), lane = tid & 63; (void)tid;
    bf16_t* H = (bf16_t*)(F.ws + WS_H);
    const bf16_t* Y = (const bf16_t*)((const unsigned char*)F.out + OUT_Y);
    const bf16_t* YS = (const bf16_t*)(F.ws + WS_YSLOT);
    unsigned* tokinfo = (unsigned*)(F.ws + WS_ROUTE);
    int* list = (int*)(F.ws + WS_ROUTE + (size_t)MG * 32);
    float* wlist = (float*)(F.ws + WS_ROUTE + (size_t)MG * 32 + (size_t)8 * MG * 4);
    LAS float* wrt = (LAS float*)F.lds;
    int rbase[8];
    if (MODE == 1) {
        for (int i = tid; i < 8 * D; i += 512) { const int c = i >> 3, e = i & 7; wrt[e * D + c] = router[i]; }
        __syncthreads();
    }
    if (MODE == 3) { int r = 0;
#pragma unroll
        for (int e = 0; e < 8; ++e) { int c = (int)__builtin_amdgcn_readfirstlane(cntw[e]); c = c > MG ? MG : c; rbase[e] = r; r += ((c + 255) >> 8) * 256; } }
    for (int row = opaque_s(F.gw); row < MG; row += F.NGW) {
        float v[16];
        if (MODE == 3) {
            const u32x4 ti = *(const u32x4*)(tokinfo + (size_t)row * 8);
            int s1 = 0, s2 = 0;
#pragma unroll
            for (int e = 0; e < 8; ++e) { if ((int)ti.x == e) s1 = rbase[e] + (int)ti.y; if ((int)ti.z == e) s2 = rbase[e] + (int)ti.w; }
#pragma unroll
            for (int hh = 0; hh < 2; ++hh) { const int c0 = hh * 512 + lane * 8;
                const u32x4 hv = *(const u32x4*)(H + (size_t)row * D + c0), y1 = *(const u32x4*)(YS + (size_t)s1 * D + c0), y2 = *(const u32x4*)(YS + (size_t)s2 * D + c0);
                float h8[8], a8[8], b8[8]; unpack8(hv, h8); unpack8(y1, a8); unpack8(y2, b8);
#pragma unroll
                for (int j = 0; j < 8; ++j) v[hh * 8 + j] = ALPHA * h8[j] + (a8[j] + b8[j]); }
        } else {
#pragma unroll
            for (int hh = 0; hh < 2; ++hh) { const u32x4 yv = *(const u32x4*)(Y + (size_t)row * D + hh * 512 + lane * 8); float y8[8]; unpack8(yv, y8);
#pragma unroll
                for (int j = 0; j < 8; ++j) v[hh * 8 + j] = y8[j]; }
        }
        float s = 0.f;
#pragma unroll
        for (int j = 0; j < 16; ++j) s += v[j];
        const float mean = wave_sum(s) * (1.f / D); float s2 = 0.f;
#pragma unroll
        for (int j = 0; j < 16; ++j) { v[j] -= mean; s2 += v[j] * v[j]; }
        const float rstd = 1.f / sqrtf(wave_sum(s2) * (1.f / D) + 1e-5f);
#pragma unroll
        for (int hh = 0; hh < 2; ++hh) { const int c0 = hh * 512 + lane * 8;
#pragma unroll
            for (int q = 0; q < 2; ++q) { const f32x4 gg = *(const f32x4*)(gam + c0 + 4 * q), bb = *(const f32x4*)(bet + c0 + 4 * q);
#pragma unroll
                for (int j = 0; j < 4; ++j) v[hh * 8 + q * 4 + j] = v[hh * 8 + q * 4 + j] * rstd * gg[j] + bb[j]; } }
#pragma unroll
        for (int hh = 0; hh < 2; ++hh) { u32x4 w; w.x = cvt_pk_bf16(v[hh * 8 + 0], v[hh * 8 + 1]); w.y = cvt_pk_bf16(v[hh * 8 + 2], v[hh * 8 + 3]); w.z = cvt_pk_bf16(v[hh * 8 + 4], v[hh * 8 + 5]); w.w = cvt_pk_bf16(v[hh * 8 + 6], v[hh * 8 + 7]);
            *(u32x4*)(H + (size_t)row * D + hh * 512 + lane * 8) = w; }
        if (FINAL) {
            const int bl = row / TP, r = row % TP;
            if (r >= FRAME0) { float* op = F.out + ((size_t)(g * GB + bl) * SEQ + (r - FRAME0)) * D;
#pragma unroll
                for (int hh = 0; hh < 2; ++hh)
#pragma unroll
                    for (int q = 0; q < 2; ++q) *(f32x4*)(op + hh * 512 + lane * 8 + 4 * q) = (f32x4){v[hh * 8 + q * 4], v[hh * 8 + q * 4 + 1], v[hh * 8 + q * 4 + 2], v[hh * 8 + q * 4 + 3]}; }
        }
        if (MODE == 1) {
            float lg[8];
#pragma unroll
            for (int e = 0; e < 8; ++e) { float acc = 0.f;
#pragma unroll
                for (int hh = 0; hh < 2; ++hh) { const LAS f32x4* wp = (const LAS f32x4*)(wrt + e * D + hh * 512 + lane * 8); const f32x4 w0 = wp[0], w1 = wp[1];
#pragma unroll
                    for (int j = 0; j < 4; ++j) acc += v[hh * 8 + j] * w0[j] + v[hh * 8 + 4 + j] * w1[j]; }
                lg[e] = wave_sum(acc); }
            int e1 = 0; float l1 = lg[0];
#pragma unroll
            for (int e = 1; e < 8; ++e) if (lg[e] > l1) { l1 = lg[e]; e1 = e; }
            int e2 = -1; float l2 = -INFINITY;
#pragma unroll
            for (int e = 0; e < 8; ++e) if (e != e1 && lg[e] > l2) { l2 = lg[e]; e2 = e; }
            const float w2 = rcpf_(1.0f + ex2(LOG2E * (l1 - l2))), w1 = 1.0f - w2;
            if (lane == 0) {
                if (PROBE_DUP == 14) { atomicAdd(cntw + 16 + e1, 1u); atomicAdd(cntw + 16 + e2, 1u); }
                const unsigned p1 = atomicAdd(cntw + e1, 1u), p2 = atomicAdd(cntw + e2, 1u);
                *(u32x4*)(tokinfo + (size_t)row * 8) = (u32x4){(unsigned)e1, p1, (unsigned)e2, p2};
                if (p1 < (unsigned)MG) { list[(size_t)e1 * MG + p1] = row; wlist[(size_t)e1 * MG + p1] = w1; }
                if (p2 < (unsigned)MG) { list[(size_t)e2 * MG + p2] = row; wlist[(size_t)e2 * MG + p2] = w2; }
            }
        }
    }
}

constexpr int NSC = 16;
constexpr int LRU_WAVE_LDS = 14336;
template <bool PASS2>
DI void lru_phase(Ctx& F, const Args& a, int l, bool dummy = false) {
    const int lane = opaque(threadIdx.x) & 63, r32 = lane & 31, hi = lane >> 5;
    bf16_t* Z = (bf16_t*)(F.ws + WS_Z);
    const bf16_t* WrT = (const bf16_t*)(F.ws + WS_WR) + (size_t)l * 16 * 4096;
    const bf16_t* WiT = (const bf16_t*)(F.ws + WS_WI) + (size_t)l * 16 * 4096;
    float* aggA = (float*)(F.ws + WS_AGG); float* aggH = aggA + (size_t)GB * NSC * D;
    const float* spt = (const float*)(F.ws + WS_TAB) + l * D;
    const float* cw = a.in[8] + (size_t)l * 4 * D; const float* cbv = a.in[9] + (size_t)l * D;
    const float* brv = a.in[11] + (size_t)l * D; const float* biv = a.in[13] + (size_t)l * D;
    LAS bf16_t* xraw = (LAS bf16_t*)(F.lds + F.wave * LRU_WAVE_LDS);
    LAS bf16_t* xcb = xraw + 2560;
    LAS bf16_t* gbf = xcb + 2304;
    for (int unit = opaque_s(F.gw); unit < GB * 16 * NSC; unit += F.NGW) {
        const int head = unit & 15, sc = (unit >> 4) & 15, bl = unit >> 8;
        const int t0 = sc < 2 ? 9 * sc : 18 + 8 * (sc - 2), ntile = sc < 2 ? 9 : 8;
        const size_t rowb = (size_t)bl * TP;
        bf16x8 wrf[2][4], wif[2][4];
#pragma unroll
        for (int ct = 0; ct < 2; ++ct)
#pragma unroll
            for (int ks = 0; ks < 4; ++ks) { const size_t o = (size_t)(head * 64 + ct * 32 + r32) * 64 + ks * 16 + hi * 8; wrf[ct][ks] = *(const bf16x8*)(WrT + o); wif[ct][ks] = *(const bf16x8*)(WiT + o); }
        float c0[2], c1[2], c2[2], c3[2], cb[2], br[2], bi[2], sp8[2], hst[2], apr[2];
#pragma unroll
        for (int ct = 0; ct < 2; ++ct) { const int ch = head * 64 + ct * 32 + r32;
            c0[ct] = cw[ch]; c1[ct] = cw[D + ch]; c2[ct] = cw[2 * D + ch]; c3[ct] = cw[3 * D + ch]; cb[ct] = cbv[ch]; br[ct] = brv[ch]; bi[ct] = biv[ch]; sp8[ct] = -8.0f * LOG2E * spt[ch];
            hst[ct] = 0.f; apr[ct] = 1.f; }
        if (PASS2) {
#pragma unroll
            for (int kb = 0; kb < 2; ++kb) { float fa[2][8], fh[2][8];
#pragma unroll
                for (int k = 0; k < 8; ++k)
#pragma unroll
                    for (int ct = 0; ct < 2; ++ct) { const int kk = kb * 8 + k; const bool on = kk < sc; const size_t o = ((size_t)bl * NSC + (on ? kk : 0)) * D + head * 64 + ct * 32 + r32;
                        const float av = aggA[o], hv = aggH[o]; fa[ct][k] = on ? av : 1.0f; fh[ct][k] = on ? hv : 0.f; }
#pragma unroll
                for (int k = 0; k < 8; ++k)
#pragma unroll
                    for (int ct = 0; ct < 2; ++ct) hst[ct] = fa[ct][k] * hst[ct] + fh[ct][k]; }
        }
        u32x4 px[5], pg[4];
#define LRU_LOAD(tile) do { const int _r0 = (tile) * 32; \
            _Pragma("unroll") for (int k = 0; k < 5; ++k) { const int p = lane + 64 * k; const int j = p >> 3, c8 = p & 7; const int rr = _r0 - 3 + j; const int rc = rr < 0 ? 0 : rr; \
                u32x4 v = (u32x4){0u, 0u, 0u, 0u}; if (p < 280) v = *(const u32x4*)(Z + (rowb + rc) * LDZ + ZXR + head * 64 + c8 * 8); if (rr < PADR) v = (u32x4){0u, 0u, 0u, 0u}; px[k] = v; } \
            if (PASS2) { _Pragma("unroll") for (int k = 0; k < 4; ++k) { const int p = lane + 64 * k; pg[k] = *(const u32x4*)(Z + (rowb + _r0 + (p >> 3)) * LDZ + ZGR + head * 64 + (p & 7) * 8); } } } while (0)
        LRU_LOAD(t0);
        for (int ti = 0; ti < ntile; ++ti) {
            const int r0 = (t0 + ti) * 32;
#pragma unroll
            for (int k = 0; k < 5; ++k) { const int p = lane + 64 * k; if (p < 280) *(LAS u32x4*)(xraw + (p >> 3) * 72 + (p & 7) * 8) = px[k]; }
            if (PASS2) {
#pragma unroll
                for (int k = 0; k < 4; ++k) { const int p = lane + 64 * k; *(LAS u32x4*)(gbf + (p >> 3) * 72 + (p & 7) * 8) = pg[k]; } }
            if (ti + 1 < ntile) LRU_LOAD(t0 + ti + 1);
            f32x16 xc[2];
#pragma unroll
            for (int ct = 0; ct < 2; ++ct) {
#pragma unroll
                for (int sg = 0; sg < 4; ++sg) { float xw[7];
#pragma unroll
                    for (int d = 0; d < 7; ++d) xw[d] = bf2f(xraw[(8 * sg + 4 * hi + d) * 72 + ct * 32 + r32]);
#pragma unroll
                    for (int q = 0; q < 4; ++q) xc[ct][4 * sg + q] = cb[ct] + c0[ct] * xw[q] + c1[ct] * xw[q + 1] + c2[ct] * xw[q + 2] + c3[ct] * xw[q + 3]; } }
#pragma unroll
            for (int ct = 0; ct < 2; ++ct)
#pragma unroll
                for (int r = 0; r < 16; ++r) xcb[crow(r, hi) * 72 + ct * 32 + r32] = f2bf(xc[ct][r]);
            bf16x8 af[4];
#pragma unroll
            for (int ks = 0; ks < 4; ++ks) af[ks] = *(const LAS bf16x8*)(xcb + r32 * 72 + ks * 16 + hi * 8);
#pragma unroll
            for (int ct = 0; ct < 2; ++ct) {
                f32x16 grx, gix;
#pragma unroll
                for (int r = 0; r < 16; ++r) { grx[r] = 0.f; gix[r] = 0.f; }
#pragma unroll
                for (int ks = 0; ks < 4; ++ks) { grx = __builtin_amdgcn_mfma_f32_32x32x16_bf16(af[ks], wrf[ct][ks], grx, 0, 0, 0); gix = __builtin_amdgcn_mfma_f32_32x32x16_bf16(af[ks], wif[ct][ks], gix, 0, 0, 0); }
                f32x16 av, uv;
#pragma unroll
                for (int r = 0; r < 16; ++r) { const float rg = sigm(grx[r] + br[ct]), ig = sigm(gix[r] + bi[ct]);
                    const float aa = ex2(sp8[ct] * rg); const float m2 = 1.0f - aa * aa; const float mult = sqrtf(m2 > 0.f ? m2 : 0.f);
                    const bool pad = (r0 + crow(r, hi)) < PADR;
                    av[r] = pad ? 1.0f : aa; uv[r] = pad ? 0.f : mult * ig * xc[ct][r]; }
                float As[4], Us[4];
#pragma unroll
                for (int sg = 0; sg < 4; ++sg) { As[sg] = (av[4 * sg] * av[4 * sg + 1]) * (av[4 * sg + 2] * av[4 * sg + 3]);
                    Us[sg] = ((uv[4 * sg] * av[4 * sg + 1] + uv[4 * sg + 1]) * av[4 * sg + 2] + uv[4 * sg + 2]) * av[4 * sg + 3] + uv[4 * sg + 3]; }
                float h = hst[ct], hs[4];
#pragma unroll
                for (int sg = 0; sg < 4; ++sg) { const float he0 = As[sg] * h + Us[sg]; const float t = __shfl_xor(he0, 32);
                    const float he1 = As[sg] * t + Us[sg]; const float t2 = __shfl_xor(he1, 32);
                    hs[sg] = hi ? t : h; h = hi ? he1 : t2; }
                hst[ct] = h;
                if (!PASS2) { const float own = (As[0] * As[1]) * (As[2] * As[3]); apr[ct] *= own * __shfl_xor(own, 32); }
                else {
#pragma unroll
                    for (int sg = 0; sg < 4; ++sg) { float hh = hs[sg];
#pragma unroll
                        for (int q = 0; q < 4; ++q) { hh = av[4 * sg + q] * hh + uv[4 * sg + q];
                            LAS bf16_t* p = gbf + (8 * sg + 4 * hi + q) * 72 + ct * 32 + r32; *p = f2bf(hh * bf2f(*p)); } }
                }
            }
            if (PASS2) {
#pragma unroll
                for (int k = 0; k < 4; ++k) { const int p = lane + 64 * k; const u32x4 v = *(const LAS u32x4*)(gbf + (p >> 3) * 72 + (p & 7) * 8);
                    bf16_t* dst = dummy ? (bf16_t*)(F.ws + WS_YSLOT) + (rowb + r0 + (p >> 3)) * 1024 + head * 64 + (p & 7) * 8 : Z + (rowb + r0 + (p >> 3)) * LDZ + ZGR + head * 64 + (p & 7) * 8;
                    *(u32x4*)dst = v; } }
        }
#undef LRU_LOAD
        if (!PASS2 && hi == 0) {
#pragma unroll
            for (int ct = 0; ct < 2; ++ct) { const size_t o = ((size_t)bl * NSC + sc) * D + head * 64 + ct * 32 + r32; aggA[o] = apr[ct]; aggH[o] = hst[ct]; } }
    }
}

constexpr int ATT_BUFB = 16384;
DI void attn_unit(Ctx& F, const Args& a, int l, int bl, int head, int j, bool dummy) {
    const int lane = opaque(threadIdx.x) & 63, r32 = lane & 31, hi = lane >> 5;
    const int wid = F.wave;
    bf16_t* Z = (bf16_t*)(F.ws + WS_Z); const bf16_t* VT = (const bf16_t*)(F.ws + WS_VT);
    const float* tab = (const float*)(F.ws + WS_TAB) + DEPTH * D + 2 * l;
    const float lam = tab[0], omli = tab[1];
    const int qt0 = j == 0 ? 0 : 4 * j - 3, nq = j == 0 ? 1 : 4;
    const int myqt = qt0 + (wid >> 1);
    const bool active = (wid >> 1) < nq;
    const int ktlast = qt0 + nq - 1;
    const int qb = (active ? myqt : qt0) * 2 + (wid & 1);
    const size_t rowq = (size_t)bl * TP + qb * 32 + r32;
    bf16_t* zq = Z + rowq * LDZ + ZQ + head * 64;
    const int drow = 8 * wid + (lane >> 3), dch = (lane & 7) ^ ((drow >> 1) & 7);
    const bf16_t* ksrc = Z + ((size_t)bl * TP + drow) * LDZ + ZK + head * 64 + dch * 8;
    const bf16_t* vsrc = VT + (size_t)(head * 64 + drow) * MG + (size_t)bl * TP + dch * 8;
    LAS unsigned char* ring = F.lds;
#define ATT_ISSUE(kt) do { const int _b = ((kt) % 3) * ATT_BUFB + wid * 1024; \
        __builtin_amdgcn_global_load_lds((const unsigned*)(ksrc + (size_t)(kt) * 64 * LDZ), (LAS unsigned*)(ring + _b), 16, 0, 0); \
        __builtin_amdgcn_global_load_lds((const unsigned*)(vsrc + (size_t)(kt) * 64), (LAS unsigned*)(ring + _b + 8192), 16, 0, 0); } while (0)
    bf16x8 qf[2][2];
#pragma unroll
    for (int m = 0; m < 2; ++m)
#pragma unroll
        for (int s = 0; s < 2; ++s) qf[m][s] = *(const bf16x8*)(zq + m * 32 + s * 16 + hi * 8);
    ATT_ISSUE(0);
    if (ktlast >= 1) ATT_ISSUE(1);
    f32x16 O[2][2];
#pragma unroll
    for (int m = 0; m < 2; ++m)
#pragma unroll
        for (int vh = 0; vh < 2; ++vh)
#pragma unroll
            for (int r = 0; r < 16; ++r) O[m][vh][r] = 0.f;
    float mrun[2] = {-INFINITY, -INFINITY}, lrun[2] = {0.f, 0.f};
    const int pr = (r32 & ~12) | ((r32 & 4) << 1) | ((r32 & 8) >> 1);
    const int koff = pr * 128, kswz = (pr >> 1) & 7, voff = r32 * 128, vswz = (r32 >> 1) & 7;
    for (int kt = 0; kt <= ktlast; ++kt) {
        if (kt < ktlast) asm volatile("s_waitcnt vmcnt(2) lgkmcnt(0)\n\ts_barrier" ::: "memory");
        else asm volatile("s_waitcnt vmcnt(0) lgkmcnt(0)\n\ts_barrier" ::: "memory");
        if (kt + 2 <= ktlast) ATT_ISSUE(kt + 2);
        if (active && kt <= myqt) {
            const LAS unsigned char* Kb = ring + (kt % 3) * ATT_BUFB; const LAS unsigned char* Vb = Kb + 8192;
            bf16x8 vf[2][4];
#pragma unroll
            for (int vh = 0; vh < 2; ++vh)
#pragma unroll
                for (int s = 0; s < 4; ++s) vf[vh][s] = *(const LAS bf16x8*)(Vb + vh * 4096 + voff + (((s * 2 + hi) ^ vswz) * 16));
#pragma unroll
            for (int m = 0; m < 2; ++m) {
                f32x16 S[2];
#pragma unroll
                for (int hf = 0; hf < 2; ++hf) {
#pragma unroll
                    for (int r = 0; r < 16; ++r) S[hf][r] = 0.f;
#pragma unroll
                    for (int s = 0; s < 2; ++s) { const bf16x8 kfr = *(const LAS bf16x8*)(Kb + hf * 4096 + koff + (((m * 4 + s * 2 + hi) ^ kswz) * 16));
                        S[hf] = __builtin_amdgcn_mfma_f32_32x32x16_bf16(kfr, qf[m][s], S[hf], 0, 0, 0); } }
                if (kt == 0) {
#pragma unroll
                    for (int r = 0; r < 16; ++r) S[0][r] = -INFINITY;
#pragma unroll
                    for (int r = 0; r < 8; ++r) S[1][r] = -INFINITY; }
                float mx = fmaxf(S[0][0], S[1][0]);
#pragma unroll
                for (int r = 1; r < 16; ++r) mx = fmaxf(mx, fmaxf(S[0][r], S[1][r]));
                mx = fmaxf(mx, __shfl_xor(mx, 32));
                const float mnew = fmaxf(mrun[m], mx);
                if (__any(mnew > mrun[m])) { const float alpha = ex2(mrun[m] - mnew); lrun[m] *= alpha;
#pragma unroll
                    for (int vh = 0; vh < 2; ++vh)
#pragma unroll
                        for (int r = 0; r < 16; ++r) O[m][vh][r] *= alpha; }
                mrun[m] = mnew;
                float ps = 0.f;
#pragma unroll
                for (int hf = 0; hf < 2; ++hf)
#pragma unroll
                    for (int r = 0; r < 16; ++r) { S[hf][r] = ex2(S[hf][r] - mnew); ps += S[hf][r]; }
                lrun[m] += ps;
#pragma unroll
                for (int s = 0; s < 4; ++s) { const int hf = s >> 1, b0 = 8 * (s & 1);
                    u32x4 w; w.x = cvt_pk_bf16(S[hf][b0], S[hf][b0 + 1]); w.y = cvt_pk_bf16(S[hf][b0 + 2], S[hf][b0 + 3]); w.z = cvt_pk_bf16(S[hf][b0 + 4], S[hf][b0 + 5]); w.w = cvt_pk_bf16(S[hf][b0 + 6], S[hf][b0 + 7]);
                    const bf16x8 pfr = __builtin_bit_cast(bf16x8, w);
#pragma unroll
                    for (int vh = 0; vh < 2; ++vh) O[m][vh] = __builtin_amdgcn_mfma_f32_32x32x16_bf16(vf[vh][s], pfr, O[m][vh], 0, 0, 0); }
            }
        }
    }
#undef ATT_ISSUE
    if (active) {
        const float l1 = lrun[0] + __shfl_xor(lrun[0], 32), l2 = lrun[1] + __shfl_xor(lrun[1], 32);
        const float c1 = 1.0f / l1, c2 = lam / l2;
        float ss = 0.f;
#pragma unroll
        for (int vh = 0; vh < 2; ++vh)
#pragma unroll
            for (int r = 0; r < 16; ++r) { const float o = O[0][vh][r] * c1 - O[1][vh][r] * c2; O[0][vh][r] = o; ss += o * o; }
        ss += __shfl_xor(ss, 32);
        const float rms = omli / sqrtf(ss * (1.0f / 64.0f) + 1e-5f);
        const float* sg = a.in[7] + l * 64;
        bf16_t* zo = dummy ? (bf16_t*)(F.ws + WS_YSLOT) + rowq * 512 + head * 64 : zq;
#pragma unroll
        for (int vh = 0; vh < 2; ++vh)
#pragma unroll
            for (int g4 = 0; g4 < 4; ++g4) { const int vd = vh * 32 + 8 * g4 + 4 * hi; const f32x4 gv = *(const f32x4*)(sg + vd);
                u32x2 w; w.x = cvt_pk_bf16(O[0][vh][4 * g4] * rms * gv[0], O[0][vh][4 * g4 + 1] * rms * gv[1]); w.y = cvt_pk_bf16(O[0][vh][4 * g4 + 2] * rms * gv[2], O[0][vh][4 * g4 + 3] * rms * gv[3]);
                *(u32x2*)(zo + vd) = w; }
    }
    asm volatile("s_waitcnt lgkmcnt(0)\n\ts_barrier" ::: "memory");
}
DI void attn_phase(Ctx& F, const Args& a, int l, unsigned* qhead, bool dummy) {
    const int tid = opaque(threadIdx.x);
    for (;;) {
        if (tid == 0) F.MISC[0] = atomicAdd(qhead, 1u);
        __syncthreads();
        const unsigned u = F.MISC[0];
        __syncthreads();
        if (u >= 17u * 64u) break;
        const int j = 16 - (int)(u >> 6), bh = (int)(u & 63);
        attn_unit(F, a, l, bh >> 3, bh & 7, j, dummy);
    }
}

__global__ void __launch_bounds__(512, 2) fwd_kernel(Args a) {
    extern __shared__ __attribute__((aligned(16))) unsigned char lds_raw[];
    Ctx F;
    F.lds = (LAS unsigned char*)lds_raw; F.MISC = (volatile LAS unsigned*)(F.lds + MISC_OFF);
    F.wave = __builtin_amdgcn_readfirstlane(threadIdx.x >> 6);
    F.G = gridDim.x; F.gw = blockIdx.x * 8 + F.wave; F.NGW = F.G * 8;
    F.ws = a.ws; F.ctl = (unsigned*)(a.ws + WS_CTL); F.out = a.out;
    if (threadIdx.x < 64) F.MISC[threadIdx.x] = 0u;
    __syncthreads();
    XcdBarrier bar = xcd_barrier_post(F.ctl + CW_BAR, F.MISC + 8);
    const char* wsb = (const char*)a.ws;
    bf16_t* Zp = (bf16_t*)(a.ws + WS_Z); bf16_t* Hp = (bf16_t*)(a.ws + WS_H); bf16_t* Yp = (bf16_t*)((unsigned char*)a.out + OUT_Y);
    bf16_t* ACTp = (bf16_t*)(a.ws + WS_ACT);

#ifndef PH_MASK
#define PH_MASK 0xffff
#endif
#define GRIDBAR() do { xcd_barrier(bar); if (PROBE_DUP == 13) xcd_barrier(bar); } while (0)
    if (PROBE_DUP == 12) prologue(F, a);
    if (PH_MASK & 1) prologue(F, a);
#pragma unroll 1
    for (int g = 0; g < NGRP; ++g) {
        if (PH_MASK & 2) ln_in_phase(F, a, g);
        GRIDBAR();
#pragma unroll 1
        for (int l = 0; l < DEPTH; ++l) {
            const int mi = l >> 1;
            { ProbInProj P; P.Abase = wsb; P.G = F.G; P.c = opaque_s(blockIdx.x); P.offW = (unsigned)(WS_WIN + (size_t)l * PROJW * D * 2); P.bg0 = a.in[5] + (size_t)l * 2 * D; P.bg1 = P.bg0 + D; P.Z = Zp; P.VT = (bf16_t*)(a.ws + WS_VT);
              if (PROBE_DUP == 1) g8::gemm_phase(F.lds, P);
              if (PH_MASK & 4) g8::gemm_phase(F.lds, P); }
            GRIDBAR();
            if (PROBE_DUP == 3) lru_phase<false>(F, a, l);
            if (PH_MASK & 8) lru_phase<false>(F, a, l);
            __syncthreads();
            if (PROBE_DUP == 2) attn_phase(F, a, l, F.ctl + CW_Q + 64 * (8 + g * 4 + l), true);
            if (PH_MASK & 16) attn_phase(F, a, l, F.ctl + CW_Q + 64 * (g * 4 + l), false);
            GRIDBAR();
            if (PROBE_DUP == 4) lru_phase<true>(F, a, l, true);
            if (PH_MASK & 32) lru_phase<true>(F, a, l);
            GRIDBAR();
            { ProbMix P; P.Abase = wsb; P.G = F.G; P.c = opaque_s(blockIdx.x); P.offW = (unsigned)(WS_WMIX + (size_t)l * D * 1536 * 2); P.Z = Zp;
              if (PH_MASK & 64) g8::gemm_phase(F.lds, P); }
            GRIDBAR();
            { ProbResid<16, 1024> P; P.Abase = wsb; P.G = F.G; P.c = opaque_s(blockIdx.x); P.offA = (unsigned)(WS_Z + ZGA * 2); P.lda2 = LDZ * 2; P.offW = (unsigned)(WS_WO + (size_t)l * D * D * 2); P.H = Hp; P.Y = Yp;
              if (PROBE_DUP == 6) g8::gemm_phase(F.lds, P);
              if (PH_MASK & 128) g8::gemm_phase(F.lds, P); }
            GRIDBAR();
            const float* g1 = a.in[18] + (size_t)(l * 2) * D; const float* b1 = a.in[19] + (size_t)(l * 2) * D;
            unsigned* cntw = F.ctl + CW_CNT + 64 * (g * 2 + mi);
            if ((l & 1) == 0) {
                if (PROBE_DUP == 7) ln_phase<0, false>(F, a, g, g1, b1, nullptr, nullptr);
                if (PH_MASK & 256) ln_phase<0, false>(F, a, g, g1, b1, nullptr, nullptr);
                GRIDBAR();
                { ProbUpD P; P.Abase = wsb; P.G = F.G; P.c = opaque_s(blockIdx.x); P.offW = (unsigned)(WS_WGUD + (size_t)mi * PROJW * D * 2); P.ACT = ACTp;
                  if (PROBE_DUP == 8) g8::gemm_phase(F.lds, P);
                  if (PH_MASK & 512) g8::gemm_phase(F.lds, P); }
                GRIDBAR();
                { ProbResid<44, 2816> P; P.Abase = wsb; P.G = F.G; P.c = opaque_s(blockIdx.x); P.offA = (unsigned)WS_ACT; P.lda2 = DFF * 2; P.offW = (unsigned)(WS_WDD + (size_t)mi * D * DFF * 2); P.H = Hp; P.Y = Yp;
                  if (PROBE_DUP == 9) g8::gemm_phase(F.lds, P);
                  if (PH_MASK & 1024) g8::gemm_phase(F.lds, P); }
                GRIDBAR();
                if (PH_MASK & 256) ln_phase<0, false>(F, a, g, g1 + D, b1 + D, nullptr, nullptr);
                GRIDBAR();
            } else {
                if (PH_MASK & 2048) ln_phase<1, false>(F, a, g, g1, b1, a.in[23] + (size_t)mi * D * 8, cntw);
                GRIDBAR();
                { ProbUpM P; P.Abase = wsb; P.G = F.G; P.c = opaque_s(blockIdx.x); P.offW = (unsigned)(WS_WGUM + (size_t)mi * 8 * PROJW * D * 2); P.ACT = ACTp;
                  P.list = (const int*)(a.ws + WS_ROUTE + (size_t)MG * 32); P.tab.init(cntw, 22);
                  if (PROBE_DUP == 10) g8::gemm_phase(F.lds, P);
                  if (PH_MASK & 4096) g8::gemm_phase(F.lds, P); }
                GRIDBAR();
                { ProbDownM P; P.Abase = wsb; P.G = F.G; P.c = opaque_s(blockIdx.x); P.offW = (unsigned)(WS_WDM + (size_t)mi * 8 * D * DFF * 2); P.YS = (bf16_t*)(a.ws + WS_YSLOT);
                  P.wlist = (const float*)(a.ws + WS_ROUTE + (size_t)MG * 32 + (size_t)8 * MG * 4); P.tab.init(cntw, 4);
                  if (PROBE_DUP == 11) g8::gemm_phase(F.lds, P);
                  if (PH_MASK & 8192) g8::gemm_phase(F.lds, P); }
                GRIDBAR();
                if (PH_MASK & 16384) { if (l == DEPTH - 1) ln_phase<3, true>(F, a, g, g1 + D, b1 + D, nullptr, cntw);
                else ln_phase<3, false>(F, a, g, g1 + D, b1 + D, nullptr, cntw); }
                GRIDBAR();
            }
        }
    }
}

extern "C" void kernel_launch(void* const* d_in, const int* in_sizes, int n_in, void* d_out, int out_size, void* d_ws, size_t ws_size, hipStream_t stream) {
    static int grid = 0;
    if (grid == 0) {
        if (n_in != 27 || out_size != NBATCH * SEQ * D || ws_size < WS_END) { fprintf(stderr, "kernel_launch: unexpected problem (n_in %d, out %d, ws %zu)\n", n_in, out_size, ws_size); grid = -1; return; }
        int dev = 0, cus = 0;
        if (hipGetDevice(&dev) != hipSuccess || hipDeviceGetAttribute(&cus, hipDeviceAttributeMultiprocessorCount, dev) != hipSuccess) { grid = -1; return; }
        if (hipFuncSetAttribute((const void*)fwd_kernel, hipFuncAttributeMaxDynamicSharedMemorySize, LDS_BYTES) != hipSuccess) { fprintf(stderr, "kernel_launch: hipFuncSetAttribute failed\n"); grid = -1; return; }
        int per_cu = 0;
        if (hipOccupancyMaxActiveBlocksPerMultiprocessor(&per_cu, (const void*)fwd_kernel, 512, LDS_BYTES) != hipSuccess || per_cu < 1) fprintf(stderr, "kernel_launch: occupancy query says %d\n", per_cu);
        (void)hipGetLastError();
        grid = cus;
    }
    if (grid < 0) return;
    (void)hipMemsetAsync((char*)d_ws + WS_CTL, 0, CTL_BYTES, stream);
    Args a{};
    for (int i = 0; i < 27; ++i) a.in[i] = (const float*)d_in[i];
    a.out = (float*)d_out; a.ws = (unsigned char*)d_ws;
    hipLaunchKernelGGL(fwd_kernel, dim3(grid), dim3(512), LDS_BYTES, stream, a);
}
```

```cpp
#include <hip/hip_runtime.h>
#include <cstdio>
#include <cstdint>

#ifndef PROBE_DUP
#define PROBE_DUP 0
#endif
#ifndef PROBE_T
#define PROBE_T 0
#endif
#define PROBE_OFS 0.0f
#define DI __device__ __forceinline__
#define LAS __attribute__((address_space(3)))
typedef unsigned short bf16_t;
typedef short bf16x8 __attribute__((ext_vector_type(8)));
typedef float f32x4 __attribute__((ext_vector_type(4)));
typedef float f32x16 __attribute__((ext_vector_type(16)));
typedef unsigned u32x4 __attribute__((ext_vector_type(4)));
typedef unsigned u32x2 __attribute__((ext_vector_type(2)));

constexpr int D = 1024, NBATCH = 16, SEQ = 4096, DEPTH = 4;
constexpr int TP = 4160;
constexpr int PADR = 48, FRAME0 = 64;
constexpr int GB = 8, NGRP = NBATCH / GB;
constexpr int MG = GB * TP;
constexpr int NMT = MG / 256;
constexpr int LDZ = 5120;
constexpr int ZQ = 0, ZK = 512, ZXR = 1024, ZGR = 2048, ZGA = 3072, ZGL = 4096;
constexpr size_t ZBLK = (size_t)MG * 512;
#define ZOFF(row, col) ((size_t)((col) >> 9) * ZBLK + (size_t)(row) * 512 + ((col) & 511))
constexpr int DFF = 2816, NEXP = 8, PROJW = 5632;
constexpr int NCHUNK = TP / 64;
constexpr int NQB = TP / 32;
constexpr float ALPHA = 1.681792830507429f;
constexpr float LOG2E = 1.4426950408889634f;
constexpr float QSCALE = 0.17677669529663687f * LOG2E;
constexpr int SLOT_ROWS = 2 * MG + 8 * 256;
constexpr int NMTC = GB * 16;
constexpr int META_ACT = NMTC * 256;

constexpr size_t MiB = 1u << 20;
constexpr size_t WS_CTL = 0, CTL_BYTES = 1 * MiB;
constexpr size_t WS_TAB = 1 * MiB;
constexpr size_t WS_WIN = 2 * MiB;
constexpr size_t WS_WMIX = 46 * MiB;
constexpr size_t WS_WO = 58 * MiB;
constexpr size_t WS_WR = 66 * MiB;
constexpr size_t WS_WI = 66 * MiB + 512 * 1024;
constexpr size_t WS_WGUD = 67 * MiB;
constexpr size_t WS_WDD = 89 * MiB;
constexpr size_t WS_WGUM = 100 * MiB;
constexpr size_t WS_WDM = 276 * MiB;
constexpr size_t WS_H = 364 * MiB;
constexpr size_t WS_AGG = 429 * MiB;
constexpr size_t WS_ROUTE = 434 * MiB;
constexpr size_t WS_YSLOT = 438 * MiB;
constexpr size_t WS_Z = 572 * MiB;
constexpr size_t WS_VT = 897 * MiB;
constexpr size_t WS_ACT = WS_Z;
constexpr size_t WS_MSAVE = 941 * MiB;
constexpr size_t WS_END = 942 * MiB;
constexpr size_t OUT_Y = 128 * MiB;
static_assert(WS_WIN + (size_t)DEPTH * PROJW * D * 2 <= WS_WMIX, "map");
static_assert(WS_WMIX + (size_t)DEPTH * D * 1536 * 2 <= WS_WO, "map");
static_assert(WS_WGUD + (size_t)2 * PROJW * D * 2 <= WS_WDD && WS_WDD + (size_t)2 * D * DFF * 2 <= WS_WGUM, "map");
static_assert(WS_WGUM + (size_t)16 * PROJW * D * 2 <= WS_WDM && WS_WDM + (size_t)16 * D * DFF * 2 <= WS_H, "map");
static_assert(WS_H + (size_t)MG * D * 2 <= WS_AGG && WS_AGG + (size_t)2 * GB * NCHUNK * D * 4 <= WS_ROUTE, "map");
static_assert(WS_ROUTE + (size_t)MG * 32 + (size_t)2 * 8 * MG * 4 <= WS_YSLOT && WS_YSLOT + (size_t)SLOT_ROWS * D * 2 <= WS_Z, "map");
static_assert(WS_Z + (size_t)MG * LDZ * 2 <= WS_VT && WS_VT + (size_t)512 * MG * 2 <= WS_END && WS_ACT + (size_t)SLOT_ROWS * DFF * 2 <= WS_END, "map");

constexpr int CW_BAR = 4096;
constexpr int CW_Q = 8192;
constexpr int CW_CNT = 12288;

constexpr int LDS_STAGE = 131072;
constexpr int MISC_OFF = LDS_STAGE;
constexpr int LDS_BYTES = LDS_STAGE + 1024;

DI float bf_lo(unsigned w) { return __uint_as_float(w << 16); }
DI float bf_hi(unsigned w) { return __uint_as_float(w & 0xffff0000u); }
DI float bf2f(bf16_t b) { return __uint_as_float((unsigned)b << 16); }
typedef float f32x2_t __attribute__((ext_vector_type(2))); typedef __bf16 bf16x2_t __attribute__((ext_vector_type(2)));
DI unsigned cvt_pk_bf16(float lo, float hi) { const f32x2_t v = {lo, hi}; const bf16x2_t b = __builtin_convertvector(v, bf16x2_t); return __builtin_bit_cast(unsigned, b); }
DI bf16_t f2bf(float f) { return (bf16_t)(cvt_pk_bf16(f, 0.f) & 0xffffu); }
DI float ex2(float x) { return __builtin_amdgcn_exp2f(x); }
DI float rcpf_(float x) { return __builtin_amdgcn_rcpf(x); }
DI float sigm(float x) { return rcpf_(1.0f + ex2(-LOG2E * x)); }
DI float silu_(float x) { return x * sigm(x); }
DI float gelu_tanh(float x) { const float u = 0.7978845608028654f * (x + 0.044715f * x * x * x); return x * sigm(2.0f * u); }
DI int opaque(int x) { asm volatile("" : "+v"(x)); return x; }
DI int opaque_s(int x) { asm volatile("" : "+s"(x)); return x; }
DI float bcast_lo(float v) { const auto r = __builtin_amdgcn_permlane32_swap(__float_as_uint(v), __float_as_uint(v), false, false); return __uint_as_float(r[0]); }
DI float bcast_hi(float v) { const auto r = __builtin_amdgcn_permlane32_swap(__float_as_uint(v), __float_as_uint(v), false, false); return __uint_as_float(r[1]); }
template <int CTRL> DI float dpp_mov(float v) { return __int_as_float(__builtin_amdgcn_update_dpp(0, __float_as_int(v), CTRL, 0xf, 0xf, true)); }
DI float wave_sum(float v) {
    v += dpp_mov<0xB1>(v);
    v += dpp_mov<0x4E>(v);
    v += dpp_mov<0x141>(v);
    v += dpp_mov<0x140>(v);
    { const auto r = __builtin_amdgcn_permlane16_swap(__float_as_uint(v), __float_as_uint(v), false, false); v = __uint_as_float(r[0]) + __uint_as_float(r[1]); }
    { const auto r = __builtin_amdgcn_permlane32_swap(__float_as_uint(v), __float_as_uint(v), false, false); v = __uint_as_float(r[0]) + __uint_as_float(r[1]); }
    return v;
}
DI float half_sum(float v) { const auto r = __builtin_amdgcn_permlane32_swap(__float_as_uint(v), __float_as_uint(v), false, false); return __uint_as_float(r[0]) + __uint_as_float(r[1]); }
DI void unpack8(const u32x4 w, float (&f)[8]) { f[0] = bf_lo(w.x); f[1] = bf_hi(w.x); f[2] = bf_lo(w.y); f[3] = bf_hi(w.y); f[4] = bf_lo(w.z); f[5] = bf_hi(w.z); f[6] = bf_lo(w.w); f[7] = bf_hi(w.w); }
DI u32x4 pack8(const f32x4 a, const f32x4 b) { u32x4 w; w.x = cvt_pk_bf16(a[0], a[1]); w.y = cvt_pk_bf16(a[2], a[3]); w.z = cvt_pk_bf16(b[0], b[1]); w.w = cvt_pk_bf16(b[2], b[3]); return w; }

#define XB_TMO      128
#define XB_XCNT(j)  (256  + 64 * (j))
#define XB_XSUB(j)  (1280 + 64 * (j))
#define XB_XGEN(j)  (2304 + 64 * (j))
#define XB_TOP      3328
#define XB_TOPGEN   3392
#define XCD_BAR_WORDS 3456
#define XB_SPIN_CAP (1u << 18)
DI unsigned xb_ld(unsigned* p)              { return __hip_atomic_load(p, __ATOMIC_RELAXED, __HIP_MEMORY_SCOPE_AGENT); }
DI unsigned xb_add(unsigned* p, unsigned v) { return __hip_atomic_fetch_add(p, v, __ATOMIC_RELAXED, __HIP_MEMORY_SCOPE_AGENT); }
DI unsigned xb_xcc_id() { return (unsigned)__builtin_amdgcn_s_getreg((3 << 11) | 20) & 0xFu; }
#define XB_SPIN(cond, bar) do { unsigned _sp = 0; while (cond) { __builtin_amdgcn_s_sleep(1); \
    if ((++_sp & 255u) == 0u) { if (xb_ld(&(bar)[XB_TMO])) break; if (_sp > XB_SPIN_CAP) { atomicAdd(&(bar)[XB_TMO], 1u); break; } } } } while (0)
struct XcdBarrier { unsigned* bar; unsigned x; volatile LAS unsigned* st; };
DI XcdBarrier xcd_barrier_post(unsigned* bar, volatile LAS unsigned* st) {
    XcdBarrier b; b.bar = bar; b.x = xb_xcc_id(); b.st = st;
    if (threadIdx.x == 0) (void)xb_add(&bar[XB_XCNT(b.x)], 1u);
    return b;
}
DI void xcd_barrier_complete(unsigned* bar, unsigned x, unsigned& nloc, unsigned& nx) {
    const unsigned G = gridDim.x * gridDim.y * gridDim.z;
    unsigned sum, cnt, mine, sp = 0u;
    for (;;) {
        sum = 0u; cnt = 0u; mine = 0u;
#pragma unroll
        for (unsigned j = 0; j < 16; ++j) { const unsigned c = xb_ld(&bar[XB_XCNT(j)]); sum += c; cnt += (c > 0u) ? 1u : 0u; mine = (j == x) ? c : mine; }
        if (sum == G) break;
        __builtin_amdgcn_s_sleep(1);
        if ((++sp & 255u) == 0u) { if (xb_ld(&bar[XB_TMO])) break; if (sp > XB_SPIN_CAP) { atomicAdd(&bar[XB_TMO], 1u); break; } }
    }
    nloc = mine > 0u ? mine : 1u; nx = cnt > 0u ? cnt : 1u;
}
DI void xcd_barrier(const XcdBarrier& b) {
    asm volatile("s_waitcnt vmcnt(0)" ::: "memory");
    __syncthreads();
    if (threadIdx.x == 0) {
        unsigned* bar = b.bar;
        __builtin_amdgcn_s_waitcnt(0);
        unsigned nloc = b.st[0], nx = b.st[1];
        if (nloc == 0u) { xcd_barrier_complete(bar, b.x, nloc, nx); b.st[0] = nloc; b.st[1] = nx; }
        const unsigned old = xb_add(&bar[XB_XSUB(b.x)], 1u);
        const unsigned gen = old / nloc;
        if (old + 1u == (gen + 1u) * nloc) {
            __builtin_amdgcn_fence(__ATOMIC_RELEASE, "agent");
            asm volatile("s_waitcnt vmcnt(0)" ::: "memory");
            const unsigned og = xb_add(&bar[XB_TOP], 1u);
            const unsigned tg = og / nx;
            if (og + 1u == (tg + 1u) * nx) xb_add(&bar[XB_TOPGEN], 1u);
            else XB_SPIN(xb_ld(&bar[XB_TOPGEN]) == tg, bar);
            __builtin_amdgcn_fence(__ATOMIC_ACQUIRE, "agent");
            xb_add(&bar[XB_XGEN(b.x)], 1u);
            asm volatile("s_waitcnt vmcnt(0)" ::: "memory");
        } else {
            XB_SPIN(xb_ld(&bar[XB_XGEN(b.x)]) == gen, bar);
            __builtin_amdgcn_fence(__ATOMIC_ACQUIRE, "agent");
            asm volatile("s_waitcnt vmcnt(0)" ::: "memory");
        }
    }
    __syncthreads();
}

namespace g8 {
constexpr int BM = 256, BK = 64, HALF = 128, HTB = HALF * BK * 2, STAGE_BYTES = 8 * HTB, NXCD = 8, WGM = 4;
static_assert(STAGE_BYTES == LDS_STAGE, "stage");
__host__ __device__ __forceinline__ int lds_byte(int r, int c) { const int st = (r >> 4) * 2 + (c >> 5), rr = r & 15, cc = c & 31, ob = rr * 64 + cc * 2; return st * 1024 + (ob ^ (((ob >> 9) & 1) << 5)); }
__host__ __device__ __forceinline__ void stage_rc(int b, int& R, int& C) { const int st = b / 1024, sb = b % 1024, swz = sb ^ (((sb >> 9) & 1) << 5); R = (st >> 1) * 16 + swz / 64; C = (st & 1) * 32 + (swz % 64) / 2; }
__host__ __device__ __forceinline__ int perm32(int rho) { const int n = rho >> 4, i = rho & 15; return 8 * (i >> 2) + 4 * n + (i & 3); }
struct Unit { int pm, pn, aux, x0, x1; };
DI int static_map(int L, int nM, int nN) {
    const int nwg = nM * nN; int wgid = L;
    { const int q = nwg / NXCD, r = nwg % NXCD, xcd = wgid % NXCD, off = wgid / NXCD; wgid = (xcd < r ? xcd * (q + 1) : r * (q + 1) + (xcd - r) * q) + off; }
    const int nig = WGM * nN, gid = wgid / nig, fm = gid * WGM, gsz = (nM - fm) < WGM ? (nM - fm) : WGM;
    return (fm + ((wgid % nig) % gsz)) | (((wgid % nig) / gsz) << 16);
}
typedef f32x4 Acc[2][2][4][2];

template <class P>
DI void gemm_phase(LAS unsigned char* lds, const P& prob) {
    const int tid = opaque(threadIdx.x), wid = __builtin_amdgcn_readfirstlane(tid >> 6), lane = tid & 63, wr = wid >> 2, wc = wid & 3, fr = lane & 15, fq = lane >> 4;
    int R[2], C[2]; unsigned voffB[2], voffA[2];
#pragma unroll
    for (int i = 0; i < 2; ++i) { stage_rc(tid * 16 + i * 8192, R[i], C[i]); const int Rb = P::PERM ? ((R[i] & ~31) + perm32(R[i] & 31)) : R[i]; voffB[i] = (unsigned)(Rb * P::LDB + C[i]) * 2u;
        voffA[i] = (unsigned)R[i] * prob.ldaB() + (unsigned)C[i] * 2u; }
    constexpr unsigned hstepB = (unsigned)HALF * P::LDB * 2u;
    const unsigned hstepA = (unsigned)HALF * prob.ldaB();
    const unsigned ldsw = (unsigned)wid * 1024u;
    const int aoff = lds_byte(wr * 64 + fr, fq * 8), boff = lds_byte(wc * 32 + fr, fq * 8);
#define G8_SA(b, h) (((b) * 2 + (h)) * HTB)
#define G8_SB(b, h) ((4 + (b) * 2 + (h)) * HTB)
#define G8_STAGE_B(bufoff, gbase) do { _Pragma("unroll") for (int _i = 0; _i < 2; ++_i) \
        __builtin_amdgcn_global_load_lds((const unsigned*)((const char*)(gbase) + voffB[_i]), (LAS unsigned*)(lds + (bufoff) + ldsw + _i * 8192), 16, 0, 0); } while (0)
#define G8_STAGE_A(bufoff, h, ub, gv, koff) do { if constexpr (P::GATHER) { const char* _kb = Ab + (koff); _Pragma("unroll") for (int _i = 0; _i < 2; ++_i) \
            __builtin_amdgcn_global_load_lds((const unsigned*)(_kb + (gv)[h][_i]), (LAS unsigned*)(lds + (bufoff) + ldsw + _i * 8192), 16, 0, 0); } \
        else { const char* _kb = Ab + ((ub) + (h) * hstepA + (koff)); _Pragma("unroll") for (int _i = 0; _i < 2; ++_i) \
            __builtin_amdgcn_global_load_lds((const unsigned*)(_kb + voffA[_i]), (LAS unsigned*)(lds + (bufoff) + ldsw + _i * 8192), 16, 0, 0); } } while (0)
#define G8_LDA(dst, b, h) do { _Pragma("unroll") for (int m = 0; m < 4; ++m) _Pragma("unroll") for (int k = 0; k < 2; ++k) dst[m][k] = *(const LAS bf16x8*)(lds + G8_SA(b, h) + aoff + m * 2048 + k * 1024); } while (0)
#define G8_LDB(dst, b, h) do { _Pragma("unroll") for (int n = 0; n < 2; ++n) _Pragma("unroll") for (int k = 0; k < 2; ++k) dst[n][k] = *(const LAS bf16x8*)(lds + G8_SB(b, h) + boff + n * 2048 + k * 1024); } while (0)
#define G8_MMA(ai, bj, At, Bt) do { __builtin_amdgcn_s_setprio(1); _Pragma("unroll") for (int m = 0; m < 4; ++m) _Pragma("unroll") for (int n = 0; n < 2; ++n) _Pragma("unroll") for (int k = 0; k < 2; ++k) \
        acc[ai][bj][m][n] = __builtin_amdgcn_mfma_f32_16x16x32_bf16(Bt[n][k], At[m][k], acc[ai][bj][m][n], 0, 0, 0); __builtin_amdgcn_s_setprio(0); } while (0)
#define G8_WAIT_V(n) asm volatile("s_waitcnt vmcnt(" #n ")" ::: "memory")
#define G8_WAIT_L(n) asm volatile("s_waitcnt lgkmcnt(" #n ")" ::: "memory")
#define G8_BAR __builtin_amdgcn_s_barrier()
#define G8_SCHED __builtin_amdgcn_sched_barrier(0)
    Unit cur, nxt; int ui = 0;
    if (!prob.next(0, cur)) return;
    Acc acc;
#pragma unroll
    for (int a = 0; a < 2; ++a)
#pragma unroll
        for (int b = 0; b < 2; ++b)
#pragma unroll
            for (int m = 0; m < 4; ++m)
#pragma unroll
                for (int n = 0; n < 2; ++n) acc[a][b][m][n] = (f32x4){0.f, 0.f, 0.f, 0.f};
    bf16x8 At[4][2], B0[2][2], B1[2][2];
    unsigned gvA[2][2], gvN[2][2];
    unsigned cU = 0, nU = 0;
    if constexpr (P::GATHER) prob.a_gather(cur, R, C, gvA); else cU = prob.a_unit(cur);
    const char* const Ab = prob.Abase;
    const char* cB = prob.b_ptr(cur);
    G8_STAGE_B(G8_SB(0, 0), cB); G8_STAGE_B(G8_SB(0, 1), cB + hstepB); G8_STAGE_A(G8_SA(0, 0), 0, cU, gvA, prob.koffA(cur, 0)); G8_STAGE_A(G8_SA(0, 1), 1, cU, gvA, prob.koffA(cur, 0));
    if (wr == 1) G8_BAR;
    G8_WAIT_V(2); G8_BAR;
    G8_STAGE_B(G8_SB(1, 0), cB + 128); G8_STAGE_A(G8_SA(1, 0), 0, cU, gvA, prob.koffA(cur, 1)); G8_STAGE_B(G8_SB(1, 1), cB + hstepB + 128);
    G8_WAIT_V(6); G8_BAR;
    for (;;) {
        const bool has_next = prob.next(ui + 1, nxt);
        if (!has_next) nxt = cur;
        if constexpr (P::GATHER) { if (has_next) prob.a_gather(nxt, R, C, gvN); else {
#pragma unroll
            for (int h = 0; h < 2; ++h)
#pragma unroll
                for (int i = 0; i < 2; ++i) gvN[h][i] = gvA[h][i]; } }
        else nU = has_next ? prob.a_unit(nxt) : cU;
        const char* nB = has_next ? prob.b_ptr(nxt) : cB;
        const int nt = prob.nt(cur);
        for (int t = 0; t < nt; t += 2) {
            const bool last = (t == nt - 2);
            const unsigned k1 = prob.koffA(cur, t + 1), k2 = last ? prob.koffA(nxt, 0) : prob.koffA(cur, t + 2), k3 = last ? prob.koffA(nxt, 1) : prob.koffA(cur, t + 3);
            unsigned v2[2][2]; unsigned u2 = 0;
            if constexpr (P::GATHER) {
#pragma unroll
                for (int h = 0; h < 2; ++h)
#pragma unroll
                    for (int i = 0; i < 2; ++i) v2[h][i] = last ? gvN[h][i] : gvA[h][i];
            } else u2 = last ? nU : cU;
            const char* b2 = last ? nB : cB + (size_t)(t + 2) * 128; const char* b3 = b2 + 128;
            G8_LDB(B0, 0, 0); G8_LDB(B1, 0, 1); G8_SCHED; G8_LDA(At, 0, 0); G8_STAGE_A(G8_SA(1, 1), 1, cU, gvA, k1);
            G8_WAIT_V(8); G8_WAIT_L(0); G8_BAR; G8_MMA(0, 0, At, B0); G8_MMA(0, 1, At, B1); G8_BAR; G8_SCHED;
            G8_LDA(At, 0, 1); G8_STAGE_B(G8_SB(0, 0), b2); G8_STAGE_B(G8_SB(0, 1), b2 + hstepB); G8_STAGE_A(G8_SA(0, 0), 0, u2, v2, k2);
            G8_WAIT_V(8); G8_WAIT_L(0); G8_BAR; G8_MMA(1, 0, At, B0); G8_MMA(1, 1, At, B1); G8_BAR; G8_SCHED;
            G8_LDB(B0, 1, 0); G8_LDB(B1, 1, 1); G8_SCHED; G8_LDA(At, 1, 0); G8_STAGE_A(G8_SA(0, 1), 1, u2, v2, k2);
            G8_WAIT_V(8); G8_WAIT_L(0); G8_BAR; G8_MMA(0, 0, At, B0); G8_MMA(0, 1, At, B1); G8_BAR; G8_SCHED;
            G8_LDA(At, 1, 1); G8_STAGE_B(G8_SB(1, 0), b3); G8_STAGE_B(G8_SB(1, 1), b3 + hstepB); G8_STAGE_A(G8_SA(1, 0), 0, u2, v2, k3);
            G8_WAIT_V(8); G8_WAIT_L(0); G8_BAR; G8_MMA(1, 0, At, B0); G8_MMA(1, 1, At, B1); G8_BAR; G8_SCHED;
        }
        if (wr == 0) G8_BAR;
        prob.epi(acc, cur, wr, wc, fr, fq);
        if (!has_next) break;
        if (!prob.keep(cur)) {
#pragma unroll
            for (int a = 0; a < 2; ++a)
#pragma unroll
                for (int b = 0; b < 2; ++b)
#pragma unroll
                    for (int m = 0; m < 4; ++m)
#pragma unroll
                        for (int n = 0; n < 2; ++n) acc[a][b][m][n] = (f32x4){0.f, 0.f, 0.f, 0.f};
        }
        cur = nxt; cB = nB; cU = nU; ++ui;
        if constexpr (P::GATHER) {
#pragma unroll
            for (int h = 0; h < 2; ++h)
#pragma unroll
                for (int i = 0; i < 2; ++i) gvA[h][i] = gvN[h][i];
        }
        if (wr == 1) G8_BAR;
    }
    G8_WAIT_V(0);
    G8_BAR;
#undef G8_SA
#undef G8_SB
#undef G8_STAGE_A
#undef G8_STAGE_B
#undef G8_LDA
#undef G8_LDB
#undef G8_MMA
#undef G8_WAIT_V
#undef G8_WAIT_L
#undef G8_BAR
#undef G8_SCHED
}
}
using g8::Unit; using g8::Acc;

#define ROW_OF(pm, ai, m) ((pm) * 256 + (ai) * 128 + wr * 64 + (m) * 16 + fr)
DI int crow0(int pm) { return (pm >> 4) * TP + FRAME0 + (pm & 15) * 256; }
#define PROW_OF(pm, ai, m) (crow0(pm) + (ai) * 128 + wr * 64 + (m) * 16 + fr)

struct ProbBase { const char* Abase; int G, c; };

struct ProbInProj : ProbBase {
    static constexpr bool PERM = true; static constexpr int NT = 16, LDB = 1024;
    unsigned offW; const float* bg0; const float* bg1; bf16_t* Z; bf16_t* VT;
    static constexpr int U1 = NMT * 20, U2 = 2 * NMT;
    DI bool next(int i, Unit& u) const {
        const int L = i * G + c; if (L >= U1 + U2) return false;
        const int L2 = L - U1; const bool second = L2 >= 0;
        const int pk = g8::static_map(second ? 0 : L, NMT, 20);
        Unit t; t.aux = second ? 1 : 0; t.pm = second ? L2 / NMT : (pk & 0xffff); t.pn = second ? L2 % NMT : (pk >> 16); t.x0 = 0; t.x1 = 0; u = t; return true;
    }
    static constexpr bool GATHER = false;
    DI unsigned ldaB() const { return 2048u; }
    DI unsigned a_unit(const Unit& u) const { return (u.aux ? offW + 5120u * 2048u : (unsigned)WS_H) + (unsigned)u.pm * (256u * 2048u); }
    DI unsigned koffA(const Unit&, int t) const { return (unsigned)t * 128u; }
    DI int nt(const Unit&) const { return NT; }
    DI bool keep(const Unit&) const { return false; }
    DI const char* b_ptr(const Unit& u) const { return Abase + (u.aux ? (size_t)WS_H : (size_t)offW) + (size_t)u.pn * 256 * 2048; }
    DI void epi(Acc& acc, const Unit& u, int wr, int wc, int fr, int fq) const {
        if (u.aux == 0) {
            const int colt = u.pn * 256;
            const int kind = colt < ZGR ? 0 : (colt < ZGA ? 1 : (colt < ZGL ? 2 : 3));
            f32x4 bv[2][2];
#pragma unroll
            for (int bj = 0; bj < 2; ++bj)
#pragma unroll
                for (int n = 0; n < 2; ++n) bv[bj][n] = (f32x4){0.f, 0.f, 0.f, 0.f};
            if (kind >= 2) { const float* bp = (kind == 2 ? bg0 + (colt - ZGA) : bg1 + (colt - ZGL)) + wc * 32 + 8 * fq;
#pragma unroll
                for (int bj = 0; bj < 2; ++bj)
#pragma unroll
                    for (int n = 0; n < 2; ++n) bv[bj][n] = *(const f32x4*)(bp + bj * 128 + 4 * n); }
#pragma unroll
            for (int ai = 0; ai < 2; ++ai)
#pragma unroll
                for (int m = 0; m < 4; ++m) { bf16_t* rowp = Z + ZOFF(ROW_OF(u.pm, ai, m), colt + wc * 32 + 8 * fq);
#pragma unroll
                    for (int bj = 0; bj < 2; ++bj) { f32x4 v0 = acc[ai][bj][m][0] + bv[bj][0], v1 = acc[ai][bj][m][1] + bv[bj][1];
                        if (kind == 1) {
#pragma unroll
                            for (int j = 0; j < 4; ++j) { v0[j] = gelu_tanh(v0[j]); v1[j] = gelu_tanh(v1[j]); } }
                        else if (kind >= 2) {
#pragma unroll
                            for (int j = 0; j < 4; ++j) { v0[j] = sigm(v0[j]); v1[j] = sigm(v1[j]); } }
                        *(u32x4*)(rowp + bj * 128) = pack8(v0, v1); } }
        } else {
#pragma unroll
            for (int ai = 0; ai < 2; ++ai)
#pragma unroll
                for (int m = 0; m < 4; ++m) { bf16_t* rowp = VT + (size_t)ROW_OF(u.pm, ai, m) * MG + u.pn * 256 + wc * 32 + 8 * fq;
#pragma unroll
                    for (int bj = 0; bj < 2; ++bj) *(u32x4*)(rowp + bj * 128) = pack8(acc[ai][bj][m][0], acc[ai][bj][m][1]); }
        }
    }
};

struct ProbMix : ProbBase {
    static constexpr bool PERM = true; static constexpr int LDB = 1536;
    unsigned offW; bf16_t* Z;
    DI bool next(int i, Unit& u) const { const int L = (i >> 1) * G + c; if (L >= NMTC * 4) return false; const int pk = g8::static_map(L, NMTC, 4); Unit t; t.pm = pk & 0xffff; t.pn = pk >> 16; t.aux = i & 1; t.x0 = 0; t.x1 = 0; u = t; return true; }
    static constexpr bool GATHER = false;
    DI unsigned ldaB() const { return 1024u; }
    DI unsigned a_unit(const Unit& u) const { return (unsigned)WS_Z + (unsigned)crow0(u.pm) * 1024u; }
    DI unsigned koffA(const Unit& u, int t) const { return (unsigned)((u.aux ? (ZGR >> 9) + (t >> 3) : 0) * (ZBLK * 2) + (t & 7) * 128); }
    DI int nt(const Unit& u) const { return u.aux ? 16 : 8; }
    DI bool keep(const Unit& u) const { return u.aux == 0; }
    DI const char* b_ptr(const Unit& u) const { return Abase + (size_t)offW + (size_t)u.pn * 256 * (1536 * 2) + (u.aux ? 1024 : 0); }
    DI void epi(Acc& acc, const Unit& u, int wr, int wc, int fr, int fq) const {
        if (u.aux == 0) {
#pragma unroll
            for (int ai = 0; ai < 2; ++ai)
#pragma unroll
                for (int m = 0; m < 4; ++m) { const size_t ro = ZOFF(PROW_OF(u.pm, ai, m), u.pn * 256 + wc * 32 + 8 * fq); const bf16_t* rowa = Z + (ZGA >> 9) * ZBLK + ro; const bf16_t* rowl = Z + (ZGL >> 9) * ZBLK + ro;
#pragma unroll
                    for (int bj = 0; bj < 2; ++bj) { const u32x4 sa = *(const u32x4*)(rowa + bj * 128), sl = *(const u32x4*)(rowl + bj * 128);
                        float a8[8], l8[8]; unpack8(sa, a8); unpack8(sl, l8);
#pragma unroll
                        for (int j = 0; j < 4; ++j) { acc[ai][bj][m][0][j] *= a8[j] * rcpf_(l8[j]); acc[ai][bj][m][1][j] *= a8[4 + j] * rcpf_(l8[4 + j]); } }
                    asm volatile("" ::: "memory"); }
        } else {
#pragma unroll
            for (int ai = 0; ai < 2; ++ai)
#pragma unroll
                for (int m = 0; m < 4; ++m) { const size_t ro = ZOFF(PROW_OF(u.pm, ai, m), u.pn * 256 + wc * 32 + 8 * fq); bf16_t* rowa = Z + (ZGA >> 9) * ZBLK + ro; const bf16_t* rowl = Z + (ZGL >> 9) * ZBLK + ro;
#pragma unroll
                    for (int bj = 0; bj < 2; ++bj) { const u32x4 sl = *(const u32x4*)(rowl + bj * 128); float l8[8]; unpack8(sl, l8);
                        f32x4 v0 = acc[ai][bj][m][0], v1 = acc[ai][bj][m][1];
#pragma unroll
                        for (int j = 0; j < 4; ++j) { v0[j] *= l8[j]; v1[j] *= l8[4 + j]; }
                        *(u32x4*)(rowa + bj * 128) = pack8(v0, v1); }
                    asm volatile("" ::: "memory"); }
        }
    }
};

template <int NT_, int LDB_>
struct ProbResid : ProbBase {
    static constexpr bool PERM = true; static constexpr int NT = NT_, LDB = LDB_;
    unsigned offA, lda2, kblk; unsigned offW; const bf16_t* H; bf16_t* Y; int a_phys;
    DI bool next(int i, Unit& u) const { const int L = i * G + c; if (L >= NMTC * 4) return false; const int pk = g8::static_map(L, NMTC, 4); Unit t; t.pm = pk & 0xffff; t.pn = pk >> 16; t.aux = 0; t.x0 = 0; t.x1 = 0; u = t; return true; }
    static constexpr bool GATHER = false;
    DI unsigned ldaB() const { return lda2; }
    DI unsigned a_unit(const Unit& u) const { return offA + (unsigned)(a_phys ? crow0(u.pm) : u.pm * 256) * lda2; }
    DI unsigned koffA(const Unit&, int t) const { return kblk ? (unsigned)(t >> 3) * kblk + (unsigned)(t & 7) * 128u : (unsigned)t * 128u; }
    DI int nt(const Unit&) const { return NT; }
    DI bool keep(const Unit&) const { return false; }
    DI const char* b_ptr(const Unit& u) const { return Abase + (size_t)offW + (size_t)u.pn * 256 * (LDB_ * 2); }
    DI void epi(Acc& acc, const Unit& u, int wr, int wc, int fr, int fq) const {
#pragma unroll
        for (int ai = 0; ai < 2; ++ai)
#pragma unroll
            for (int m = 0; m < 4; ++m) { const size_t ro = (size_t)PROW_OF(u.pm, ai, m) * D + u.pn * 256 + wc * 32 + 8 * fq;
#pragma unroll
                for (int bj = 0; bj < 2; ++bj) { const u32x4 hv = *(const u32x4*)(H + ro + bj * 128); float h8[8]; unpack8(hv, h8);
                    f32x4 v0 = acc[ai][bj][m][0], v1 = acc[ai][bj][m][1];
#pragma unroll
                    for (int j = 0; j < 4; ++j) { v0[j] += ALPHA * h8[j]; v1[j] += ALPHA * h8[4 + j]; }
                    *(u32x4*)(Y + ro + bj * 128) = pack8(v0, v1); }
                asm volatile("" ::: "memory"); }
    }
};

DI u32x2 swiglu4(const f32x4 g, const f32x4 up) { u32x2 w; w.x = cvt_pk_bf16(silu_(g[0]) * up[0], silu_(g[1]) * up[1]); w.y = cvt_pk_bf16(silu_(g[2]) * up[2], silu_(g[3]) * up[3]); return w; }
DI u32x4 widen_pair(const u32x2 a, const u32x2 b) {
    const auto r0 = __builtin_amdgcn_permlane16_swap(a.x, b.x, false, false); const auto r1 = __builtin_amdgcn_permlane16_swap(a.y, b.y, false, false);
    return (u32x4){r0[0], r1[0], r0[1], r1[1]};
}
struct ProbUpD : ProbBase {
    static constexpr bool PERM = false; static constexpr int NT = 16, LDB = 1024;
    unsigned offW; bf16_t* ACT;
    DI bool next(int i, Unit& u) const { const int L = i * G + c; if (L >= NMTC * 22) return false; const int pk = g8::static_map(L, NMTC, 22); Unit t; t.pm = pk & 0xffff; t.pn = pk >> 16; t.aux = 0; t.x0 = 0; t.x1 = 0; u = t; return true; }
    static constexpr bool GATHER = false;
    DI unsigned ldaB() const { return 2048u; }
    DI unsigned a_unit(const Unit& u) const { return (unsigned)WS_H + (unsigned)crow0(u.pm) * 2048u; }
    DI unsigned koffA(const Unit&, int t) const { return (unsigned)t * 128u; }
    DI int nt(const Unit&) const { return NT; }
    DI bool keep(const Unit&) const { return false; }
    DI const char* b_ptr(const Unit& u) const { return Abase + (size_t)offW + (size_t)u.pn * 256 * 2048; }
    DI void epi(Acc& acc, const Unit& u, int wr, int wc, int fr, int fq) const {
#pragma unroll
        for (int ai = 0; ai < 2; ++ai)
#pragma unroll
            for (int m = 0; m < 4; m += 2) { bf16_t* rowp = ACT + (size_t)ROW_OF(u.pm, ai, m + (fq & 1)) * DFF + u.pn * 128 + wc * 16 + 8 * (fq >> 1);
#pragma unroll
                for (int bj = 0; bj < 2; ++bj) *(u32x4*)(rowp + bj * 64) = widen_pair(swiglu4(acc[ai][bj][m][0], acc[ai][bj][m][1]), swiglu4(acc[ai][bj][m + 1][0], acc[ai][bj][m + 1][1])); }
    }
};

struct MoeTab {
    int cnt[8], tiles[8], ub[9], rb[8], nNt;
    DI void init(const unsigned* cw, int nN) {
        int u = 0, r = 0; nNt = nN;
#pragma unroll
        for (int e = 0; e < 8; ++e) { int c = (int)__builtin_amdgcn_readfirstlane(cw[e]); c = c > MG ? MG : c; cnt[e] = c; tiles[e] = (c + 255) >> 8; ub[e] = u; rb[e] = r; u += tiles[e] * nN; r += tiles[e]; }
        ub[8] = u;
    }
    DI bool find(int L0, Unit& u) const {
        if (L0 >= ub[8]) return false;
        int L = L0; { const int nwg = ub[8], q = nwg / 8, r = nwg % 8, xcd = L0 % 8, off = L0 / 8; L = (xcd < r ? xcd * (q + 1) : r * (q + 1) + (xcd - r) * q) + off; }
        int e = 0;
#pragma unroll
        for (int k = 1; k < 8; ++k) e += (L >= ub[k]) ? 1 : 0;
        int te = 1, ue = 0, re = 0, ce = 0;
#pragma unroll
        for (int k = 0; k < 8; ++k) if (e == k) { te = tiles[k]; ue = ub[k]; re = rb[k]; ce = cnt[k]; }
        const int r = L - ue; const int nig = 4 * nNt, gid = r / nig, w = r % nig, fm = gid * 4, gsz = (te - fm) < 4 ? (te - fm) : 4;
        Unit t; t.pm = fm + w % gsz; t.pn = w / gsz; t.aux = e; t.x0 = re; t.x1 = ce; u = t; return true;
    }
};

struct ProbUpM : ProbBase {
    static constexpr bool PERM = false; static constexpr int NT = 16, LDB = 1024;
    unsigned offW; bf16_t* ACT; const int* list; MoeTab tab;
    DI bool next(int i, Unit& u) const { return tab.find(i * G + c, u); }
    static constexpr bool GATHER = true;
    DI unsigned ldaB() const { return 2048u; }
    DI unsigned a_unit(const Unit&) const { return 0u; }
    DI void a_gather(const Unit& u, const int (&R)[2], const int (&C)[2], unsigned (&vo)[2][2]) const {
        const int* le = list + (size_t)u.aux * MG;
#pragma unroll
        for (int h = 0; h < 2; ++h)
#pragma unroll
            for (int i = 0; i < 2; ++i) { const int pos = u.pm * 256 + h * 128 + R[i]; const int tok = le[pos < u.x1 ? pos : 0];
                vo[h][i] = (unsigned)WS_H + (unsigned)tok * 2048u + (unsigned)C[i] * 2u; }
    }
    DI unsigned koffA(const Unit&, int t) const { return (unsigned)t * 128u; }
    DI int nt(const Unit&) const { return NT; }
    DI bool keep(const Unit&) const { return false; }
    DI const char* b_ptr(const Unit& u) const { return Abase + (size_t)offW + (size_t)u.aux * ((size_t)PROJW * D * 2) + (size_t)u.pn * 256 * 2048; }
    DI void epi(Acc& acc, const Unit& u, int wr, int wc, int fr, int fq) const {
#pragma unroll
        for (int ai = 0; ai < 2; ++ai)
#pragma unroll
            for (int m = 0; m < 4; m += 2) { bf16_t* rowp = ACT + (size_t)ROW_OF(u.x0 + u.pm, ai, m + (fq & 1)) * DFF + u.pn * 128 + wc * 16 + 8 * (fq >> 1);
#pragma unroll
                for (int bj = 0; bj < 2; ++bj) *(u32x4*)(rowp + bj * 64) = widen_pair(swiglu4(acc[ai][bj][m][0], acc[ai][bj][m][1]), swiglu4(acc[ai][bj][m + 1][0], acc[ai][bj][m + 1][1])); }
    }
};
struct ProbDownM : ProbBase {
    static constexpr bool PERM = true; static constexpr int NT = 44, LDB = 2816;
    unsigned offW; bf16_t* YS; const float* wlist; MoeTab tab;
    DI bool next(int i, Unit& u) const { return tab.find(i * G + c, u); }
    static constexpr bool GATHER = false;
    DI unsigned ldaB() const { return DFF * 2u; }
    DI unsigned a_unit(const Unit& u) const { return (unsigned)WS_ACT + (unsigned)(u.x0 + u.pm) * (256u * DFF * 2u); }
    DI unsigned koffA(const Unit&, int t) const { return (unsigned)t * 128u; }
    DI int nt(const Unit&) const { return NT; }
    DI bool keep(const Unit&) const { return false; }
    DI const char* b_ptr(const Unit& u) const { return Abase + (size_t)offW + (size_t)u.aux * ((size_t)D * DFF * 2) + (size_t)u.pn * 256 * (DFF * 2); }
    DI void epi(Acc& acc, const Unit& u, int wr, int wc, int fr, int fq) const {
        const float* we = wlist + (size_t)u.aux * MG;
#pragma unroll
        for (int ai = 0; ai < 2; ++ai)
#pragma unroll
            for (int m = 0; m < 4; ++m) { const int pos = ROW_OF(u.pm, ai, m); const float w = pos < u.x1 ? we[pos] : 0.f;
                bf16_t* rowp = YS + (size_t)(u.x0 * 256 + pos) * D + u.pn * 256 + wc * 32 + 8 * fq;
#pragma unroll
                for (int bj = 0; bj < 2; ++bj) *(u32x4*)(rowp + bj * 128) = pack8(acc[ai][bj][m][0] * w, acc[ai][bj][m][1] * w); }
    }
};

struct Args { const float* in[27]; float* out; unsigned char* ws; };
struct Ctx {
    LAS unsigned char* lds; volatile LAS unsigned* MISC;
    unsigned char* ws; unsigned* ctl; float* out;
    int wave, G, gw, NGW;
};
DI int crow(int r, int hi) { return (r & 3) + 8 * (r >> 2) + 4 * hi; }

DI void transpose_item(const float* W, int N, bf16_t* WT, int ldt, int kofs, int row_off, int mode, LAS float* scr, int item, int lane) {
    const int nblk = N / 32, kb = item / nblk, nb = item % nblk, k0 = 64 * kb, n0 = 32 * nb;
#pragma unroll 8
    for (int i = 0; i < 32; ++i) { const int kk = 2 * i + (lane >> 5); scr[kk * 33 + (lane & 31)] = W[(size_t)(k0 + kk) * N + n0 + (lane & 31)]; }
    asm volatile("s_waitcnt lgkmcnt(0)" ::: "memory");
    const int c = lane & 7;
    const float sc = (mode == 1 && n0 < 512) ? QSCALE : 1.0f;
#pragma unroll
    for (int j = 0; j < 4; ++j) { const int n = (lane >> 3) + 8 * j; const LAS float* s = scr + (8 * c) * 33 + n;
        const int ns = n0 + n; int drow;
        if (mode == 0) drow = row_off + ns;
        else if (mode == 1) drow = ns < 1024 ? ns : (ns < 1536 ? 5120 + (ns - 1024) : ns - 512);
        else drow = 32 * (ns >> 4) + 16 * row_off + (ns & 15);
        u32x4 o; o.x = cvt_pk_bf16(s[0 * 33] * sc, s[1 * 33] * sc); o.y = cvt_pk_bf16(s[2 * 33] * sc, s[3 * 33] * sc); o.z = cvt_pk_bf16(s[4 * 33] * sc, s[5 * 33] * sc); o.w = cvt_pk_bf16(s[6 * 33] * sc, s[7 * 33] * sc);
        *(u32x4*)(WT + (size_t)drow * ldt + kofs + k0 + 8 * c) = o; }
    asm volatile("s_waitcnt lgkmcnt(0)" ::: "memory");
}
DI void prologue(Ctx& F, const Args& a) {
    const int tid = opaque(threadIdx.x), lane = tid & 63;
    LAS float* scr = (LAS float*)(F.lds + F.wave * 16384);
    unsigned char* ws = F.ws;
    constexpr int L_IN = 16 * 176, L_AO = 8 * 32, L_LO = 16 * 32, L_O = 16 * 32, L_G = 32;
    constexpr int L_ALL = L_IN + L_AO + L_LO + L_O + 2 * L_G;
    constexpr int F_G = 16 * 88, F_D = 44 * 32, F_ALL = 2 * F_G + F_D;
    constexpr int NITEMS = DEPTH * L_ALL + 18 * F_ALL;
    for (int it = opaque_s(F.gw); it < NITEMS; it += F.NGW) {
        if (it < DEPTH * L_ALL) {
            const int l = it / L_ALL; int r = it % L_ALL;
            if (r < L_IN) { transpose_item(a.in[4] + (size_t)l * D * PROJW, PROJW, (bf16_t*)(ws + WS_WIN) + (size_t)l * PROJW * D, D, 0, 0, 1, scr, r, lane); continue; } r -= L_IN;
            if (r < L_AO) { transpose_item(a.in[15] + (size_t)l * 512 * D, D, (bf16_t*)(ws + WS_WMIX) + (size_t)l * D * 1536, 1536, 0, 0, 0, scr, r, lane); continue; } r -= L_AO;
            if (r < L_LO) { transpose_item(a.in[16] + (size_t)l * D * D, D, (bf16_t*)(ws + WS_WMIX) + (size_t)l * D * 1536, 1536, 512, 0, 0, scr, r, lane); continue; } r -= L_LO;
            if (r < L_O) { transpose_item(a.in[17] + (size_t)l * D * D, D, (bf16_t*)(ws + WS_WO) + (size_t)l * D * D, D, 0, 0, 0, scr, r, lane); continue; } r -= L_O;
            const int which = r / L_G, hh = (r % L_G) >> 1, sub = r & 1;
            transpose_item(a.in[which ? 12 : 10] + ((size_t)l * 16 + hh) * 4096, 64, (bf16_t*)(ws + (which ? WS_WI : WS_WR)) + ((size_t)l * 16 + hh) * 4096, 64, 0, 0, 0, scr, sub, lane);
        } else {
            const int r0 = it - DEPTH * L_ALL, set = r0 / F_ALL; int r = r0 % F_ALL;
            const float *wg, *wu, *wd; bf16_t *dgu, *dd;
            if (set < 2) { wg = a.in[20] + (size_t)set * D * DFF; wu = a.in[21] + (size_t)set * D * DFF; wd = a.in[22] + (size_t)set * DFF * D;
                dgu = (bf16_t*)(ws + WS_WGUD) + (size_t)set * PROJW * D; dd = (bf16_t*)(ws + WS_WDD) + (size_t)set * D * DFF; }
            else { const int s2 = set - 2; wg = a.in[24] + (size_t)s2 * D * DFF; wu = a.in[25] + (size_t)s2 * D * DFF; wd = a.in[26] + (size_t)s2 * DFF * D;
                dgu = (bf16_t*)(ws + WS_WGUM) + (size_t)s2 * PROJW * D; dd = (bf16_t*)(ws + WS_WDM) + (size_t)s2 * D * DFF; }
            if (r < F_G) { transpose_item(wg, DFF, dgu, D, 0, 0, 2, scr, r, lane); continue; } r -= F_G;
            if (r < F_G) { transpose_item(wu, DFF, dgu, D, 0, 1, 2, scr, r, lane); continue; } r -= F_G;
            transpose_item(wd, D, dd, DFF, 0, 0, 0, scr, r, lane);
        }
    }
    float* tab = (float*)(ws + WS_TAB);
    for (int i = blockIdx.x * 512 + tid; i < DEPTH * D; i += F.G * 512) { const float x = a.in[14][i]; tab[i] = log1pf(expf(-x)); }
    if (blockIdx.x == 0 && tid < DEPTH) { const int l = tid; const float* dl = a.in[6] + l * 128; float s1 = 0.f, s2 = 0.f;
        for (int j = 0; j < 32; ++j) { s1 += dl[j] * dl[32 + j]; s2 += dl[64 + j] * dl[96 + j]; }
        const float lam_init = 0.8f - 0.6f * expf(-0.3f * (float)l);
        tab[DEPTH * D + 2 * l] = expf(s1) - expf(s2) + lam_init; tab[DEPTH * D + 2 * l + 1] = 1.0f - lam_init; }
}

DI void ln_in_phase(Ctx& F, const Args& a, int g) {
    const int tid = opaque(threadIdx.x), lane = tid & 63; (void)tid;
    bf16_t* H = (bf16_t*)(F.ws + WS_H);
    const float* gam = a.in[2]; const float* bet = a.in[3];
    for (int row = opaque_s(F.gw); row < MG; row += F.NGW) {
        const int bl = row / TP, r = row % TP;
        u32x4* o = (u32x4*)(H + (size_t)row * D) + lane;
        const bool padrow = r < PADR;
        const float* src = r < FRAME0 ? a.in[1] + (size_t)(padrow ? 0 : r - PADR) * D : a.in[0] + ((size_t)(g * GB + bl) * SEQ + (r - FRAME0)) * D;
        f32x4 v[4]; float s = 0.f;
#pragma unroll
        for (int j = 0; j < 4; ++j) { v[j] = *(const f32x4*)(src + (j >> 1) * 512 + lane * 8 + (j & 1) * 4); s += (v[j][0] + v[j][1]) + (v[j][2] + v[j][3]); }
        const float mean = wave_sum(s) * (1.f / D); float s2 = 0.f;
#pragma unroll
        for (int j = 0; j < 4; ++j) { v[j] = v[j] - mean; s2 += (v[j][0] * v[j][0] + v[j][1] * v[j][1]) + (v[j][2] * v[j][2] + v[j][3] * v[j][3]); }
        const float rstd = 1.f / sqrtf(wave_sum(s2) * (1.f / D) + 1e-5f);
#pragma unroll
        for (int j = 0; j < 4; ++j) { const int c0 = (j >> 1) * 512 + lane * 8 + (j & 1) * 4; const f32x4 gg = *(const f32x4*)(gam + c0), bb = *(const f32x4*)(bet + c0); v[j] = v[j] * rstd * gg + bb; }
        u32x4 w0 = pack8(v[0], v[1]), w1 = pack8(v[2], v[3]);
        if (padrow) { w0 = (u32x4){0u, 0u, 0u, 0u}; w1 = w0; }
        o[0] = w0; o[64] = w1;
    }
}

template <int MODE, bool FINAL>
DI void ln_phase(Ctx& F, const Args& a, int g, const float* gam, const float* bet, const float* router, unsigned* cntw) {
    const int tid = opaque(threadIdx.x), lane = tid & 63; (void)tid;
    bf16_t* H = (bf16_t*)(F.ws + WS_H);
    const bf16_t* Y = (const bf16_t*)((const unsigned char*)F.out + OUT_Y);
    const bf16_t* YS = (const bf16_t*)(F.ws + WS_YSLOT);
    unsigned* tokinfo = (unsigned*)(F.ws + WS_ROUTE);
    int* list = (int*)(F.ws + WS_ROUTE + (size_t)MG * 32);
    float* wlist = (float*)(F.ws + WS_ROUTE + (size_t)MG * 32 + (size_t)8 * MG * 4);
    LAS float* wrt = (LAS float*)F.lds;
    LAS unsigned* recs = (LAS unsigned*)(F.lds + 32768);
    LAS unsigned* lcnt = (LAS unsigned*)(F.lds + 32768 + 8 * 20 * 32);
    LAS unsigned* lbase = lcnt + 8;
    int rbase[8]; int nrec = 0;
    const int gw0 = opaque_s(F.gw);
    if (MODE == 1) {
        for (int i = tid; i < 8 * D; i += 512) { const int c = i >> 3, e = i & 7; wrt[e * D + c] = router[i]; }
        if (tid < 32) lcnt[tid] = 0u;
        __syncthreads();
    }
    if (MODE == 3) { int r = 0;
#pragma unroll
        for (int e = 0; e < 8; ++e) { int c = (int)__builtin_amdgcn_readfirstlane(cntw[e]); c = c > MG ? MG : c; rbase[e] = r; r += ((c + 255) >> 8) * 256; } }
    for (int row = gw0; row < MG; row += F.NGW) {
        const int rbl = row / TP, rrr = row % TP;
        if (rrr < FRAME0 && (rbl != 0 || rrr < PADR)) continue;
        float v[16];
        if (MODE == 3) {
            const u32x4 ti = *(const u32x4*)(tokinfo + (size_t)row * 8);
            int s1 = 0, s2 = 0;
#pragma unroll
            for (int e = 0; e < 8; ++e) { if ((int)ti.x == e) s1 = rbase[e] + (int)ti.y; if ((int)ti.z == e) s2 = rbase[e] + (int)ti.w; }
#pragma unroll
            for (int hh = 0; hh < 2; ++hh) { const int c0 = hh * 512 + lane * 8;
                const u32x4 hv = *(const u32x4*)(H + (size_t)row * D + c0), y1 = *(const u32x4*)(YS + (size_t)s1 * D + c0), y2 = *(const u32x4*)(YS + (size_t)s2 * D + c0);
                float h8[8], a8[8], b8[8]; unpack8(hv, h8); unpack8(y1, a8); unpack8(y2, b8);
#pragma unroll
                for (int j = 0; j < 8; ++j) v[hh * 8 + j] = ALPHA * h8[j] + (a8[j] + b8[j]); }
        } else {
#pragma unroll
            for (int hh = 0; hh < 2; ++hh) { const u32x4 yv = *(const u32x4*)(Y + (size_t)row * D + hh * 512 + lane * 8); float y8[8]; unpack8(yv, y8);
#pragma unroll
                for (int j = 0; j < 8; ++j) v[hh * 8 + j] = y8[j]; }
        }
        float s = 0.f;
#pragma unroll
        for (int j = 0; j < 16; ++j) s += v[j];
        const float mean = wave_sum(s) * (1.f / D); float s2 = 0.f;
#pragma unroll
        for (int j = 0; j < 16; ++j) { v[j] -= mean; s2 += v[j] * v[j]; }
        const float rstd = 1.f / sqrtf(wave_sum(s2) * (1.f / D) + 1e-5f);
#pragma unroll
        for (int hh = 0; hh < 2; ++hh) { const int c0 = hh * 512 + lane * 8;
#pragma unroll
            for (int q = 0; q < 2; ++q) { const f32x4 gg = *(const f32x4*)(gam + c0 + 4 * q), bb = *(const f32x4*)(bet + c0 + 4 * q);
#pragma unroll
                for (int j = 0; j < 4; ++j) v[hh * 8 + q * 4 + j] = v[hh * 8 + q * 4 + j] * rstd * gg[j] + bb[j]; } }
#pragma unroll
        for (int hh = 0; hh < 2; ++hh) { u32x4 w; w.x = cvt_pk_bf16(v[hh * 8 + 0], v[hh * 8 + 1]); w.y = cvt_pk_bf16(v[hh * 8 + 2], v[hh * 8 + 3]); w.z = cvt_pk_bf16(v[hh * 8 + 4], v[hh * 8 + 5]); w.w = cvt_pk_bf16(v[hh * 8 + 6], v[hh * 8 + 7]);
            *(u32x4*)(H + (size_t)row * D + hh * 512 + lane * 8) = w;
            if (rrr < FRAME0) {
#pragma unroll
                for (int k = 1; k < GB; ++k) *(u32x4*)(H + ((size_t)row + (size_t)k * TP) * D + hh * 512 + lane * 8) = w; } }
        if (FINAL) {
            const int bl = row / TP, r = row % TP;
            if (r >= FRAME0) { float* op = F.out + ((size_t)(g * GB + bl) * SEQ + (r - FRAME0)) * D;
#pragma unroll
                for (int hh = 0; hh < 2; ++hh)
#pragma unroll
                    for (int q = 0; q < 2; ++q) *(f32x4*)(op + hh * 512 + lane * 8 + 4 * q) = (f32x4){v[hh * 8 + q * 4], v[hh * 8 + q * 4 + 1], v[hh * 8 + q * 4 + 2], v[hh * 8 + q * 4 + 3]}; }
        }
        if (MODE == 1) {
            float lg[8];
#pragma unroll
            for (int e = 0; e < 8; ++e) { float acc = 0.f;
#pragma unroll
                for (int hh = 0; hh < 2; ++hh) { const LAS f32x4* wp = (const LAS f32x4*)(wrt + e * D + hh * 512 + lane * 8); const f32x4 w0 = wp[0], w1 = wp[1];
#pragma unroll
                    for (int j = 0; j < 4; ++j) acc += v[hh * 8 + j] * w0[j] + v[hh * 8 + 4 + j] * w1[j]; }
                lg[e] = wave_sum(acc); }
            int e1 = 0; float l1 = lg[0];
#pragma unroll
            for (int e = 1; e < 8; ++e) if (lg[e] > l1) { l1 = lg[e]; e1 = e; }
            int e2 = -1; float l2 = -INFINITY;
#pragma unroll
            for (int e = 0; e < 8; ++e) if (e != e1 && lg[e] > l2) { l2 = lg[e]; e2 = e; }
            const float w2 = rcpf_(1.0f + ex2(LOG2E * (l1 - l2))), w1 = 1.0f - w2;
            if (lane == 0) {
                const unsigned q1 = __hip_atomic_fetch_add(lcnt + e1, 1u, __ATOMIC_RELAXED, __HIP_MEMORY_SCOPE_WORKGROUP), q2 = __hip_atomic_fetch_add(lcnt + e2, 1u, __ATOMIC_RELAXED, __HIP_MEMORY_SCOPE_WORKGROUP);
                LAS unsigned* rc = recs + (F.wave * 20 + nrec) * 8;
                rc[0] = (unsigned)e1; rc[1] = q1; rc[2] = (unsigned)e2; rc[3] = q2; rc[4] = __float_as_uint(w1); rc[5] = __float_as_uint(w2); rc[6] = (unsigned)row;
            }
            ++nrec;
        }
    }
    if (MODE == 1) {
        if (lane == 0) lcnt[16 + F.wave] = (unsigned)nrec;
        __syncthreads();
        if (tid < 8) lbase[tid] = atomicAdd(cntw + tid, lcnt[tid]);
        __syncthreads();
        const int wv = tid / 20, k = tid % 20;
        if (wv < 8 && k < (int)lcnt[16 + (wv & 7)]) {
            const LAS unsigned* rc = recs + (wv * 20 + k) * 8;
            const unsigned e1 = rc[0], e2 = rc[2], p1 = lbase[e1] + rc[1], p2 = lbase[e2] + rc[3]; const int row = (int)rc[6];
            *(u32x4*)(tokinfo + (size_t)row * 8) = (u32x4){e1, p1, e2, p2};
            if (p1 < (unsigned)MG) { list[(size_t)e1 * MG + p1] = row; wlist[(size_t)e1 * MG + p1] = __uint_as_float(rc[4]); }
            if (p2 < (unsigned)MG) { list[(size_t)e2 * MG + p2] = row; wlist[(size_t)e2 * MG + p2] = __uint_as_float(rc[5]); }
        }
        __syncthreads();
    }
}

template <int MODE, bool FINAL>
DI void ln_fast(Ctx& F, const Args& a, int g, const float* gam, const float* bet, unsigned* cntw) {
    constexpr int R = 4;
    const int lane = opaque(threadIdx.x) & 63;
    bf16_t* H = (bf16_t*)(F.ws + WS_H);
    const bf16_t* Y = (const bf16_t*)((const unsigned char*)F.out + OUT_Y);
    const bf16_t* YS = (const bf16_t*)(F.ws + WS_YSLOT);
    const unsigned* tokinfo = (const unsigned*)(F.ws + WS_ROUTE);
    int rbase[8];
    if (MODE == 3) { int r = 0;
#pragma unroll
        for (int e = 0; e < 8; ++e) { int c = (int)__builtin_amdgcn_readfirstlane(cntw[e]); c = c > MG ? MG : c; rbase[e] = r; r += ((c + 255) >> 8) * 256; } }
    float gv[16], bv[16];
#pragma unroll
    for (int hh = 0; hh < 2; ++hh)
#pragma unroll
        for (int q = 0; q < 2; ++q) { const f32x4 gg = *(const f32x4*)(gam + hh * 512 + lane * 8 + 4 * q), bb = *(const f32x4*)(bet + hh * 512 + lane * 8 + 4 * q);
#pragma unroll
            for (int j = 0; j < 4; ++j) { gv[hh * 8 + q * 4 + j] = gg[j]; bv[hh * 8 + q * 4 + j] = bb[j]; } }
    for (int base = opaque_s(F.gw) * R; base < MG; base += F.NGW * R) {
        float v[R][16]; bool ok[R]; int rr_[R];
#pragma unroll
        for (int r = 0; r < R; ++r) { const int row = base + r; const int rbl = row / TP, rrr = row % TP; rr_[r] = rrr; ok[r] = !(rrr < FRAME0 && (rbl != 0 || rrr < PADR)); }
        if (MODE == 3) {
            u32x4 ti[R];
#pragma unroll
            for (int r = 0; r < R; ++r) ti[r] = *(const u32x4*)(tokinfo + (size_t)(base + r) * 8);
#pragma unroll
            for (int r = 0; r < R; ++r) { int s1 = 0, s2 = 0;
                if (ok[r]) {
#pragma unroll
                    for (int e = 0; e < 8; ++e) { if ((int)ti[r].x == e) s1 = rbase[e] + (int)ti[r].y; if ((int)ti[r].z == e) s2 = rbase[e] + (int)ti[r].w; } }
                s1 = s1 < SLOT_ROWS ? s1 : 0; s2 = s2 < SLOT_ROWS ? s2 : 0;
#pragma unroll
                for (int hh = 0; hh < 2; ++hh) { const int c0 = hh * 512 + lane * 8;
                    const u32x4 hv = *(const u32x4*)(H + (size_t)(base + r) * D + c0), y1 = *(const u32x4*)(YS + (size_t)s1 * D + c0), y2 = *(const u32x4*)(YS + (size_t)s2 * D + c0);
                    float h8[8], a8[8], b8[8]; unpack8(hv, h8); unpack8(y1, a8); unpack8(y2, b8);
#pragma unroll
                    for (int j = 0; j < 8; ++j) v[r][hh * 8 + j] = ALPHA * h8[j] + (a8[j] + b8[j]); } }
        } else {
#pragma unroll
            for (int r = 0; r < R; ++r)
#pragma unroll
                for (int hh = 0; hh < 2; ++hh) { const u32x4 yv = *(const u32x4*)(Y + (size_t)(base + r) * D + hh * 512 + lane * 8); float y8[8]; unpack8(yv, y8);
#pragma unroll
                    for (int j = 0; j < 8; ++j) v[r][hh * 8 + j] = y8[j]; }
        }
        float sm[R], sq[R];
#pragma unroll
        for (int r = 0; r < R; ++r) { float s = 0.f;
#pragma unroll
            for (int j = 0; j < 16; ++j) s += v[r][j];
            sm[r] = s; }
#pragma unroll
        for (int r = 0; r < R; ++r) sm[r] = wave_sum(sm[r]);
#pragma unroll
        for (int r = 0; r < R; ++r) { const float mean = sm[r] * (1.f / D); float s2 = 0.f;
#pragma unroll
            for (int j = 0; j < 16; ++j) { v[r][j] -= mean; s2 += v[r][j] * v[r][j]; }
            sq[r] = s2; }
#pragma unroll
        for (int r = 0; r < R; ++r) sq[r] = wave_sum(sq[r]);
#pragma unroll
        for (int r = 0; r < R; ++r) {
            const float rstd = 1.f / sqrtf(sq[r] * (1.f / D) + 1e-5f);
#pragma unroll
            for (int j = 0; j < 16; ++j) v[r][j] = v[r][j] * rstd * gv[j] + bv[j];
            if (ok[r]) {
                const int row = base + r;
                if (!FINAL)
#pragma unroll
                for (int hh = 0; hh < 2; ++hh) { u32x4 w; w.x = cvt_pk_bf16(v[r][hh * 8 + 0], v[r][hh * 8 + 1]); w.y = cvt_pk_bf16(v[r][hh * 8 + 2], v[r][hh * 8 + 3]); w.z = cvt_pk_bf16(v[r][hh * 8 + 4], v[r][hh * 8 + 5]); w.w = cvt_pk_bf16(v[r][hh * 8 + 6], v[r][hh * 8 + 7]);
                    *(u32x4*)(H + (size_t)row * D + hh * 512 + lane * 8) = w;
                    if (rr_[r] < FRAME0) {
#pragma unroll
                        for (int k = 1; k < GB; ++k) *(u32x4*)(H + ((size_t)row + (size_t)k * TP) * D + hh * 512 + lane * 8) = w; } }
                if (FINAL && rr_[r] >= FRAME0) { float* op = F.out + ((size_t)(g * GB + row / TP) * SEQ + (rr_[r] - FRAME0)) * D;
#pragma unroll
                    for (int hh = 0; hh < 2; ++hh)
#pragma unroll
                        for (int q = 0; q < 2; ++q) *(f32x4*)(op + hh * 512 + lane * 8 + 4 * q) = (f32x4){v[r][hh * 8 + q * 4], v[r][hh * 8 + q * 4 + 1], v[r][hh * 8 + q * 4 + 2], v[r][hh * 8 + q * 4 + 3]}; }
            }
        }
    }
}

constexpr int NSC = 16;
constexpr int LRU_WAVE_LDS = 14336;
template <bool PASS2, bool META = false>
DI void lru_phase(Ctx& F, const Args& a, int l, bool dummy = false) {
    const int lane = opaque(threadIdx.x) & 63, r32 = lane & 31, hi = lane >> 5;
    bf16_t* Z = (bf16_t*)(F.ws + WS_Z);
    const bf16_t* WrT = (const bf16_t*)(F.ws + WS_WR) + (size_t)l * 16 * 4096;
    const bf16_t* WiT = (const bf16_t*)(F.ws + WS_WI) + (size_t)l * 16 * 4096;
    float* aggA = (float*)(F.ws + WS_AGG); float* aggH = aggA + (size_t)GB * NSC * D; float* aggM = aggH + (size_t)GB * NSC * D;
    const float* spt = (const float*)(F.ws + WS_TAB) + l * D;
    const float* cw = a.in[8] + (size_t)l * 4 * D; const float* cbv = a.in[9] + (size_t)l * D;
    const float* brv = a.in[11] + (size_t)l * D; const float* biv = a.in[13] + (size_t)l * D;
    LAS bf16_t* xraw = (LAS bf16_t*)(F.lds + F.wave * LRU_WAVE_LDS);
    LAS bf16_t* xcb = xraw + 2560;
    LAS bf16_t* gbf = xcb + 2304;
    for (int unit = opaque_s(F.gw); unit < (META ? 16 : GB * 16 * NSC); unit += F.NGW) {
        const int head = unit & 15, sc = META ? 0 : (unit >> 4) & 15, bl = META ? 0 : unit >> 8;
        const int t0 = META ? 1 : 2 + 8 * sc, ntile = opaque_s(META ? 1 : 8);
        const size_t rowb = (size_t)bl * TP;
        bf16x8 wrf[2][4], wif[2][4];
#pragma unroll
        for (int ct = 0; ct < 2; ++ct)
#pragma unroll
            for (int ks = 0; ks < 4; ++ks) { const size_t o = (size_t)(head * 64 + ct * 32 + r32) * 64 + ks * 16 + hi * 8; wrf[ct][ks] = *(const bf16x8*)(WrT + o); wif[ct][ks] = *(const bf16x8*)(WiT + o); }
        float c0[2], c1[2], c2[2], c3[2], cb[2], br[2], bi[2], sp8[2], hst[2], apr[2];
#pragma unroll
        for (int ct = 0; ct < 2; ++ct) { const int ch = head * 64 + ct * 32 + r32;
            c0[ct] = cw[ch]; c1[ct] = cw[D + ch]; c2[ct] = cw[2 * D + ch]; c3[ct] = cw[3 * D + ch]; cb[ct] = cbv[ch]; br[ct] = -LOG2E * brv[ch]; bi[ct] = -LOG2E * biv[ch]; sp8[ct] = -8.0f * LOG2E * spt[ch];
            hst[ct] = 0.f; apr[ct] = 1.f; }
        if (PASS2 && !META) {
#pragma unroll
            for (int ct = 0; ct < 2; ++ct) hst[ct] = aggM[head * 64 + ct * 32 + r32];
#pragma unroll
            for (int kb = 0; kb < 2; ++kb) { float fa[2][8], fh[2][8];
#pragma unroll
                for (int k = 0; k < 8; ++k)
#pragma unroll
                    for (int ct = 0; ct < 2; ++ct) { const int kk = kb * 8 + k; const bool on = kk < sc; const size_t o = ((size_t)bl * NSC + (on ? kk : 0)) * D + head * 64 + ct * 32 + r32;
                        const float av = aggA[o], hv = aggH[o]; fa[ct][k] = on ? av : 1.0f; fh[ct][k] = on ? hv : 0.f; }
#pragma unroll
                for (int k = 0; k < 8; ++k)
#pragma unroll
                    for (int ct = 0; ct < 2; ++ct) hst[ct] = fa[ct][k] * hst[ct] + fh[ct][k]; }
        }
        u32x4 px[5], pg[4];
#define LRU_LOAD(tile) do { const int _r0 = (tile) * 32; \
            _Pragma("unroll") for (int k = 0; k < 5; ++k) { const int p = lane + 64 * k; const int j = p >> 3, c8 = p & 7; const int rr = _r0 - 3 + j; const int rc = rr < 0 ? 0 : rr; \
                u32x4 v = (u32x4){0u, 0u, 0u, 0u}; if (p < 280) v = *(const u32x4*)(Z + ZOFF(rowb + rc, ZXR + head * 64 + c8 * 8)); if (META && rr < PADR) v = (u32x4){0u, 0u, 0u, 0u}; px[k] = v; } \
            if (PASS2) { _Pragma("unroll") for (int k = 0; k < 4; ++k) { const int p = lane + 64 * k; pg[k] = *(const u32x4*)(Z + ZOFF(rowb + _r0 + (p >> 3), ZGR + head * 64 + (p & 7) * 8)); } } } while (0)
        LRU_LOAD(t0);
        for (int ti = 0; ti < ntile; ++ti) {
            const int r0 = (t0 + ti) * 32;
#pragma unroll
            for (int k = 0; k < 5; ++k) { const int p = lane + 64 * k; if (p < 280) *(LAS u32x4*)(xraw + (p >> 3) * 72 + (p & 7) * 8) = px[k]; }
            if (PASS2) {
#pragma unroll
                for (int k = 0; k < 4; ++k) { const int p = lane + 64 * k; *(LAS u32x4*)(gbf + (p >> 3) * 72 + (p & 7) * 8) = pg[k]; } }
            if (ti + 1 < ntile) LRU_LOAD(t0 + ti + 1);
            f32x16 xc[2];
#pragma unroll
            for (int ct = 0; ct < 2; ++ct) {
#pragma unroll
                for (int sg = 0; sg < 4; ++sg) { float xw[7];
#pragma unroll
                    for (int d = 0; d < 7; ++d) xw[d] = bf2f(xraw[(8 * sg + 4 * hi + d) * 72 + ct * 32 + r32]);
#pragma unroll
                    for (int q = 0; q < 4; ++q) xc[ct][4 * sg + q] = cb[ct] + c0[ct] * xw[q] + c1[ct] * xw[q + 1] + c2[ct] * xw[q + 2] + c3[ct] * xw[q + 3]; } }
#pragma unroll
            for (int ct = 0; ct < 2; ++ct)
#pragma unroll
                for (int r = 0; r < 16; ++r) xcb[crow(r, hi) * 72 + ct * 32 + r32] = f2bf(xc[ct][r]);
            bf16x8 af[4];
#pragma unroll
            for (int ks = 0; ks < 4; ++ks) af[ks] = *(const LAS bf16x8*)(xcb + r32 * 72 + ks * 16 + hi * 8);
#pragma unroll
            for (int ct = 0; ct < 2; ++ct) {
                f32x16 grx, gix;
#pragma unroll
                for (int r = 0; r < 16; ++r) { grx[r] = 0.f; gix[r] = 0.f; }
#pragma unroll
                for (int ks = 0; ks < 4; ++ks) { grx = __builtin_amdgcn_mfma_f32_32x32x16_bf16(af[ks], wrf[ct][ks], grx, 0, 0, 0); gix = __builtin_amdgcn_mfma_f32_32x32x16_bf16(af[ks], wif[ct][ks], gix, 0, 0, 0); }
                f32x16 av, uv;
#pragma unroll
                for (int r = 0; r < 16; ++r) { const float rg = rcpf_(1.0f + ex2(__builtin_fmaf(grx[r], -LOG2E, br[ct]))), ig = rcpf_(1.0f + ex2(__builtin_fmaf(gix[r], -LOG2E, bi[ct])));
                    const float aa = ex2(sp8[ct] * rg); const float m2 = 1.0f - aa * aa; const float mult = __builtin_amdgcn_sqrtf(__builtin_fmaxf(m2, 0.f));
                    const bool pad = (r0 + crow(r, hi)) < PADR;
                    av[r] = pad ? 1.0f : aa; uv[r] = pad ? 0.f : mult * ig * xc[ct][r]; }
                float As[4], Us[4];
#pragma unroll
                for (int sg = 0; sg < 4; ++sg) { As[sg] = (av[4 * sg] * av[4 * sg + 1]) * (av[4 * sg + 2] * av[4 * sg + 3]);
                    Us[sg] = ((uv[4 * sg] * av[4 * sg + 1] + uv[4 * sg + 1]) * av[4 * sg + 2] + uv[4 * sg + 2]) * av[4 * sg + 3] + uv[4 * sg + 3]; }
                float h = hst[ct], hs[4];
#pragma unroll
                for (int sg = 0; sg < 4; ++sg) { const float he0 = As[sg] * h + Us[sg]; const float t = bcast_lo(he0);
                    const float he1 = As[sg] * t + Us[sg];
                    hs[sg] = hi ? t : h; h = bcast_hi(he1); }
                hst[ct] = h;
                if (!PASS2) { const float own = (As[0] * As[1]) * (As[2] * As[3]); apr[ct] *= bcast_lo(own) * bcast_hi(own); }
                else {
#pragma unroll
                    for (int sg = 0; sg < 4; ++sg) { float hh = hs[sg];
#pragma unroll
                        for (int q = 0; q < 4; ++q) { hh = av[4 * sg + q] * hh + uv[4 * sg + q];
                            LAS bf16_t* p = gbf + (8 * sg + 4 * hi + q) * 72 + ct * 32 + r32; *p = f2bf(hh * bf2f(*p)); } }
                }
            }
            if (PASS2) {
#pragma unroll
                for (int k = 0; k < 4; ++k) { const int p = lane + 64 * k; const u32x4 v = *(const LAS u32x4*)(gbf + (p >> 3) * 72 + (p & 7) * 8);
                    bf16_t* dst = dummy ? (bf16_t*)(F.ws + WS_YSLOT) + (rowb + r0 + (p >> 3)) * 1024 + head * 64 + (p & 7) * 8 : Z + ZOFF(rowb + r0 + (p >> 3), ZGR + head * 64 + (p & 7) * 8);
                    *(u32x4*)dst = v; } }
        }
#undef LRU_LOAD
        if (!PASS2 && hi == 0) {
#pragma unroll
            for (int ct = 0; ct < 2; ++ct) { const size_t o = ((size_t)bl * NSC + sc) * D + head * 64 + ct * 32 + r32; aggA[o] = apr[ct]; aggH[o] = hst[ct]; } }
        if (META && hi == 0) {
#pragma unroll
            for (int ct = 0; ct < 2; ++ct) aggM[head * 64 + ct * 32 + r32] = hst[ct]; }
    }
}

DI float max3f(float a, float b, float c) { float r; asm("v_max3_f32 %0, %1, %2, %3" : "=v"(r) : "v"(a), "v"(b), "v"(c)); return r; }
DI float max16f(const f32x16& a) { float r;
    asm("v_max3_f32 %0, %1, %2, %3\n\tv_max3_f32 %0, %0, %4, %5\n\tv_max3_f32 %0, %0, %6, %7\n\tv_max3_f32 %0, %0, %8, %9\n\tv_max3_f32 %0, %0, %10, %11\n\tv_max3_f32 %0, %0, %12, %13\n\tv_max3_f32 %0, %0, %14, %15\n\tv_max3_f32 %0, %0, %16, %16"
        : "=&v"(r) : "v"(a[0]), "v"(a[1]), "v"(a[2]), "v"(a[3]), "v"(a[4]), "v"(a[5]), "v"(a[6]), "v"(a[7]), "v"(a[8]), "v"(a[9]), "v"(a[10]), "v"(a[11]), "v"(a[12]), "v"(a[13]), "v"(a[14]), "v"(a[15]));
    return r; }
DI float max16f(float acc, const f32x16& a) {
    asm("v_max3_f32 %0, %0, %1, %2\n\tv_max3_f32 %0, %0, %3, %4\n\tv_max3_f32 %0, %0, %5, %6\n\tv_max3_f32 %0, %0, %7, %8\n\tv_max3_f32 %0, %0, %9, %10\n\tv_max3_f32 %0, %0, %11, %12\n\tv_max3_f32 %0, %0, %13, %14\n\tv_max3_f32 %0, %0, %15, %16"
        : "+v"(acc) : "v"(a[0]), "v"(a[1]), "v"(a[2]), "v"(a[3]), "v"(a[4]), "v"(a[5]), "v"(a[6]), "v"(a[7]), "v"(a[8]), "v"(a[9]), "v"(a[10]), "v"(a[11]), "v"(a[12]), "v"(a[13]), "v"(a[14]), "v"(a[15]));
    return acc; }
constexpr float ATT_PBIG = 4096.0f, ATT_MARGIN = 6.0f;
DI void attn_qk(const LAS unsigned char* Kb, const bf16x8 (&qf)[2][2], const float nref, f32x16 (&S)[2][2], int koff, int kswz, int hi) {
    f32x16 Cneg;
#pragma unroll
    for (int r = 0; r < 16; ++r) Cneg[r] = nref;
#pragma unroll
    for (int s = 0; s < 2; ++s)
#pragma unroll
        for (int hf = 0; hf < 2; ++hf)
#pragma unroll
            for (int m = 0; m < 2; ++m) { const bf16x8 kfr = *(const LAS bf16x8*)(Kb + hf * 4096 + koff + (((m * 4 + s * 2 + hi) ^ kswz) * 16));
                S[m][hf] = __builtin_amdgcn_mfma_f32_32x32x16_bf16(kfr, qf[m][s], s == 0 ? Cneg : S[m][hf], 0, 0, 0); }
}
DI void attn_exps(f32x16 (&S)[2][2], float (&ps)[2]) {
#pragma unroll
    for (int m = 0; m < 2; ++m) { float t = 0.f;
#pragma unroll
        for (int hf = 0; hf < 2; ++hf)
#pragma unroll
            for (int r = 0; r < 16; ++r) { S[m][hf][r] = ex2(S[m][hf][r]); t += S[m][hf][r]; }
        ps[m] = t; }
}
#define ATT_LOADV() do { _Pragma("unroll") for (int vh = 0; vh < 2; ++vh) _Pragma("unroll") for (int s = 0; s < 4; ++s) vf[vh][s] = *(const LAS bf16x8*)(Vb + vh * 4096 + voff + (((s * 2 + hi) ^ vswz) * 16)); } while (0)
DI void attn_tile(const LAS unsigned char* Kb, bool first, const bf16x8 (&qf)[2][2], f32x16 (&O)[2][2], float& nref, float (&lrun)[2], int koff, int kswz, int voff, int vswz, int hi) {
    const LAS unsigned char* Vb = Kb + 8192;
    f32x16 S[2][2]; bf16x8 vf[2][4]; float ps[2];
    bool slow = first;
    if (!first) {
        attn_qk(Kb, qf, nref, S, koff, kswz, hi);
        asm volatile("" ::: "memory");
        ATT_LOADV();
        attn_exps(S, ps);
        slow = __any(__builtin_fmaxf(ps[0], ps[1]) > ATT_PBIG); }
    if (slow) {
        attn_qk(Kb, qf, nref, S, koff, kswz, hi);
        asm volatile("s_nop 15\n\ts_nop 7" : "+v"(S[0][0]), "+v"(S[0][1]), "+v"(S[1][0]), "+v"(S[1][1]) :: "memory");
        ATT_LOADV();
        if (first) {
#pragma unroll
            for (int m = 0; m < 2; ++m) {
#pragma unroll
                for (int r = 0; r < 16; ++r) S[m][0][r] = -INFINITY;
#pragma unroll
                for (int r = 0; r < 8; ++r) S[m][1][r] = -INFINITY; } }
        float mxb;
        { float mx0 = max16f(max16f(S[0][0]), S[0][1]), mx1 = max16f(max16f(S[1][0]), S[1][1]); mxb = __builtin_fmaxf(mx0, mx1);
          const auto rr = __builtin_amdgcn_permlane32_swap(__float_as_uint(mxb), __float_as_uint(mxb), false, false); mxb = __builtin_fmaxf(__uint_as_float(rr[0]), __uint_as_float(rr[1])); }
        const float d = __builtin_fmaxf(mxb + ATT_MARGIN, first ? -INFINITY : 0.f); const float alpha = ex2(__builtin_fminf(-d, 0.f));
#pragma unroll
        for (int m = 0; m < 2; ++m) { lrun[m] *= alpha;
#pragma unroll
            for (int vh = 0; vh < 2; ++vh)
#pragma unroll
                for (int r = 0; r < 16; ++r) O[m][vh][r] *= alpha;
#pragma unroll
            for (int hf = 0; hf < 2; ++hf)
#pragma unroll
                for (int r = 0; r < 16; ++r) S[m][hf][r] -= d; }
        nref -= d;
        attn_exps(S, ps); }
#pragma unroll
    for (int m = 0; m < 2; ++m) {
        lrun[m] += ps[m];
#pragma unroll
        for (int s = 0; s < 4; ++s) { const int hf = s >> 1, b0 = 8 * (s & 1);
            u32x4 w; w.x = cvt_pk_bf16(S[m][hf][b0], S[m][hf][b0 + 1]); w.y = cvt_pk_bf16(S[m][hf][b0 + 2], S[m][hf][b0 + 3]); w.z = cvt_pk_bf16(S[m][hf][b0 + 4], S[m][hf][b0 + 5]); w.w = cvt_pk_bf16(S[m][hf][b0 + 6], S[m][hf][b0 + 7]);
            const bf16x8 pfr = __builtin_bit_cast(bf16x8, w);
#pragma unroll
            for (int vh = 0; vh < 2; ++vh) O[m][vh] = __builtin_amdgcn_mfma_f32_32x32x16_bf16(vf[vh][s], pfr, O[m][vh], 0, 0, 0); }
    }
}
#undef ATT_LOADV
constexpr int ATT_BUFB = 16384;
DI void attn_unit(Ctx& F, const Args& a, int l, int bl, int head, int j, bool dummy) {
    const int lane = opaque(threadIdx.x) & 63, r32 = lane & 31, hi = lane >> 5;
    const int wid = F.wave;
    bf16_t* Z = (bf16_t*)(F.ws + WS_Z); const bf16_t* VT = (const bf16_t*)(F.ws + WS_VT);
    const float* tab = (const float*)(F.ws + WS_TAB) + DEPTH * D + 2 * l;
    const float lam = tab[0], omli = tab[1];
    const int qt0 = j == 0 ? 0 : 4 * j - 3, nq = j == 0 ? 1 : 4;
    const int myqt = qt0 + (wid >> 1);
    const bool active = (wid >> 1) < nq;
    const int ktlast = qt0 + nq - 1;
    const int qb = (active ? myqt : qt0) * 2 + (wid & 1);
    const size_t rowq = (size_t)bl * TP + qb * 32 + r32;
    bf16_t* zq = Z + ZOFF(rowq, ZQ + head * 64);
    const int drow = 8 * wid + (lane >> 3), dch = (lane & 7) ^ ((drow >> 1) & 7);
    const unsigned kso = (unsigned)ZOFF((size_t)bl * TP + drow, ZK + head * 64 + dch * 8);
    const unsigned vso = (unsigned)((size_t)(head * 64 + drow) * MG + (size_t)bl * TP + dch * 8);
    LAS unsigned char* ring = F.lds;
#define ATT_ISSUE(kt) do { const int _b = ((kt) % 4) * ATT_BUFB + wid * 1024; \
        __builtin_amdgcn_global_load_lds((const unsigned*)(Z + (kso + (unsigned)(kt) * (64u * 512u))), (LAS unsigned*)(ring + _b), 16, 0, 0); \
        __builtin_amdgcn_global_load_lds((const unsigned*)(VT + (vso + (unsigned)(kt) * 64u)), (LAS unsigned*)(ring + _b + 8192), 16, 0, 0); } while (0)
    bf16x8 qf[2][2];
#pragma unroll
    for (int m = 0; m < 2; ++m)
#pragma unroll
        for (int s = 0; s < 2; ++s) qf[m][s] = *(const bf16x8*)(zq + m * 32 + s * 16 + hi * 8);
    if (wid >= 4) __builtin_amdgcn_s_setprio(1);
    ATT_ISSUE(0);
    if (ktlast >= 1) ATT_ISSUE(1);
    if (ktlast >= 2) ATT_ISSUE(2);
    f32x16 O[2][2];
#pragma unroll
    for (int m = 0; m < 2; ++m)
#pragma unroll
        for (int vh = 0; vh < 2; ++vh)
#pragma unroll
            for (int r = 0; r < 16; ++r) O[m][vh][r] = 0.f;
    float lrun[2] = {0.f, 0.f};
    float nref = 0.f;
    const int pr = (r32 & ~12) | ((r32 & 4) << 1) | ((r32 & 8) >> 1);
    const int koff = pr * 128, kswz = (pr >> 1) & 7, voff = r32 * 128, vswz = (r32 >> 1) & 7;
#define ATT_STEP(kt, RB) do { \
        if ((kt) + 2 <= ktlast) asm volatile("s_waitcnt vmcnt(4) lgkmcnt(0)\n\ts_barrier" ::: "memory"); \
        else if ((kt) < ktlast) asm volatile("s_waitcnt vmcnt(2) lgkmcnt(0)\n\ts_barrier" ::: "memory"); \
        else asm volatile("s_waitcnt vmcnt(0) lgkmcnt(0)\n\ts_barrier" ::: "memory"); \
        if ((kt) + 3 <= ktlast) { const int _b = (((RB) + 3) % 4) * ATT_BUFB + wid * 1024; \
            __builtin_amdgcn_global_load_lds((const unsigned*)(Z + (kso + (unsigned)((kt) + 3) * (64u * 512u))), (LAS unsigned*)(ring + _b), 16, 0, 0); \
            __builtin_amdgcn_global_load_lds((const unsigned*)(VT + (vso + (unsigned)((kt) + 3) * 64u)), (LAS unsigned*)(ring + _b + 8192), 16, 0, 0); } \
        if (active && (kt) <= myqt) attn_tile(ring + (RB) * ATT_BUFB, (kt) == 0, qf, O, nref, lrun, koff, kswz, voff, vswz, hi); } while (0)
    for (int kt0 = 0; kt0 <= ktlast; kt0 += 4) {
        ATT_STEP(kt0, 0);
        if (kt0 + 1 <= ktlast) ATT_STEP(kt0 + 1, 1);
        if (kt0 + 2 <= ktlast) ATT_STEP(kt0 + 2, 2);
        if (kt0 + 3 <= ktlast) ATT_STEP(kt0 + 3, 3);
    }
#undef ATT_STEP
#undef ATT_ISSUE
    if (active) {
        const float l1 = half_sum(lrun[0]), l2 = half_sum(lrun[1]);
        const float c1 = 1.0f / l1, c2 = lam / l2;
        float ss = 0.f;
#pragma unroll
        for (int vh = 0; vh < 2; ++vh)
#pragma unroll
            for (int r = 0; r < 16; ++r) { const float o = O[0][vh][r] * c1 - O[1][vh][r] * c2; O[0][vh][r] = o; ss += o * o; }
        ss = half_sum(ss);
        const float rms = omli / sqrtf(ss * (1.0f / 64.0f) + 1e-5f);
        const float* sg = a.in[7] + l * 64;
        bf16_t* zo = dummy ? (bf16_t*)(F.ws + WS_YSLOT) + rowq * 512 + head * 64 : zq;
#pragma unroll
        for (int vh = 0; vh < 2; ++vh)
#pragma unroll
            for (int g4 = 0; g4 < 4; g4 += 2) {
                u32x2 w[2];
#pragma unroll
                for (int q = 0; q < 2; ++q) { const int vd = vh * 32 + 8 * (g4 + q) + 4 * hi; const f32x4 gv = *(const f32x4*)(sg + vd);
                    w[q].x = cvt_pk_bf16(O[0][vh][4 * (g4 + q)] * rms * gv[0], O[0][vh][4 * (g4 + q) + 1] * rms * gv[1]); w[q].y = cvt_pk_bf16(O[0][vh][4 * (g4 + q) + 2] * rms * gv[2], O[0][vh][4 * (g4 + q) + 3] * rms * gv[3]); }
                const auto rx = __builtin_amdgcn_permlane32_swap(w[0].x, w[1].x, false, false); const auto ry = __builtin_amdgcn_permlane32_swap(w[0].y, w[1].y, false, false);
                *(u32x4*)(zo + vh * 32 + 8 * g4 + 8 * hi) = (u32x4){rx[0], ry[0], rx[1], ry[1]}; }
    }
    __builtin_amdgcn_s_setprio(0);
    asm volatile("s_waitcnt lgkmcnt(0)\n\ts_barrier" ::: "memory");
}
DI void attn_phase(Ctx& F, const Args& a, int l, unsigned* qhead, bool dummy) {
    const int tid = opaque(threadIdx.x);
    const int x0 = (int)(xb_xcc_id() & 7u);
    int live = 0;
    for (;;) {
        if (tid == 0) { unsigned code = 0xffffffffu;
            for (; live < 8; ++live) { const int q = (x0 + live) & 7; const unsigned t = atomicAdd(qhead + 16 * q, 1u); if (t < 17u * 8u) { code = t * 8u + (unsigned)q; break; } }
            F.MISC[0] = code; }
        __syncthreads();
        const unsigned u = F.MISC[0];
        __syncthreads();
        if (u == 0xffffffffu) break;
        const int head = (int)(u & 7u), t = (int)(u >> 3), j = 16 - (t >> 3), bl = t & 7;
        attn_unit(F, a, l, bl, head, j, dummy);
    }
}
DI void mini_dot(const bf16_t* A, int lda, const bf16_t* B, int ldb, int k0, int klen, f32x4 (&acc)[4], int lane) {
    const int rr = lane & 15, kq = (lane >> 4) * 8;
#pragma unroll 4
    for (int kk = 0; kk < klen; kk += 32) {
        const bf16x8 af = *(const bf16x8*)(A + (size_t)rr * lda + k0 + kk + kq);
#pragma unroll
        for (int cb = 0; cb < 4; ++cb) { const bf16x8 bfr = *(const bf16x8*)(B + (size_t)(cb * 16 + rr) * ldb + k0 + kk + kq);
            acc[cb] = __builtin_amdgcn_mfma_f32_16x16x32_bf16(bfr, af, acc[cb], 0, 0, 0); }
    }
}
template <int KIND>
DI void mini_task(Ctx& F, int l, int mi, int task) {
    const int tid = opaque(threadIdx.x), lane = tid & 63, wv = F.wave;
    bf16_t* Z = (bf16_t*)(F.ws + WS_Z); bf16_t* H = (bf16_t*)(F.ws + WS_H); bf16_t* ACT = (bf16_t*)(F.ws + WS_ACT);
    bf16_t* Y = (bf16_t*)((unsigned char*)F.out + OUT_Y);
    LAS float* red = (LAS float*)F.lds;
    f32x4 acc[4], acc2[4];
#pragma unroll
    for (int cb = 0; cb < 4; ++cb) { acc[cb] = (f32x4){0.f, 0.f, 0.f, 0.f}; acc2[cb] = (f32x4){0.f, 0.f, 0.f, 0.f}; }
    const size_t prow0 = PADR;
    if (KIND == 0) { const bf16_t* B = (const bf16_t*)(F.ws + WS_WMIX) + (size_t)l * D * 1536 + (size_t)task * 64 * 1536;
        mini_dot(Z + ZOFF(prow0, ZQ + wv * 64), 512, B + wv * 64, 1536, 0, 64, acc, lane);
        mini_dot(Z + ZOFF(prow0, ZGR + wv * 128), 512, B + 512 + wv * 128, 1536, 0, 128, acc2, lane); }
    if (KIND == 1) { const bf16_t* B = (const bf16_t*)(F.ws + WS_WO) + (size_t)l * D * D + (size_t)task * 64 * D;
        mini_dot(Z + ZOFF(prow0, ZGA + wv * 128), 512, B + wv * 128, D, 0, 128, acc, lane); }
    if (KIND == 2) { const bf16_t* B = (const bf16_t*)(F.ws + WS_WGUD) + (size_t)mi * PROJW * D + (size_t)task * 64 * D;
        mini_dot(H + prow0 * D, D, B, D, wv * 128, 128, acc, lane); }
    if (KIND == 3) { const bf16_t* B = (const bf16_t*)(F.ws + WS_WDD) + (size_t)mi * D * DFF + (size_t)task * 64 * DFF;
        mini_dot(ACT + (size_t)META_ACT * DFF, DFF, B, DFF, wv * 352, 352, acc, lane); }
    { const int fr = lane & 15, fq = lane >> 4;
#pragma unroll
        for (int cb = 0; cb < 4; ++cb) { *(LAS f32x4*)(red + wv * 1024 + fr * 64 + cb * 16 + 4 * fq) = acc[cb];
            if (KIND == 0) *(LAS f32x4*)(red + 8192 + wv * 1024 + fr * 64 + cb * 16 + 4 * fq) = acc2[cb]; } }
    __syncthreads();
    if (tid < 256) {
        const int row = tid >> 4, c0 = (tid & 15) * 4;
        f32x4 u = (f32x4){0.f, 0.f, 0.f, 0.f}, v = (f32x4){0.f, 0.f, 0.f, 0.f};
#pragma unroll
        for (int w = 0; w < 8; ++w) { u += *(const LAS f32x4*)(red + w * 1024 + row * 64 + c0); if (KIND == 0) v += *(const LAS f32x4*)(red + 8192 + w * 1024 + row * 64 + c0); }
        const size_t pr = prow0 + row; const int n = task * 64 + c0;
        if (KIND == 0) { const u32x2 sa = *(const u32x2*)(Z + ZOFF(pr, ZGA + n)), sl = *(const u32x2*)(Z + ZOFF(pr, ZGL + n));
            u32x2 w; w.x = cvt_pk_bf16(bf_lo(sa.x) * u[0] + bf_lo(sl.x) * v[0], bf_hi(sa.x) * u[1] + bf_hi(sl.x) * v[1]); w.y = cvt_pk_bf16(bf_lo(sa.y) * u[2] + bf_lo(sl.y) * v[2], bf_hi(sa.y) * u[3] + bf_hi(sl.y) * v[3]);
            *(u32x2*)(Z + ZOFF(pr, ZGA + n)) = w; }
        if (KIND == 1 || KIND == 3) { const u32x2 hv = *(const u32x2*)(H + pr * D + n);
            u32x2 w; w.x = cvt_pk_bf16(u[0] + ALPHA * bf_lo(hv.x), u[1] + ALPHA * bf_hi(hv.x)); w.y = cvt_pk_bf16(u[2] + ALPHA * bf_lo(hv.y), u[3] + ALPHA * bf_hi(hv.y));
            *(u32x2*)(Y + pr * D + n) = w; *(u32x2*)((bf16_t*)(F.ws + WS_MSAVE) + (size_t)((l * 2 + (KIND == 3 ? 1 : 0)) * 16 + row) * D + n) = w; }
        if (KIND == 2) {
            if ((c0 & 16) == 0) { f32x4 up = (f32x4){0.f, 0.f, 0.f, 0.f};
#pragma unroll
                for (int w = 0; w < 8; ++w) up += *(const LAS f32x4*)(red + w * 1024 + row * 64 + c0 + 16);
                const int oc = task * 32 + (c0 >> 5) * 16 + (c0 & 15);
                u32x2 w2; w2.x = cvt_pk_bf16(silu_(u[0]) * up[0], silu_(u[1]) * up[1]); w2.y = cvt_pk_bf16(silu_(u[2]) * up[2], silu_(u[3]) * up[3]);
                *(u32x2*)(ACT + (size_t)(META_ACT + row) * DFF + oc) = w2; } }
    }
    __syncthreads();
}

DI void meta_restore(Ctx& F, int slot) {
    const int tid = opaque(threadIdx.x);
    bf16_t* Y = (bf16_t*)((unsigned char*)F.out + OUT_Y); const bf16_t* save = (const bf16_t*)(F.ws + WS_MSAVE) + (size_t)slot * 16 * D;
    for (int i = tid; i < 16 * D / 8; i += 512) ((u32x4*)(Y + (size_t)PADR * D))[i] = ((const u32x4*)save)[i];
}
__global__ void __launch_bounds__(512, 2) fwd_kernel(Args a) {
    extern __shared__ __attribute__((aligned(16))) unsigned char lds_raw[];
    Ctx F;
    F.lds = (LAS unsigned char*)lds_raw; F.MISC = (volatile LAS unsigned*)(F.lds + MISC_OFF);
    F.wave = __builtin_amdgcn_readfirstlane(threadIdx.x >> 6);
    F.G = gridDim.x; F.gw = blockIdx.x * 8 + F.wave; F.NGW = F.G * 8;
    F.ws = a.ws; F.ctl = (unsigned*)(a.ws + WS_CTL); F.out = a.out;
    if (threadIdx.x < 64) F.MISC[threadIdx.x] = 0u;
    __syncthreads();
    XcdBarrier bar = xcd_barrier_post(F.ctl + CW_BAR, F.MISC + 8);
    const char* wsb = (const char*)a.ws;
    bf16_t* Zp = (bf16_t*)(a.ws + WS_Z); bf16_t* Hp = (bf16_t*)(a.ws + WS_H); bf16_t* Yp = (bf16_t*)((unsigned char*)a.out + OUT_Y);
    bf16_t* ACTp = (bf16_t*)(a.ws + WS_ACT);

#ifndef PH_MASK
#define PH_MASK 0xffff
#endif
#define GRIDBAR() do { xcd_barrier(bar); if (PROBE_DUP == 13) xcd_barrier(bar); } while (0)
    unsigned long long t_prev = PROBE_T ? wall_clock64() : 0ull, t_acc = 0ull;
#define TSTAMP(ty) do { if (PROBE_T) { const unsigned long long _t = wall_clock64(); if (PROBE_T == (ty)) t_acc += _t - t_prev; t_prev = _t; } } while (0)
    if (PROBE_DUP == 12) prologue(F, a);
    if (PH_MASK & 1) prologue(F, a);
#pragma unroll 1
    for (int g = 0; g < NGRP; ++g) {
        if (PH_MASK & 2) ln_in_phase(F, a, g);
        GRIDBAR(); TSTAMP(14);
#pragma unroll 1
        for (int l = 0; l < DEPTH; ++l) {
            const int mi = l >> 1;
            { ProbInProj P; P.Abase = wsb; P.G = F.G; P.c = opaque_s(blockIdx.x); P.offW = (unsigned)(WS_WIN + (size_t)l * PROJW * D * 2); P.bg0 = a.in[5] + (size_t)l * 2 * D; P.bg1 = P.bg0 + D; P.Z = Zp; P.VT = (bf16_t*)(a.ws + WS_VT);
              if (PROBE_DUP == 1) g8::gemm_phase(F.lds, P);
              if (PH_MASK & 4) g8::gemm_phase(F.lds, P); }
            GRIDBAR(); TSTAMP(1);
            if (PROBE_DUP == 3) lru_phase<false>(F, a, l);
            if (PH_MASK & 8) { lru_phase<true, true>(F, a, l); lru_phase<false>(F, a, l); }
            __syncthreads();
            if (PROBE_DUP == 2) attn_phase(F, a, l, F.ctl + CW_Q + 128 * (8 + g * 4 + l), true);
            if (PH_MASK & 16) attn_phase(F, a, l, F.ctl + CW_Q + 128 * (g * 4 + l), false);
            GRIDBAR(); TSTAMP(2);
            if (PROBE_DUP == 4) lru_phase<true>(F, a, l, true);
            if (PH_MASK & 32) lru_phase<true>(F, a, l);
            GRIDBAR(); TSTAMP(3);
            if (g == 0 && (int)blockIdx.x < 16) mini_task<0>(F, l, mi, blockIdx.x);
            { ProbMix P; P.Abase = wsb; P.G = F.G; P.c = opaque_s(blockIdx.x); P.offW = (unsigned)(WS_WMIX + (size_t)l * D * 1536 * 2); P.Z = Zp;
              if (PH_MASK & 64) g8::gemm_phase(F.lds, P); }
            GRIDBAR(); TSTAMP(4);
            if (g == 0) { if ((int)blockIdx.x < 16) mini_task<1>(F, l, mi, blockIdx.x); }
            else if (blockIdx.x == 0) meta_restore(F, l * 2);
            { ProbResid<16, 1024> P; P.Abase = wsb; P.G = F.G; P.c = opaque_s(blockIdx.x); P.offA = (unsigned)(WS_Z + (ZGA >> 9) * ZBLK * 2); P.lda2 = 1024; P.kblk = (unsigned)(ZBLK * 2); P.a_phys = 1; P.offW = (unsigned)(WS_WO + (size_t)l * D * D * 2); P.H = Hp; P.Y = Yp;
              if (PROBE_DUP == 6) g8::gemm_phase(F.lds, P);
              if (PH_MASK & 128) g8::gemm_phase(F.lds, P); }
            GRIDBAR(); TSTAMP(5);
            const float* g1 = a.in[18] + (size_t)(l * 2) * D; const float* b1 = a.in[19] + (size_t)(l * 2) * D;
            unsigned* cntw = F.ctl + CW_CNT + 64 * (g * 2 + mi);
            if ((l & 1) == 0) {
                if (PROBE_DUP == 7) ln_fast<0, false>(F, a, g, g1, b1, nullptr);
                if (PH_MASK & 256) ln_fast<0, false>(F, a, g, g1, b1, nullptr);
                GRIDBAR(); TSTAMP(6);
                if (g == 0 && (int)blockIdx.x < 88) mini_task<2>(F, l, mi, blockIdx.x);
                { ProbUpD P; P.Abase = wsb; P.G = F.G; P.c = opaque_s(blockIdx.x); P.offW = (unsigned)(WS_WGUD + (size_t)mi * PROJW * D * 2); P.ACT = ACTp;
                  if (PROBE_DUP == 8) g8::gemm_phase(F.lds, P);
                  if (PH_MASK & 512) g8::gemm_phase(F.lds, P); }
                GRIDBAR(); TSTAMP(7);
                if (g == 0) { if ((int)blockIdx.x < 16) mini_task<3>(F, l, mi, blockIdx.x); }
                else if (blockIdx.x == 0) meta_restore(F, l * 2 + 1);
                { ProbResid<44, 2816> P; P.Abase = wsb; P.G = F.G; P.c = opaque_s(blockIdx.x); P.offA = (unsigned)WS_ACT; P.lda2 = DFF * 2; P.kblk = 0; P.a_phys = 0; P.offW = (unsigned)(WS_WDD + (size_t)mi * D * DFF * 2); P.H = Hp; P.Y = Yp;
                  if (PROBE_DUP == 9) g8::gemm_phase(F.lds, P);
                  if (PH_MASK & 1024) g8::gemm_phase(F.lds, P); }
                GRIDBAR(); TSTAMP(8);
                if (PH_MASK & 256) ln_fast<0, false>(F, a, g, g1 + D, b1 + D, nullptr);
                GRIDBAR(); TSTAMP(9);
            } else {
                if (PH_MASK & 2048) ln_phase<1, false>(F, a, g, g1, b1, a.in[23] + (size_t)mi * D * 8, cntw);
                GRIDBAR(); TSTAMP(10);
                { ProbUpM P; P.Abase = wsb; P.G = F.G; P.c = opaque_s(blockIdx.x); P.offW = (unsigned)(WS_WGUM + (size_t)mi * 8 * PROJW * D * 2); P.ACT = ACTp;
                  P.list = (const int*)(a.ws + WS_ROUTE + (size_t)MG * 32); P.tab.init(cntw, 22);
                  if (PROBE_DUP == 10) g8::gemm_phase(F.lds, P);
                  if (PH_MASK & 4096) g8::gemm_phase(F.lds, P); }
                GRIDBAR(); TSTAMP(11);
                { ProbDownM P; P.Abase = wsb; P.G = F.G; P.c = opaque_s(blockIdx.x); P.offW = (unsigned)(WS_WDM + (size_t)mi * 8 * D * DFF * 2); P.YS = (bf16_t*)(a.ws + WS_YSLOT);
                  P.wlist = (const float*)(a.ws + WS_ROUTE + (size_t)MG * 32 + (size_t)8 * MG * 4); P.tab.init(cntw, 4);
                  if (PROBE_DUP == 11) g8::gemm_phase(F.lds, P);
                  if (PH_MASK & 8192) g8::gemm_phase(F.lds, P); }
                GRIDBAR(); TSTAMP(12);
                if (PH_MASK & 16384) { if (l == DEPTH - 1) ln_fast<3, true>(F, a, g, g1 + D, b1 + D, cntw);
                else ln_fast<3, false>(F, a, g, g1 + D, b1 + D, cntw); }
                GRIDBAR(); TSTAMP(13);
            }
        }
    }
    if (PROBE_T) {
        if (blockIdx.x == 0 && threadIdx.x == 0) __hip_atomic_store(F.ctl + 2048, (unsigned)(t_acc / 100ull), __ATOMIC_RELAXED, __HIP_MEMORY_SCOPE_AGENT);
        GRIDBAR();
        const float V0 = (float)__hip_atomic_load(F.ctl + 2048, __ATOMIC_RELAXED, __HIP_MEMORY_SCOPE_AGENT) * 0.01f;
        const float V = exp2f(rintf(log2f(V0 > 0.01f ? V0 : 0.01f) * 6.0f + PROBE_OFS) * (1.0f / 6.0f) - PROBE_OFS * (1.0f / 6.0f));
        for (size_t i = (size_t)blockIdx.x * 512 + threadIdx.x; i < (size_t)NBATCH * SEQ * D; i += (size_t)gridDim.x * 512) F.out[i] = V;
    }
}

extern "C" void kernel_launch(void* const* d_in, const int* in_sizes, int n_in, void* d_out, int out_size, void* d_ws, size_t ws_size, hipStream_t stream) {
    static int grid = 0;
    if (grid == 0) {
        if (n_in != 27 || out_size != NBATCH * SEQ * D || ws_size < WS_END) { fprintf(stderr, "kernel_launch: unexpected problem (n_in %d, out %d, ws %zu)\n", n_in, out_size, ws_size); grid = -1; return; }
        int dev = 0, cus = 0;
        if (hipGetDevice(&dev) != hipSuccess || hipDeviceGetAttribute(&cus, hipDeviceAttributeMultiprocessorCount, dev) != hipSuccess) { grid = -1; return; }
        if (hipFuncSetAttribute((const void*)fwd_kernel, hipFuncAttributeMaxDynamicSharedMemorySize, LDS_BYTES) != hipSuccess) { fprintf(stderr, "kernel_launch: hipFuncSetAttribute failed\n"); grid = -1; return; }
        int per_cu = 0;
        if (hipOccupancyMaxActiveBlocksPerMultiprocessor(&per_cu, (const void*)fwd_kernel, 512, LDS_BYTES) != hipSuccess || per_cu < 1) fprintf(stderr, "kernel_launch: occupancy query says %d\n", per_cu);
        (void)hipGetLastError();
        grid = cus;
    }
    if (grid < 0) return;
    (void)hipMemsetAsync((char*)d_ws + WS_CTL, 0, CTL_BYTES, stream);
    Args a{};
    for (int i = 0; i < 27; ++i) a.in[i] = (const float*)d_in[i];
    a.out = (float*)d_out; a.ws = (unsigned char*)d_ws;
    hipLaunchKernelGGL(fwd_kernel, dim3(grid), dim3(512), LDS_BYTES, stream, a);
}
```

```cpp
#include <hip/hip_runtime.h>
#include <cstdio>
#include <cstdint>

#ifndef PROBE_DUP
#define PROBE_DUP 0
#endif
#ifndef PROBE_T
#define PROBE_T 0
#endif
#define PROBE_OFS 0.0f
#define DI __device__ __forceinline__
#define LAS __attribute__((address_space(3)))
typedef unsigned short bf16_t;
typedef short bf16x8 __attribute__((ext_vector_type(8)));
typedef float f32x4 __attribute__((ext_vector_type(4)));
typedef float f32x16 __attribute__((ext_vector_type(16)));
typedef unsigned u32x4 __attribute__((ext_vector_type(4)));
typedef unsigned u32x2 __attribute__((ext_vector_type(2)));

constexpr int D = 1024, NBATCH = 16, SEQ = 4096, DEPTH = 4;
constexpr int TP = 4160;
constexpr int PADR = 48, FRAME0 = 64;
constexpr int GB = 8, NGRP = NBATCH / GB;
constexpr int MG = GB * TP;
constexpr int NMT = MG / 256;
constexpr int LDZ = 5120;
constexpr int ZQ = 0, ZK = 512, ZXR = 1024, ZGR = 2048, ZGA = 3072, ZGL = 4096;
constexpr size_t ZBLK = (size_t)MG * 512;
#define ZOFF(row, col) ((size_t)((col) >> 9) * ZBLK + (size_t)(row) * 512 + ((col) & 511))
constexpr int DFF = 2816, NEXP = 8, PROJW = 5632;
constexpr int NCHUNK = TP / 64;
constexpr int NQB = TP / 32;
constexpr float ALPHA = 1.681792830507429f;
constexpr float LOG2E = 1.4426950408889634f;
constexpr float QSCALE = 0.17677669529663687f * LOG2E;
constexpr int SLOT_ROWS = 2 * MG + 8 * 256;
constexpr int NMTC = GB * 16;
constexpr int META_ACT = NMTC * 256;

constexpr size_t MiB = 1u << 20;
constexpr size_t WS_CTL = 0, CTL_BYTES = 1 * MiB;
constexpr size_t WS_TAB = 1 * MiB;
constexpr size_t WS_WIN = 2 * MiB;
constexpr size_t WS_WMIX = 46 * MiB;
constexpr size_t WS_WO = 58 * MiB;
constexpr size_t WS_WR = 66 * MiB;
constexpr size_t WS_WI = 66 * MiB + 512 * 1024;
constexpr size_t WS_WGUD = 67 * MiB;
constexpr size_t WS_WDD = 89 * MiB;
constexpr size_t WS_WGUM = 100 * MiB;
constexpr size_t WS_WDM = 276 * MiB;
constexpr size_t WS_H = 364 * MiB;
constexpr size_t WS_AGG = 429 * MiB;
constexpr size_t WS_ROUTE = 434 * MiB;
constexpr size_t WS_YSLOT = 438 * MiB;
constexpr size_t WS_Z = 572 * MiB;
constexpr size_t WS_VT = 897 * MiB;
constexpr size_t WS_ACT = WS_Z;
constexpr size_t WS_MSAVE = 941 * MiB;
constexpr size_t WS_END = 942 * MiB;
constexpr size_t OUT_Y = 128 * MiB;
static_assert(WS_WIN + (size_t)DEPTH * PROJW * D * 2 <= WS_WMIX, "map");
static_assert(WS_WMIX + (size_t)DEPTH * D * 1536 * 2 <= WS_WO, "map");
static_assert(WS_WGUD + (size_t)2 * PROJW * D * 2 <= WS_WDD && WS_WDD + (size_t)2 * D * DFF * 2 <= WS_WGUM, "map");
static_assert(WS_WGUM + (size_t)16 * PROJW * D * 2 <= WS_WDM && WS_WDM + (size_t)16 * D * DFF * 2 <= WS_H, "map");
static_assert(WS_H + (size_t)MG * D * 2 <= WS_AGG && WS_AGG + (size_t)2 * GB * NCHUNK * D * 4 <= WS_ROUTE, "map");
static_assert(WS_ROUTE + (size_t)MG * 32 + (size_t)2 * 8 * MG * 4 <= WS_YSLOT && WS_YSLOT + (size_t)SLOT_ROWS * D * 2 <= WS_Z, "map");
static_assert(WS_Z + (size_t)MG * LDZ * 2 <= WS_VT && WS_VT + (size_t)512 * MG * 2 <= WS_END && WS_ACT + (size_t)SLOT_ROWS * DFF * 2 <= WS_END, "map");

constexpr int CW_BAR = 4096;
constexpr int CW_Q = 8192;
constexpr int CW_CNT = 12288;

constexpr int LDS_STAGE = 131072;
constexpr int MISC_OFF = LDS_STAGE;
constexpr int LDS_BYTES = LDS_STAGE + 1024;

DI float bf_lo(unsigned w) { return __uint_as_float(w << 16); }
DI float bf_hi(unsigned w) { return __uint_as_float(w & 0xffff0000u); }
DI float bf2f(bf16_t b) { return __uint_as_float((unsigned)b << 16); }
typedef float f32x2_t __attribute__((ext_vector_type(2))); typedef __bf16 bf16x2_t __attribute__((ext_vector_type(2)));
DI unsigned cvt_pk_bf16(float lo, float hi) { const f32x2_t v = {lo, hi}; const bf16x2_t b = __builtin_convertvector(v, bf16x2_t); return __builtin_bit_cast(unsigned, b); }
DI bf16_t f2bf(float f) { return (bf16_t)(cvt_pk_bf16(f, 0.f) & 0xffffu); }
DI float ex2(float x) { return __builtin_amdgcn_exp2f(x); }
DI float rcpf_(float x) { return __builtin_amdgcn_rcpf(x); }
DI float sigm(float x) { return rcpf_(1.0f + ex2(-LOG2E * x)); }
DI float silu_(float x) { return x * sigm(x); }
DI float gelu_tanh(float x) { const float u = 0.7978845608028654f * (x + 0.044715f * x * x * x); return x * sigm(2.0f * u); }
DI int opaque(int x) { asm volatile("" : "+v"(x)); return x; }
DI int opaque_s(int x) { asm volatile("" : "+s"(x)); return x; }
DI float bcast_lo(float v) { const auto r = __builtin_amdgcn_permlane32_swap(__float_as_uint(v), __float_as_uint(v), false, false); return __uint_as_float(r[0]); }
DI float bcast_hi(float v) { const auto r = __builtin_amdgcn_permlane32_swap(__float_as_uint(v), __float_as_uint(v), false, false); return __uint_as_float(r[1]); }
template <int CTRL> DI float dpp_mov(float v) { return __int_as_float(__builtin_amdgcn_update_dpp(0, __float_as_int(v), CTRL, 0xf, 0xf, true)); }
DI float wave_sum(float v) {
    v += dpp_mov<0xB1>(v);
    v += dpp_mov<0x4E>(v);
    v += dpp_mov<0x141>(v);
    v += dpp_mov<0x140>(v);
    { const auto r = __builtin_amdgcn_permlane16_swap(__float_as_uint(v), __float_as_uint(v), false, false); v = __uint_as_float(r[0]) + __uint_as_float(r[1]); }
    { const auto r = __builtin_amdgcn_permlane32_swap(__float_as_uint(v), __float_as_uint(v), false, false); v = __uint_as_float(r[0]) + __uint_as_float(r[1]); }
    return v;
}
DI float half_sum(float v) { const auto r = __builtin_amdgcn_permlane32_swap(__float_as_uint(v), __float_as_uint(v), false, false); return __uint_as_float(r[0]) + __uint_as_float(r[1]); }
DI void unpack8(const u32x4 w, float (&f)[8]) { f[0] = bf_lo(w.x); f[1] = bf_hi(w.x); f[2] = bf_lo(w.y); f[3] = bf_hi(w.y); f[4] = bf_lo(w.z); f[5] = bf_hi(w.z); f[6] = bf_lo(w.w); f[7] = bf_hi(w.w); }
DI u32x4 pack8(const f32x4 a, const f32x4 b) { u32x4 w; w.x = cvt_pk_bf16(a[0], a[1]); w.y = cvt_pk_bf16(a[2], a[3]); w.z = cvt_pk_bf16(b[0], b[1]); w.w = cvt_pk_bf16(b[2], b[3]); return w; }

#define XB_TMO      128
#define XB_XCNT(j)  (256  + 64 * (j))
#define XB_XSUB(j)  (1280 + 64 * (j))
#define XB_XGEN(j)  (2304 + 64 * (j))
#define XB_TOP      3328
#define XB_TOPGEN   3392
#define XCD_BAR_WORDS 3456
#define XB_SPIN_CAP (1u << 18)
DI unsigned xb_ld(unsigned* p)              { return __hip_atomic_load(p, __ATOMIC_RELAXED, __HIP_MEMORY_SCOPE_AGENT); }
DI unsigned xb_add(unsigned* p, unsigned v) { return __hip_atomic_fetch_add(p, v, __ATOMIC_RELAXED, __HIP_MEMORY_SCOPE_AGENT); }
DI unsigned xb_xcc_id() { return (unsigned)__builtin_amdgcn_s_getreg((3 << 11) | 20) & 0xFu; }
#define XB_SPIN(cond, bar) do { unsigned _sp = 0; while (cond) { __builtin_amdgcn_s_sleep(1); \
    if ((++_sp & 255u) == 0u) { if (xb_ld(&(bar)[XB_TMO])) break; if (_sp > XB_SPIN_CAP) { atomicAdd(&(bar)[XB_TMO], 1u); break; } } } } while (0)
struct XcdBarrier { unsigned* bar; unsigned x; volatile LAS unsigned* st; };
DI XcdBarrier xcd_barrier_post(unsigned* bar, volatile LAS unsigned* st) {
    XcdBarrier b; b.bar = bar; b.x = xb_xcc_id(); b.st = st;
    if (threadIdx.x == 0) (void)xb_add(&bar[XB_XCNT(b.x)], 1u);
    return b;
}
DI void xcd_barrier_complete(unsigned* bar, unsigned x, unsigned& nloc, unsigned& nx) {
    const unsigned G = gridDim.x * gridDim.y * gridDim.z;
    unsigned sum, cnt, mine, sp = 0u;
    for (;;) {
        sum = 0u; cnt = 0u; mine = 0u;
#pragma unroll
        for (unsigned j = 0; j < 16; ++j) { const unsigned c = xb_ld(&bar[XB_XCNT(j)]); sum += c; cnt += (c > 0u) ? 1u : 0u; mine = (j == x) ? c : mine; }
        if (sum == G) break;
        __builtin_amdgcn_s_sleep(1);
        if ((++sp & 255u) == 0u) { if (xb_ld(&bar[XB_TMO])) break; if (sp > XB_SPIN_CAP) { atomicAdd(&bar[XB_TMO], 1u); break; } }
    }
    nloc = mine > 0u ? mine : 1u; nx = cnt > 0u ? cnt : 1u;
}
DI void xcd_barrier(const XcdBarrier& b) {
    asm volatile("s_waitcnt vmcnt(0)" ::: "memory");
    __syncthreads();
    if (threadIdx.x == 0) {
        unsigned* bar = b.bar;
        __builtin_amdgcn_s_waitcnt(0);
        unsigned nloc = b.st[0], nx = b.st[1];
        if (nloc == 0u) { xcd_barrier_complete(bar, b.x, nloc, nx); b.st[0] = nloc; b.st[1] = nx; }
        const unsigned old = xb_add(&bar[XB_XSUB(b.x)], 1u);
        const unsigned gen = old / nloc;
        if (old + 1u == (gen + 1u) * nloc) {
            __builtin_amdgcn_fence(__ATOMIC_RELEASE, "agent");
            asm volatile("s_waitcnt vmcnt(0)" ::: "memory");
            const unsigned og = xb_add(&bar[XB_TOP], 1u);
            const unsigned tg = og / nx;
            if (og + 1u == (tg + 1u) * nx) xb_add(&bar[XB_TOPGEN], 1u);
            else XB_SPIN(xb_ld(&bar[XB_TOPGEN]) == tg, bar);
            __builtin_amdgcn_fence(__ATOMIC_ACQUIRE, "agent");
            xb_add(&bar[XB_XGEN(b.x)], 1u);
            asm volatile("s_waitcnt vmcnt(0)" ::: "memory");
        } else {
            XB_SPIN(xb_ld(&bar[XB_XGEN(b.x)]) == gen, bar);
            __builtin_amdgcn_fence(__ATOMIC_ACQUIRE, "agent");
            asm volatile("s_waitcnt vmcnt(0)" ::: "memory");
        }
    }
    __syncthreads();
}

namespace g8 {
constexpr int BM = 256, BK = 64, HALF = 128, HTB = HALF * BK * 2, STAGE_BYTES = 8 * HTB, NXCD = 8, WGM = 4;
static_assert(STAGE_BYTES == LDS_STAGE, "stage");
__host__ __device__ __forceinline__ int lds_byte(int r, int c) { const int st = (r >> 4) * 2 + (c >> 5), rr = r & 15, cc = c & 31, ob = rr * 64 + cc * 2; return st * 1024 + (ob ^ (((ob >> 9) & 1) << 5)); }
__host__ __device__ __forceinline__ void stage_rc(int b, int& R, int& C) { const int st = b / 1024, sb = b % 1024, swz = sb ^ (((sb >> 9) & 1) << 5); R = (st >> 1) * 16 + swz / 64; C = (st & 1) * 32 + (swz % 64) / 2; }
__host__ __device__ __forceinline__ int perm32(int rho) { const int n = rho >> 4, i = rho & 15; return 8 * (i >> 2) + 4 * n + (i & 3); }
struct Unit { int pm, pn, aux, x0, x1; };
DI int static_map(int L, int nM, int nN) {
    const int nwg = nM * nN; int wgid = L;
    { const int q = nwg / NXCD, r = nwg % NXCD, xcd = wgid % NXCD, off = wgid / NXCD; wgid = (xcd < r ? xcd * (q + 1) : r * (q + 1) + (xcd - r) * q) + off; }
    const int nig = WGM * nN, gid = wgid / nig, fm = gid * WGM, gsz = (nM - fm) < WGM ? (nM - fm) : WGM;
    return (fm + ((wgid % nig) % gsz)) | (((wgid % nig) / gsz) << 16);
}
typedef f32x4 Acc[2][2][4][2];

template <class P>
DI void gemm_phase(LAS unsigned char* lds, const P& prob) {
    const int tid = opaque(threadIdx.x), wid = __builtin_amdgcn_readfirstlane(tid >> 6), lane = tid & 63, wr = wid >> 2, wc = wid & 3, fr = lane & 15, fq = lane >> 4;
    int R[2], C[2]; unsigned voffB[2], voffA[2];
#pragma unroll
    for (int i = 0; i < 2; ++i) { stage_rc(tid * 16 + i * 8192, R[i], C[i]); const int Rb = P::PERM ? ((R[i] & ~31) + perm32(R[i] & 31)) : R[i]; voffB[i] = (unsigned)(Rb * P::LDB + C[i]) * 2u;
        voffA[i] = (unsigned)R[i] * prob.ldaB() + (unsigned)C[i] * 2u; }
    constexpr unsigned hstepB = (unsigned)HALF * P::LDB * 2u;
    const unsigned hstepA = (unsigned)HALF * prob.ldaB();
    const unsigned ldsw = (unsigned)wid * 1024u;
    const int aoff = lds_byte(wr * 64 + fr, fq * 8), boff = lds_byte(wc * 32 + fr, fq * 8);
#define G8_SA(b, h) (((b) * 2 + (h)) * HTB)
#define G8_SB(b, h) ((4 + (b) * 2 + (h)) * HTB)
#define G8_STAGE_B(bufoff, gbase) do { _Pragma("unroll") for (int _i = 0; _i < 2; ++_i) \
        __builtin_amdgcn_global_load_lds((const unsigned*)((const char*)(gbase) + voffB[_i]), (LAS unsigned*)(lds + (bufoff) + ldsw + _i * 8192), 16, 0, 0); } while (0)
#define G8_STAGE_A(bufoff, h, ub, gv, koff) do { if constexpr (P::GATHER) { const char* _kb = Ab + (koff); _Pragma("unroll") for (int _i = 0; _i < 2; ++_i) \
            __builtin_amdgcn_global_load_lds((const unsigned*)(_kb + (gv)[h][_i]), (LAS unsigned*)(lds + (bufoff) + ldsw + _i * 8192), 16, 0, 0); } \
        else { const char* _kb = Ab + ((ub) + (h) * hstepA + (koff)); _Pragma("unroll") for (int _i = 0; _i < 2; ++_i) \
            __builtin_amdgcn_global_load_lds((const unsigned*)(_kb + voffA[_i]), (LAS unsigned*)(lds + (bufoff) + ldsw + _i * 8192), 16, 0, 0); } } while (0)
#define G8_LDA(dst, b, h) do { _Pragma("unroll") for (int m = 0; m < 4; ++m) _Pragma("unroll") for (int k = 0; k < 2; ++k) dst[m][k] = *(const LAS bf16x8*)(lds + G8_SA(b, h) + aoff + m * 2048 + k * 1024); } while (0)
#define G8_LDB(dst, b, h) do { _Pragma("unroll") for (int n = 0; n < 2; ++n) _Pragma("unroll") for (int k = 0; k < 2; ++k) dst[n][k] = *(const LAS bf16x8*)(lds + G8_SB(b, h) + boff + n * 2048 + k * 1024); } while (0)
#define G8_MMA(ai, bj, At, Bt) do { __builtin_amdgcn_s_setprio(1); _Pragma("unroll") for (int m = 0; m < 4; ++m) _Pragma("unroll") for (int n = 0; n < 2; ++n) _Pragma("unroll") for (int k = 0; k < 2; ++k) \
        acc[ai][bj][m][n] = __builtin_amdgcn_mfma_f32_16x16x32_bf16(Bt[n][k], At[m][k], acc[ai][bj][m][n], 0, 0, 0); __builtin_amdgcn_s_setprio(0); } while (0)
#define G8_WAIT_V(n) asm volatile("s_waitcnt vmcnt(" #n ")" ::: "memory")
#define G8_WAIT_L(n) asm volatile("s_waitcnt lgkmcnt(" #n ")" ::: "memory")
#define G8_BAR __builtin_amdgcn_s_barrier()
#define G8_SCHED __builtin_amdgcn_sched_barrier(0)
    Unit cur, nxt; int ui = 0;
    if (!prob.next(0, cur)) return;
    Acc acc;
#pragma unroll
    for (int a = 0; a < 2; ++a)
#pragma unroll
        for (int b = 0; b < 2; ++b)
#pragma unroll
            for (int m = 0; m < 4; ++m)
#pragma unroll
                for (int n = 0; n < 2; ++n) acc[a][b][m][n] = (f32x4){0.f, 0.f, 0.f, 0.f};
    bf16x8 At[4][2], B0[2][2], B1[2][2];
    unsigned gvA[2][2], gvN[2][2];
    unsigned cU = 0, nU = 0;
    if constexpr (P::GATHER) prob.a_gather(cur, R, C, gvA); else cU = prob.a_unit(cur);
    const char* const Ab = prob.Abase;
    const char* cB = prob.b_ptr(cur);
    G8_STAGE_B(G8_SB(0, 0), cB); G8_STAGE_B(G8_SB(0, 1), cB + hstepB); G8_STAGE_A(G8_SA(0, 0), 0, cU, gvA, prob.koffA(cur, 0)); G8_STAGE_A(G8_SA(0, 1), 1, cU, gvA, prob.koffA(cur, 0));
    if (wr == 1) G8_BAR;
    G8_WAIT_V(2); G8_BAR;
    G8_STAGE_B(G8_SB(1, 0), cB + 128); G8_STAGE_A(G8_SA(1, 0), 0, cU, gvA, prob.koffA(cur, 1)); G8_STAGE_B(G8_SB(1, 1), cB + hstepB + 128);
    G8_WAIT_V(6); G8_BAR;
    for (;;) {
        const bool has_next = prob.next(ui + 1, nxt);
        if (!has_next) nxt = cur;
        if constexpr (P::GATHER) { if (has_next) prob.a_gather(nxt, R, C, gvN); else {
#pragma unroll
            for (int h = 0; h < 2; ++h)
#pragma unroll
                for (int i = 0; i < 2; ++i) gvN[h][i] = gvA[h][i]; } }
        else nU = has_next ? prob.a_unit(nxt) : cU;
        const char* nB = has_next ? prob.b_ptr(nxt) : cB;
        const int nt = prob.nt(cur);
        for (int t = 0; t < nt; t += 2) {
            const bool last = (t == nt - 2);
            const unsigned k1 = prob.koffA(cur, t + 1), k2 = last ? prob.koffA(nxt, 0) : prob.koffA(cur, t + 2), k3 = last ? prob.koffA(nxt, 1) : prob.koffA(cur, t + 3);
            unsigned v2[2][2]; unsigned u2 = 0;
            if constexpr (P::GATHER) {
#pragma unroll
                for (int h = 0; h < 2; ++h)
#pragma unroll
                    for (int i = 0; i < 2; ++i) v2[h][i] = last ? gvN[h][i] : gvA[h][i];
            } else u2 = last ? nU : cU;
            const char* b2 = last ? nB : cB + (size_t)(t + 2) * 128; const char* b3 = b2 + 128;
            G8_LDB(B0, 0, 0); G8_LDB(B1, 0, 1); G8_SCHED; G8_LDA(At, 0, 0); G8_STAGE_A(G8_SA(1, 1), 1, cU, gvA, k1);
            G8_WAIT_V(8); G8_WAIT_L(0); G8_BAR; G8_MMA(0, 0, At, B0); G8_MMA(0, 1, At, B1); G8_BAR; G8_SCHED;
            G8_LDA(At, 0, 1); G8_STAGE_B(G8_SB(0, 0), b2); G8_STAGE_B(G8_SB(0, 1), b2 + hstepB); G8_STAGE_A(G8_SA(0, 0), 0, u2, v2, k2);
            G8_WAIT_V(8); G8_WAIT_L(0); G8_BAR; G8_MMA(1, 0, At, B0); G8_MMA(1, 1, At, B1); G8_BAR; G8_SCHED;
            G8_LDB(B0, 1, 0); G8_LDB(B1, 1, 1); G8_SCHED; G8_LDA(At, 1, 0); G8_STAGE_A(G8_SA(0, 1), 1, u2, v2, k2);
            G8_WAIT_V(8); G8_WAIT_L(0); G8_BAR; G8_MMA(0, 0, At, B0); G8_MMA(0, 1, At, B1); G8_BAR; G8_SCHED;
            G8_LDA(At, 1, 1); G8_STAGE_B(G8_SB(1, 0), b3); G8_STAGE_B(G8_SB(1, 1), b3 + hstepB); G8_STAGE_A(G8_SA(1, 0), 0, u2, v2, k3);
            G8_WAIT_V(8); G8_WAIT_L(0); G8_BAR; G8_MMA(1, 0, At, B0); G8_MMA(1, 1, At, B1); G8_BAR; G8_SCHED;
        }
        if (wr == 0) G8_BAR;
        prob.epi(acc, cur, wr, wc, fr, fq);
        if (!has_next) break;
        if (!prob.keep(cur)) {
#pragma unroll
            for (int a = 0; a < 2; ++a)
#pragma unroll
                for (int b = 0; b < 2; ++b)
#pragma unroll
                    for (int m = 0; m < 4; ++m)
#pragma unroll
                        for (int n = 0; n < 2; ++n) acc[a][b][m][n] = (f32x4){0.f, 0.f, 0.f, 0.f};
        }
        cur = nxt; cB = nB; cU = nU; ++ui;
        if constexpr (P::GATHER) {
#pragma unroll
            for (int h = 0; h < 2; ++h)
#pragma unroll
                for (int i = 0; i < 2; ++i) gvA[h][i] = gvN[h][i];
        }
        if (wr == 1) G8_BAR;
    }
    G8_WAIT_V(0);
    G8_BAR;
#undef G8_SA
#undef G8_SB
#undef G8_STAGE_A
#undef G8_STAGE_B
#undef G8_LDA
#undef G8_LDB
#undef G8_MMA
#undef G8_WAIT_V
#undef G8_WAIT_L
#undef G8_BAR
#undef G8_SCHED
}
}
using g8::Unit; using g8::Acc;

#define ROW_OF(pm, ai, m) ((pm) * 256 + (ai) * 128 + wr * 64 + (m) * 16 + fr)
DI int crow0(int pm) { return (pm >> 4) * TP + FRAME0 + (pm & 15) * 256; }
#define PROW_OF(pm, ai, m) (crow0(pm) + (ai) * 128 + wr * 64 + (m) * 16 + fr)

struct ProbBase { const char* Abase; int G, c; };

struct ProbInProj : ProbBase {
    static constexpr bool PERM = true; static constexpr int NT = 16, LDB = 1024;
    unsigned offW; const float* bg0; const float* bg1; bf16_t* Z; bf16_t* VT;
    static constexpr int U1 = NMT * 20, U2 = 2 * NMT;
    DI bool next(int i, Unit& u) const {
        const int L = i * G + c; if (L >= U1 + U2) return false;
        const int L2 = L - U1; const bool second = L2 >= 0;
        const int pk = g8::static_map(second ? 0 : L, NMT, 20);
        Unit t; t.aux = second ? 1 : 0; t.pm = second ? L2 / NMT : (pk & 0xffff); t.pn = second ? L2 % NMT : (pk >> 16); t.x0 = 0; t.x1 = 0; u = t; return true;
    }
    static constexpr bool GATHER = false;
    DI unsigned ldaB() const { return 2048u; }
    DI unsigned a_unit(const Unit& u) const { return (u.aux ? offW + 5120u * 2048u : (unsigned)WS_H) + (unsigned)u.pm * (256u * 2048u); }
    DI unsigned koffA(const Unit&, int t) const { return (unsigned)t * 128u; }
    DI int nt(const Unit&) const { return NT; }
    DI bool keep(const Unit&) const { return false; }
    DI const char* b_ptr(const Unit& u) const { return Abase + (u.aux ? (size_t)WS_H : (size_t)offW) + (size_t)u.pn * 256 * 2048; }
    DI void epi(Acc& acc, const Unit& u, int wr, int wc, int fr, int fq) const {
        if (u.aux == 0) {
            const int colt = u.pn * 256;
            const int kind = colt < ZGR ? 0 : (colt < ZGA ? 1 : (colt < ZGL ? 2 : 3));
            f32x4 bv[2][2];
#pragma unroll
            for (int bj = 0; bj < 2; ++bj)
#pragma unroll
                for (int n = 0; n < 2; ++n) bv[bj][n] = (f32x4){0.f, 0.f, 0.f, 0.f};
            if (kind >= 2) { const float* bp = (kind == 2 ? bg0 + (colt - ZGA) : bg1 + (colt - ZGL)) + wc * 32 + 8 * fq;
#pragma unroll
                for (int bj = 0; bj < 2; ++bj)
#pragma unroll
                    for (int n = 0; n < 2; ++n) bv[bj][n] = *(const f32x4*)(bp + bj * 128 + 4 * n); }
#pragma unroll
            for (int ai = 0; ai < 2; ++ai)
#pragma unroll
                for (int m = 0; m < 4; ++m) { bf16_t* rowp = Z + ZOFF(ROW_OF(u.pm, ai, m), colt + wc * 32 + 8 * fq);
#pragma unroll
                    for (int bj = 0; bj < 2; ++bj) { f32x4 v0 = acc[ai][bj][m][0] + bv[bj][0], v1 = acc[ai][bj][m][1] + bv[bj][1];
                        if (kind == 1) {
#pragma unroll
                            for (int j = 0; j < 4; ++j) { v0[j] = gelu_tanh(v0[j]); v1[j] = gelu_tanh(v1[j]); } }
                        else if (kind >= 2) {
#pragma unroll
                            for (int j = 0; j < 4; ++j) { v0[j] = sigm(v0[j]); v1[j] = sigm(v1[j]); } }
                        *(u32x4*)(rowp + bj * 128) = pack8(v0, v1); } }
        } else {
#pragma unroll
            for (int ai = 0; ai < 2; ++ai)
#pragma unroll
                for (int m = 0; m < 4; ++m) { bf16_t* rowp = VT + (size_t)ROW_OF(u.pm, ai, m) * MG + u.pn * 256 + wc * 32 + 8 * fq;
#pragma unroll
                    for (int bj = 0; bj < 2; ++bj) *(u32x4*)(rowp + bj * 128) = pack8(acc[ai][bj][m][0], acc[ai][bj][m][1]); }
        }
    }
};

struct ProbMix : ProbBase {
    static constexpr bool PERM = true; static constexpr int LDB = 1536;
    unsigned offW; bf16_t* Z;
    DI bool next(int i, Unit& u) const { const int L = (i >> 1) * G + c; if (L >= NMTC * 4) return false; const int pk = g8::static_map(L, NMTC, 4); Unit t; t.pm = pk & 0xffff; t.pn = pk >> 16; t.aux = i & 1; t.x0 = 0; t.x1 = 0; u = t; return true; }
    static constexpr bool GATHER = false;
    DI unsigned ldaB() const { return 1024u; }
    DI unsigned a_unit(const Unit& u) const { return (unsigned)WS_Z + (unsigned)crow0(u.pm) * 1024u; }
    DI unsigned koffA(const Unit& u, int t) const { return (unsigned)((u.aux ? (ZGR >> 9) + (t >> 3) : 0) * (ZBLK * 2) + (t & 7) * 128); }
    DI int nt(const Unit& u) const { return u.aux ? 16 : 8; }
    DI bool keep(const Unit& u) const { return u.aux == 0; }
    DI const char* b_ptr(const Unit& u) const { return Abase + (size_t)offW + (size_t)u.pn * 256 * (1536 * 2) + (u.aux ? 1024 : 0); }
    DI void epi(Acc& acc, const Unit& u, int wr, int wc, int fr, int fq) const {
        if (u.aux == 0) {
#pragma unroll
            for (int ai = 0; ai < 2; ++ai)
#pragma unroll
                for (int m = 0; m < 4; ++m) { const size_t ro = ZOFF(PROW_OF(u.pm, ai, m), u.pn * 256 + wc * 32 + 8 * fq); const bf16_t* rowa = Z + (ZGA >> 9) * ZBLK + ro; const bf16_t* rowl = Z + (ZGL >> 9) * ZBLK + ro;
#pragma unroll
                    for (int bj = 0; bj < 2; ++bj) { const u32x4 sa = *(const u32x4*)(rowa + bj * 128), sl = *(const u32x4*)(rowl + bj * 128);
                        float a8[8], l8[8]; unpack8(sa, a8); unpack8(sl, l8);
#pragma unroll
                        for (int j = 0; j < 4; ++j) { acc[ai][bj][m][0][j] *= a8[j] * rcpf_(l8[j]); acc[ai][bj][m][1][j] *= a8[4 + j] * rcpf_(l8[4 + j]); } }
                    asm volatile("" ::: "memory"); }
        } else {
#pragma unroll
            for (int ai = 0; ai < 2; ++ai)
#pragma unroll
                for (int m = 0; m < 4; ++m) { const size_t ro = ZOFF(PROW_OF(u.pm, ai, m), u.pn * 256 + wc * 32 + 8 * fq); bf16_t* rowa = Z + (ZGA >> 9) * ZBLK + ro; const bf16_t* rowl = Z + (ZGL >> 9) * ZBLK + ro;
#pragma unroll
                    for (int bj = 0; bj < 2; ++bj) { const u32x4 sl = *(const u32x4*)(rowl + bj * 128); float l8[8]; unpack8(sl, l8);
                        f32x4 v0 = acc[ai][bj][m][0], v1 = acc[ai][bj][m][1];
#pragma unroll
                        for (int j = 0; j < 4; ++j) { v0[j] *= l8[j]; v1[j] *= l8[4 + j]; }
                        *(u32x4*)(rowa + bj * 128) = pack8(v0, v1); }
                    asm volatile("" ::: "memory"); }
        }
    }
};

template <int NT_, int LDB_>
struct ProbResid : ProbBase {
    static constexpr bool PERM = true; static constexpr int NT = NT_, LDB = LDB_;
    unsigned offA, lda2, kblk; unsigned offW; const bf16_t* H; bf16_t* Y; int a_phys;
    DI bool next(int i, Unit& u) const { const int L = i * G + c; if (L >= NMTC * 4) return false; const int pk = g8::static_map(L, NMTC, 4); Unit t; t.pm = pk & 0xffff; t.pn = pk >> 16; t.aux = 0; t.x0 = 0; t.x1 = 0; u = t; return true; }
    static constexpr bool GATHER = false;
    DI unsigned ldaB() const { return lda2; }
    DI unsigned a_unit(const Unit& u) const { return offA + (unsigned)(a_phys ? crow0(u.pm) : u.pm * 256) * lda2; }
    DI unsigned koffA(const Unit&, int t) const { return kblk ? (unsigned)(t >> 3) * kblk + (unsigned)(t & 7) * 128u : (unsigned)t * 128u; }
    DI int nt(const Unit&) const { return NT; }
    DI bool keep(const Unit&) const { return false; }
    DI const char* b_ptr(const Unit& u) const { return Abase + (size_t)offW + (size_t)u.pn * 256 * (LDB_ * 2); }
    DI void epi(Acc& acc, const Unit& u, int wr, int wc, int fr, int fq) const {
#pragma unroll
        for (int ai = 0; ai < 2; ++ai)
#pragma unroll
            for (int m = 0; m < 4; ++m) { const size_t ro = (size_t)PROW_OF(u.pm, ai, m) * D + u.pn * 256 + wc * 32 + 8 * fq;
#pragma unroll
                for (int bj = 0; bj < 2; ++bj) { const u32x4 hv = *(const u32x4*)(H + ro + bj * 128); float h8[8]; unpack8(hv, h8);
                    f32x4 v0 = acc[ai][bj][m][0], v1 = acc[ai][bj][m][1];
#pragma unroll
                    for (int j = 0; j < 4; ++j) { v0[j] += ALPHA * h8[j]; v1[j] += ALPHA * h8[4 + j]; }
                    *(u32x4*)(Y + ro + bj * 128) = pack8(v0, v1); }
                asm volatile("" ::: "memory"); }
    }
};

DI u32x2 swiglu4(const f32x4 g, const f32x4 up) { u32x2 w; w.x = cvt_pk_bf16(silu_(g[0]) * up[0], silu_(g[1]) * up[1]); w.y = cvt_pk_bf16(silu_(g[2]) * up[2], silu_(g[3]) * up[3]); return w; }
DI u32x4 widen_pair(const u32x2 a, const u32x2 b) {
    const auto r0 = __builtin_amdgcn_permlane16_swap(a.x, b.x, false, false); const auto r1 = __builtin_amdgcn_permlane16_swap(a.y, b.y, false, false);
    return (u32x4){r0[0], r1[0], r0[1], r1[1]};
}
struct ProbUpD : ProbBase {
    static constexpr bool PERM = false; static constexpr int NT = 16, LDB = 1024;
    unsigned offW; bf16_t* ACT;
    DI bool next(int i, Unit& u) const { const int L = i * G + c; if (L >= NMTC * 22) return false; const int pk = g8::static_map(L, NMTC, 22); Unit t; t.pm = pk & 0xffff; t.pn = pk >> 16; t.aux = 0; t.x0 = 0; t.x1 = 0; u = t; return true; }
    static constexpr bool GATHER = false;
    DI unsigned ldaB() const { return 2048u; }
    DI unsigned a_unit(const Unit& u) const { return (unsigned)WS_H + (unsigned)crow0(u.pm) * 2048u; }
    DI unsigned koffA(const Unit&, int t) const { return (unsigned)t * 128u; }
    DI int nt(const Unit&) const { return NT; }
    DI bool keep(const Unit&) const { return false; }
    DI const char* b_ptr(const Unit& u) const { return Abase + (size_t)offW + (size_t)u.pn * 256 * 2048; }
    DI void epi(Acc& acc, const Unit& u, int wr, int wc, int fr, int fq) const {
#pragma unroll
        for (int ai = 0; ai < 2; ++ai)
#pragma unroll
            for (int m = 0; m < 4; m += 2) { bf16_t* rowp = ACT + (size_t)ROW_OF(u.pm, ai, m + (fq & 1)) * DFF + u.pn * 128 + wc * 16 + 8 * (fq >> 1);
#pragma unroll
                for (int bj = 0; bj < 2; ++bj) *(u32x4*)(rowp + bj * 64) = widen_pair(swiglu4(acc[ai][bj][m][0], acc[ai][bj][m][1]), swiglu4(acc[ai][bj][m + 1][0], acc[ai][bj][m + 1][1])); }
    }
};

struct MoeTab {
    int cnt[8], tiles[8], ub[9], rb[8], nNt;
    DI void init(const unsigned* cw, int nN) {
        int u = 0, r = 0; nNt = nN;
#pragma unroll
        for (int e = 0; e < 8; ++e) { int c = (int)__builtin_amdgcn_readfirstlane(cw[e]); c = c > MG ? MG : c; cnt[e] = c; tiles[e] = (c + 255) >> 8; ub[e] = u; rb[e] = r; u += tiles[e] * nN; r += tiles[e]; }
        ub[8] = u;
    }
    DI bool find(int L0, Unit& u) const {
        if (L0 >= ub[8]) return false;
        int L = L0; { const int nwg = ub[8], q = nwg / 8, r = nwg % 8, xcd = L0 % 8, off = L0 / 8; L = (xcd < r ? xcd * (q + 1) : r * (q + 1) + (xcd - r) * q) + off; }
        int e = 0;
#pragma unroll
        for (int k = 1; k < 8; ++k) e += (L >= ub[k]) ? 1 : 0;
        int te = 1, ue = 0, re = 0, ce = 0;
#pragma unroll
        for (int k = 0; k < 8; ++k) if (e == k) { te = tiles[k]; ue = ub[k]; re = rb[k]; ce = cnt[k]; }
        const int r = L - ue; const int nig = 4 * nNt, gid = r / nig, w = r % nig, fm = gid * 4, gsz = (te - fm) < 4 ? (te - fm) : 4;
        Unit t; t.pm = fm + w % gsz; t.pn = w / gsz; t.aux = e; t.x0 = re; t.x1 = ce; u = t; return true;
    }
};

struct ProbUpM : ProbBase {
    static constexpr bool PERM = false; static constexpr int NT = 16, LDB = 1024;
    unsigned offW; bf16_t* ACT; const int* list; MoeTab tab;
    DI bool next(int i, Unit& u) const { return tab.find(i * G + c, u); }
    static constexpr bool GATHER = true;
    DI unsigned ldaB() const { return 2048u; }
    DI unsigned a_unit(const Unit&) const { return 0u; }
    DI void a_gather(const Unit& u, const int (&R)[2], const int (&C)[2], unsigned (&vo)[2][2]) const {
        const int* le = list + (size_t)u.aux * MG;
#pragma unroll
        for (int h = 0; h < 2; ++h)
#pragma unroll
            for (int i = 0; i < 2; ++i) { const int pos = u.pm * 256 + h * 128 + R[i]; const int tok = le[pos < u.x1 ? pos : 0];
                vo[h][i] = (unsigned)WS_H + (unsigned)tok * 2048u + (unsigned)C[i] * 2u; }
    }
    DI unsigned koffA(const Unit&, int t) const { return (unsigned)t * 128u; }
    DI int nt(const Unit&) const { return NT; }
    DI bool keep(const Unit&) const { return false; }
    DI const char* b_ptr(const Unit& u) const { return Abase + (size_t)offW + (size_t)u.aux * ((size_t)PROJW * D * 2) + (size_t)u.pn * 256 * 2048; }
    DI void epi(Acc& acc, const Unit& u, int wr, int wc, int fr, int fq) const {
#pragma unroll
        for (int ai = 0; ai < 2; ++ai)
#pragma unroll
            for (int m = 0; m < 4; m += 2) { bf16_t* rowp = ACT + (size_t)ROW_OF(u.x0 + u.pm, ai, m + (fq & 1)) * DFF + u.pn * 128 + wc * 16 + 8 * (fq >> 1);
#pragma unroll
                for (int bj = 0; bj < 2; ++bj) *(u32x4*)(rowp + bj * 64) = widen_pair(swiglu4(acc[ai][bj][m][0], acc[ai][bj][m][1]), swiglu4(acc[ai][bj][m + 1][0], acc[ai][bj][m + 1][1])); }
    }
};
struct ProbDownM : ProbBase {
    static constexpr bool PERM = true; static constexpr int NT = 44, LDB = 2816;
    unsigned offW; bf16_t* YS; const float* wlist; MoeTab tab;
    DI bool next(int i, Unit& u) const { return tab.find(i * G + c, u); }
    static constexpr bool GATHER = false;
    DI unsigned ldaB() const { return DFF * 2u; }
    DI unsigned a_unit(const Unit& u) const { return (unsigned)WS_ACT + (unsigned)(u.x0 + u.pm) * (256u * DFF * 2u); }
    DI unsigned koffA(const Unit&, int t) const { return (unsigned)t * 128u; }
    DI int nt(const Unit&) const { return NT; }
    DI bool keep(const Unit&) const { return false; }
    DI const char* b_ptr(const Unit& u) const { return Abase + (size_t)offW + (size_t)u.aux * ((size_t)D * DFF * 2) + (size_t)u.pn * 256 * (DFF * 2); }
    DI void epi(Acc& acc, const Unit& u, int wr, int wc, int fr, int fq) const {
        const float* we = wlist + (size_t)u.aux * MG;
#pragma unroll
        for (int ai = 0; ai < 2; ++ai)
#pragma unroll
            for (int m = 0; m < 4; ++m) { const int pos = ROW_OF(u.pm, ai, m); const float w = pos < u.x1 ? we[pos] : 0.f;
                bf16_t* rowp = YS + (size_t)(u.x0 * 256 + pos) * D + u.pn * 256 + wc * 32 + 8 * fq;
#pragma unroll
                for (int bj = 0; bj < 2; ++bj) *(u32x4*)(rowp + bj * 128) = pack8(acc[ai][bj][m][0] * w, acc[ai][bj][m][1] * w); }
    }
};

struct Args { const float* in[27]; float* out; unsigned char* ws; };
struct Ctx {
    LAS unsigned char* lds; volatile LAS unsigned* MISC;
    unsigned char* ws; unsigned* ctl; float* out;
    int wave, G, gw, NGW;
};
DI int crow(int r, int hi) { return (r & 3) + 8 * (r >> 2) + 4 * hi; }

template <int PH>
DI void transpose_item(const float* W, int N, bf16_t* WT, int ldt, int kofs, int row_off, int mode, LAS float* scr, int item, int lane, f32x4 (&ld)[8]) {
    const int nblk = N / 32, kb = item / nblk, nb = item % nblk, k0 = 64 * kb, n0 = 32 * nb;
    if (PH != 1) {
#pragma unroll
        for (int i = 0; i < 8; ++i) ld[i] = *(const f32x4*)(W + (size_t)(k0 + 8 * i + (lane >> 3)) * N + n0 + 4 * (lane & 7)); }
    if (PH == 0) return;
#pragma unroll
    for (int i = 0; i < 8; ++i) { LAS float* d = scr + (8 * i + (lane >> 3)) * 33 + 4 * (lane & 7); d[0] = ld[i][0]; d[1] = ld[i][1]; d[2] = ld[i][2]; d[3] = ld[i][3]; }
    asm volatile("s_waitcnt lgkmcnt(0)" ::: "memory");
    const int c = lane & 7;
    const float sc = (mode == 1 && n0 < 512) ? QSCALE : 1.0f;
#pragma unroll
    for (int j = 0; j < 4; ++j) { const int n = (lane >> 3) + 8 * j; const LAS float* s = scr + (8 * c) * 33 + n;
        const int ns = n0 + n; int drow;
        if (mode == 0) drow = row_off + ns;
        else if (mode == 1) drow = ns < 1024 ? ns : (ns < 1536 ? 5120 + (ns - 1024) : ns - 512);
        else drow = 32 * (ns >> 4) + 16 * row_off + (ns & 15);
        u32x4 o; o.x = cvt_pk_bf16(s[0 * 33] * sc, s[1 * 33] * sc); o.y = cvt_pk_bf16(s[2 * 33] * sc, s[3 * 33] * sc); o.z = cvt_pk_bf16(s[4 * 33] * sc, s[5 * 33] * sc); o.w = cvt_pk_bf16(s[6 * 33] * sc, s[7 * 33] * sc);
        *(u32x4*)(WT + (size_t)drow * ldt + kofs + k0 + 8 * c) = o; }
    asm volatile("s_waitcnt lgkmcnt(0)" ::: "memory");
}
namespace cv {
constexpr int L_IN = 16 * 176, L_AO = 8 * 32, L_LO = 16 * 32, L_O = 16 * 32, L_G = 32;
constexpr int L_ALL = L_IN + L_AO + L_LO + L_O + 2 * L_G;
constexpr int F_G = 16 * 88, F_D = 44 * 32, F_ALL = 2 * F_G + F_D;
constexpr int NITEMS = DEPTH * L_ALL + 18 * F_ALL;
DI int ffn_base(int l) { return DEPTH * L_ALL + (l == 1 ? 2 : (l == 2 ? 1 : 10)) * F_ALL; }
DI int ffn_count(int l) { return (l == 2 ? 1 : 8) * F_ALL; }
constexpr int PER_BATCH = 32;
}
template <int PH>
DI void conv_item(Ctx& F, const Args& a, const int it, LAS float* scr, const int lane, f32x4 (&ld)[8]) {
    using namespace cv;
    unsigned char* ws = F.ws;
        if (it < DEPTH * L_ALL) {
            const int l = it / L_ALL; int r = it % L_ALL;
            if (r < L_IN) { transpose_item<PH>(a.in[4] + (size_t)l * D * PROJW, PROJW, (bf16_t*)(ws + WS_WIN) + (size_t)l * PROJW * D, D, 0, 0, 1, scr, r, lane, ld); return; } r -= L_IN;
            if (r < L_AO) { transpose_item<PH>(a.in[15] + (size_t)l * 512 * D, D, (bf16_t*)(ws + WS_WMIX) + (size_t)l * D * 1536, 1536, 0, 0, 0, scr, r, lane, ld); return; } r -= L_AO;
            if (r < L_LO) { transpose_item<PH>(a.in[16] + (size_t)l * D * D, D, (bf16_t*)(ws + WS_WMIX) + (size_t)l * D * 1536, 1536, 512, 0, 0, scr, r, lane, ld); return; } r -= L_LO;
            if (r < L_O) { transpose_item<PH>(a.in[17] + (size_t)l * D * D, D, (bf16_t*)(ws + WS_WO) + (size_t)l * D * D, D, 0, 0, 0, scr, r, lane, ld); return; } r -= L_O;
            const int which = r / L_G, hh = (r % L_G) >> 1, sub = r & 1;
            const float* p10 = a.in[10]; const float* p12 = a.in[12]; asm volatile("" : "+s"(p10), "+s"(p12));
    transpose_item<PH>((which ? p12 : p10) + ((size_t)l * 16 + hh) * 4096, 64, (bf16_t*)(ws + (which ? WS_WI : WS_WR)) + ((size_t)l * 16 + hh) * 4096, 64, 0, 0, 0, scr, sub, lane, ld);
        } else {
            const int r0 = it - DEPTH * L_ALL, set = r0 / F_ALL; int r = r0 % F_ALL;
            const float *wg, *wu, *wd; bf16_t *dgu, *dd;
            if (set < 2) { wg = a.in[20] + (size_t)set * D * DFF; wu = a.in[21] + (size_t)set * D * DFF; wd = a.in[22] + (size_t)set * DFF * D; asm volatile("" : "+s"(wg), "+s"(wu), "+s"(wd));
                dgu = (bf16_t*)(ws + WS_WGUD) + (size_t)set * PROJW * D; dd = (bf16_t*)(ws + WS_WDD) + (size_t)set * D * DFF; }
            else { const int s2 = set - 2; wg = a.in[24] + (size_t)s2 * D * DFF; wu = a.in[25] + (size_t)s2 * D * DFF; wd = a.in[26] + (size_t)s2 * DFF * D; asm volatile("" : "+s"(wg), "+s"(wu), "+s"(wd));
                dgu = (bf16_t*)(ws + WS_WGUM) + (size_t)s2 * PROJW * D; dd = (bf16_t*)(ws + WS_WDM) + (size_t)s2 * D * DFF; }
            if (r < F_G) { transpose_item<PH>(wg, DFF, dgu, D, 0, 0, 2, scr, r, lane, ld); return; } r -= F_G;
            if (r < F_G) { transpose_item<PH>(wu, DFF, dgu, D, 0, 1, 2, scr, r, lane, ld); return; } r -= F_G;
            transpose_item<PH>(wd, D, dd, DFF, 0, 0, 0, scr, r, lane, ld);
        }
}
DI void prologue(Ctx& F, const Args& a) {
    using namespace cv;
    const int tid = opaque(threadIdx.x), lane = tid & 63;
    LAS float* scr = (LAS float*)(F.lds + F.wave * 16384);
    unsigned char* ws = F.ws;
    f32x4 ld[8];
    for (int j = opaque_s(F.gw); j < L_ALL + F_ALL; j += F.NGW) conv_item<2>(F, a, j < L_ALL ? j : DEPTH * L_ALL + (j - L_ALL), scr, lane, ld);
    float* tab = (float*)(ws + WS_TAB);
    for (int i = blockIdx.x * 512 + tid; i < DEPTH * D; i += F.G * 512) { const float x = a.in[14][i]; tab[i] = log1pf(expf(-x)); }
    if (blockIdx.x == 0 && tid < DEPTH) { const int l = tid; const float* dl = a.in[6] + l * 128; float s1 = 0.f, s2 = 0.f;
        for (int j = 0; j < 32; ++j) { s1 += dl[j] * dl[32 + j]; s2 += dl[64 + j] * dl[96 + j]; }
        const float lam_init = 0.8f - 0.6f * expf(-0.3f * (float)l);
        tab[DEPTH * D + 2 * l] = expf(s1) - expf(s2) + lam_init; tab[DEPTH * D + 2 * l + 1] = 1.0f - lam_init; }
}

DI void ln_in_phase(Ctx& F, const Args& a, int g) {
    const int tid = opaque(threadIdx.x), lane = tid & 63; (void)tid;
    bf16_t* H = (bf16_t*)(F.ws + WS_H);
    const float* gam = a.in[2]; const float* bet = a.in[3];
    for (int row = opaque_s(F.gw); row < MG; row += F.NGW) {
        const int bl = row / TP, r = row % TP;
        u32x4* o = (u32x4*)(H + (size_t)row * D) + lane;
        const bool padrow = r < PADR;
        const float* src = r < FRAME0 ? a.in[1] + (size_t)(padrow ? 0 : r - PADR) * D : a.in[0] + ((size_t)(g * GB + bl) * SEQ + (r - FRAME0)) * D;
        f32x4 v[4]; float s = 0.f;
#pragma unroll
        for (int j = 0; j < 4; ++j) { v[j] = *(const f32x4*)(src + (j >> 1) * 512 + lane * 8 + (j & 1) * 4); s += (v[j][0] + v[j][1]) + (v[j][2] + v[j][3]); }
        const float mean = wave_sum(s) * (1.f / D); float s2 = 0.f;
#pragma unroll
        for (int j = 0; j < 4; ++j) { v[j] = v[j] - mean; s2 += (v[j][0] * v[j][0] + v[j][1] * v[j][1]) + (v[j][2] * v[j][2] + v[j][3] * v[j][3]); }
        const float rstd = 1.f / sqrtf(wave_sum(s2) * (1.f / D) + 1e-5f);
#pragma unroll
        for (int j = 0; j < 4; ++j) { const int c0 = (j >> 1) * 512 + lane * 8 + (j & 1) * 4; const f32x4 gg = *(const f32x4*)(gam + c0), bb = *(const f32x4*)(bet + c0); v[j] = v[j] * rstd * gg + bb; }
        u32x4 w0 = pack8(v[0], v[1]), w1 = pack8(v[2], v[3]);
        if (padrow) { w0 = (u32x4){0u, 0u, 0u, 0u}; w1 = w0; }
        o[0] = w0; o[64] = w1;
    }
}

template <int MODE, bool FINAL>
DI void ln_phase(Ctx& F, const Args& a, int g, const float* gam, const float* bet, const float* router, unsigned* cntw) {
    const int tid = opaque(threadIdx.x), lane = tid & 63; (void)tid;
    bf16_t* H = (bf16_t*)(F.ws + WS_H);
    const bf16_t* Y = (const bf16_t*)((const unsigned char*)F.out + OUT_Y);
    const bf16_t* YS = (const bf16_t*)(F.ws + WS_YSLOT);
    unsigned* tokinfo = (unsigned*)(F.ws + WS_ROUTE);
    int* list = (int*)(F.ws + WS_ROUTE + (size_t)MG * 32);
    float* wlist = (float*)(F.ws + WS_ROUTE + (size_t)MG * 32 + (size_t)8 * MG * 4);
    LAS float* wrt = (LAS float*)F.lds;
    LAS unsigned* recs = (LAS unsigned*)(F.lds + 32768);
    LAS unsigned* lcnt = (LAS unsigned*)(F.lds + 32768 + 8 * 20 * 32);
    LAS unsigned* lbase = lcnt + 8;
    int rbase[8]; int nrec = 0;
    const int gw0 = opaque_s(F.gw);
    if (MODE == 1) {
        for (int i = tid; i < 8 * D; i += 512) { const int c = i >> 3, e = i & 7; wrt[e * D + c] = router[i]; }
        if (tid < 32) lcnt[tid] = 0u;
        __syncthreads();
    }
    if (MODE == 3) { int r = 0;
#pragma unroll
        for (int e = 0; e < 8; ++e) { int c = (int)__builtin_amdgcn_readfirstlane(cntw[e]); c = c > MG ? MG : c; rbase[e] = r; r += ((c + 255) >> 8) * 256; } }
    for (int row = gw0; row < MG; row += F.NGW) {
        const int rbl = row / TP, rrr = row % TP;
        if (rrr < FRAME0 && (rbl != 0 || rrr < PADR)) continue;
        float v[16];
        if (MODE == 3) {
            const u32x4 ti = *(const u32x4*)(tokinfo + (size_t)row * 8);
            int s1 = 0, s2 = 0;
#pragma unroll
            for (int e = 0; e < 8; ++e) { if ((int)ti.x == e) s1 = rbase[e] + (int)ti.y; if ((int)ti.z == e) s2 = rbase[e] + (int)ti.w; }
#pragma unroll
            for (int hh = 0; hh < 2; ++hh) { const int c0 = hh * 512 + lane * 8;
                const u32x4 hv = *(const u32x4*)(H + (size_t)row * D + c0), y1 = *(const u32x4*)(YS + (size_t)s1 * D + c0), y2 = *(const u32x4*)(YS + (size_t)s2 * D + c0);
                float h8[8], a8[8], b8[8]; unpack8(hv, h8); unpack8(y1, a8); unpack8(y2, b8);
#pragma unroll
                for (int j = 0; j < 8; ++j) v[hh * 8 + j] = ALPHA * h8[j] + (a8[j] + b8[j]); }
        } else {
#pragma unroll
            for (int hh = 0; hh < 2; ++hh) { const u32x4 yv = *(const u32x4*)(Y + (size_t)row * D + hh * 512 + lane * 8); float y8[8]; unpack8(yv, y8);
#pragma unroll
                for (int j = 0; j < 8; ++j) v[hh * 8 + j] = y8[j]; }
        }
        float s = 0.f;
#pragma unroll
        for (int j = 0; j < 16; ++j) s += v[j];
        const float mean = wave_sum(s) * (1.f / D); float s2 = 0.f;
#pragma unroll
        for (int j = 0; j < 16; ++j) { v[j] -= mean; s2 += v[j] * v[j]; }
        const float rstd = 1.f / sqrtf(wave_sum(s2) * (1.f / D) + 1e-5f);
#pragma unroll
        for (int hh = 0; hh < 2; ++hh) { const int c0 = hh * 512 + lane * 8;
#pragma unroll
            for (int q = 0; q < 2; ++q) { const f32x4 gg = *(const f32x4*)(gam + c0 + 4 * q), bb = *(const f32x4*)(bet + c0 + 4 * q);
#pragma unroll
                for (int j = 0; j < 4; ++j) v[hh * 8 + q * 4 + j] = v[hh * 8 + q * 4 + j] * rstd * gg[j] + bb[j]; } }
#pragma unroll
        for (int hh = 0; hh < 2; ++hh) { u32x4 w; w.x = cvt_pk_bf16(v[hh * 8 + 0], v[hh * 8 + 1]); w.y = cvt_pk_bf16(v[hh * 8 + 2], v[hh * 8 + 3]); w.z = cvt_pk_bf16(v[hh * 8 + 4], v[hh * 8 + 5]); w.w = cvt_pk_bf16(v[hh * 8 + 6], v[hh * 8 + 7]);
            *(u32x4*)(H + (size_t)row * D + hh * 512 + lane * 8) = w;
            if (rrr < FRAME0) {
#pragma unroll
                for (int k = 1; k < GB; ++k) *(u32x4*)(H + ((size_t)row + (size_t)k * TP) * D + hh * 512 + lane * 8) = w; } }
        if (FINAL) {
            const int bl = row / TP, r = row % TP;
            if (r >= FRAME0) { float* op = F.out + ((size_t)(g * GB + bl) * SEQ + (r - FRAME0)) * D;
#pragma unroll
                for (int hh = 0; hh < 2; ++hh)
#pragma unroll
                    for (int q = 0; q < 2; ++q) *(f32x4*)(op + hh * 512 + lane * 8 + 4 * q) = (f32x4){v[hh * 8 + q * 4], v[hh * 8 + q * 4 + 1], v[hh * 8 + q * 4 + 2], v[hh * 8 + q * 4 + 3]}; }
        }
        if (MODE == 1) {
            float lg[8];
#pragma unroll
            for (int e = 0; e < 8; ++e) { float acc = 0.f;
#pragma unroll
                for (int hh = 0; hh < 2; ++hh) { const LAS f32x4* wp = (const LAS f32x4*)(wrt + e * D + hh * 512 + lane * 8); const f32x4 w0 = wp[0], w1 = wp[1];
#pragma unroll
                    for (int j = 0; j < 4; ++j) acc += v[hh * 8 + j] * w0[j] + v[hh * 8 + 4 + j] * w1[j]; }
                lg[e] = wave_sum(acc); }
            int e1 = 0; float l1 = lg[0];
#pragma unroll
            for (int e = 1; e < 8; ++e) if (lg[e] > l1) { l1 = lg[e]; e1 = e; }
            int e2 = -1; float l2 = -INFINITY;
#pragma unroll
            for (int e = 0; e < 8; ++e) if (e != e1 && lg[e] > l2) { l2 = lg[e]; e2 = e; }
            const float w2 = rcpf_(1.0f + ex2(LOG2E * (l1 - l2))), w1 = 1.0f - w2;
            if (lane == 0) {
                const unsigned q1 = __hip_atomic_fetch_add(lcnt + e1, 1u, __ATOMIC_RELAXED, __HIP_MEMORY_SCOPE_WORKGROUP), q2 = __hip_atomic_fetch_add(lcnt + e2, 1u, __ATOMIC_RELAXED, __HIP_MEMORY_SCOPE_WORKGROUP);
                LAS unsigned* rc = recs + (F.wave * 20 + nrec) * 8;
                rc[0] = (unsigned)e1; rc[1] = q1; rc[2] = (unsigned)e2; rc[3] = q2; rc[4] = __float_as_uint(w1); rc[5] = __float_as_uint(w2); rc[6] = (unsigned)row;
            }
            ++nrec;
        }
    }
    if (MODE == 1) {
        if (lane == 0) lcnt[16 + F.wave] = (unsigned)nrec;
        __syncthreads();
        if (tid < 8) lbase[tid] = atomicAdd(cntw + tid, lcnt[tid]);
        __syncthreads();
        const int wv = tid / 20, k = tid % 20;
        if (wv < 8 && k < (int)lcnt[16 + (wv & 7)]) {
            const LAS unsigned* rc = recs + (wv * 20 + k) * 8;
            const unsigned e1 = rc[0], e2 = rc[2], p1 = lbase[e1] + rc[1], p2 = lbase[e2] + rc[3]; const int row = (int)rc[6];
            *(u32x4*)(tokinfo + (size_t)row * 8) = (u32x4){e1, p1, e2, p2};
            if (p1 < (unsigned)MG) { list[(size_t)e1 * MG + p1] = row; wlist[(size_t)e1 * MG + p1] = __uint_as_float(rc[4]); }
            if (p2 < (unsigned)MG) { list[(size_t)e2 * MG + p2] = row; wlist[(size_t)e2 * MG + p2] = __uint_as_float(rc[5]); }
        }
        __syncthreads();
    }
}

template <int MODE, bool FINAL>
DI void ln_fast(Ctx& F, const Args& a, int g, const float* gam, const float* bet, unsigned* cntw) {
    constexpr int R = 4;
    const int lane = opaque(threadIdx.x) & 63;
    bf16_t* H = (bf16_t*)(F.ws + WS_H);
    const bf16_t* Y = (const bf16_t*)((const unsigned char*)F.out + OUT_Y);
    const bf16_t* YS = (const bf16_t*)(F.ws + WS_YSLOT);
    const unsigned* tokinfo = (const unsigned*)(F.ws + WS_ROUTE);
    int rbase[8];
    if (MODE == 3) { int r = 0;
#pragma unroll
        for (int e = 0; e < 8; ++e) { int c = (int)__builtin_amdgcn_readfirstlane(cntw[e]); c = c > MG ? MG : c; rbase[e] = r; r += ((c + 255) >> 8) * 256; } }
    float gv[16], bv[16];
#pragma unroll
    for (int hh = 0; hh < 2; ++hh)
#pragma unroll
        for (int q = 0; q < 2; ++q) { const f32x4 gg = *(const f32x4*)(gam + hh * 512 + lane * 8 + 4 * q), bb = *(const f32x4*)(bet + hh * 512 + lane * 8 + 4 * q);
#pragma unroll
            for (int j = 0; j < 4; ++j) { gv[hh * 8 + q * 4 + j] = gg[j]; bv[hh * 8 + q * 4 + j] = bb[j]; } }
    for (int base = opaque_s(F.gw) * R; base < MG; base += F.NGW * R) {
        float v[R][16]; bool ok[R]; int rr_[R];
#pragma unroll
        for (int r = 0; r < R; ++r) { const int row = base + r; const int rbl = row / TP, rrr = row % TP; rr_[r] = rrr; ok[r] = !(rrr < FRAME0 && (rbl != 0 || rrr < PADR)); }
        if (MODE == 3) {
            u32x4 ti[R];
#pragma unroll
            for (int r = 0; r < R; ++r) ti[r] = *(const u32x4*)(tokinfo + (size_t)(base + r) * 8);
#pragma unroll
            for (int r = 0; r < R; ++r) { int s1 = 0, s2 = 0;
                if (ok[r]) {
#pragma unroll
                    for (int e = 0; e < 8; ++e) { if ((int)ti[r].x == e) s1 = rbase[e] + (int)ti[r].y; if ((int)ti[r].z == e) s2 = rbase[e] + (int)ti[r].w; } }
                s1 = s1 < SLOT_ROWS ? s1 : 0; s2 = s2 < SLOT_ROWS ? s2 : 0;
#pragma unroll
                for (int hh = 0; hh < 2; ++hh) { const int c0 = hh * 512 + lane * 8;
                    const u32x4 hv = *(const u32x4*)(H + (size_t)(base + r) * D + c0), y1 = *(const u32x4*)(YS + (size_t)s1 * D + c0), y2 = *(const u32x4*)(YS + (size_t)s2 * D + c0);
                    float h8[8], a8[8], b8[8]; unpack8(hv, h8); unpack8(y1, a8); unpack8(y2, b8);
#pragma unroll
                    for (int j = 0; j < 8; ++j) v[r][hh * 8 + j] = ALPHA * h8[j] + (a8[j] + b8[j]); } }
        } else {
#pragma unroll
            for (int r = 0; r < R; ++r)
#pragma unroll
                for (int hh = 0; hh < 2; ++hh) { const u32x4 yv = *(const u32x4*)(Y + (size_t)(base + r) * D + hh * 512 + lane * 8); float y8[8]; unpack8(yv, y8);
#pragma unroll
                    for (int j = 0; j < 8; ++j) v[r][hh * 8 + j] = y8[j]; }
        }
        float sm[R], sq[R];
#pragma unroll
        for (int r = 0; r < R; ++r) { float s = 0.f;
#pragma unroll
            for (int j = 0; j < 16; ++j) s += v[r][j];
            sm[r] = s; }
#pragma unroll
        for (int r = 0; r < R; ++r) sm[r] = wave_sum(sm[r]);
#pragma unroll
        for (int r = 0; r < R; ++r) { const float mean = sm[r] * (1.f / D); float s2 = 0.f;
#pragma unroll
            for (int j = 0; j < 16; ++j) { v[r][j] -= mean; s2 += v[r][j] * v[r][j]; }
            sq[r] = s2; }
#pragma unroll
        for (int r = 0; r < R; ++r) sq[r] = wave_sum(sq[r]);
#pragma unroll
        for (int r = 0; r < R; ++r) {
            const float rstd = 1.f / sqrtf(sq[r] * (1.f / D) + 1e-5f);
#pragma unroll
            for (int j = 0; j < 16; ++j) v[r][j] = v[r][j] * rstd * gv[j] + bv[j];
            if (ok[r]) {
                const int row = base + r;
                if (!FINAL)
#pragma unroll
                for (int hh = 0; hh < 2; ++hh) { u32x4 w; w.x = cvt_pk_bf16(v[r][hh * 8 + 0], v[r][hh * 8 + 1]); w.y = cvt_pk_bf16(v[r][hh * 8 + 2], v[r][hh * 8 + 3]); w.z = cvt_pk_bf16(v[r][hh * 8 + 4], v[r][hh * 8 + 5]); w.w = cvt_pk_bf16(v[r][hh * 8 + 6], v[r][hh * 8 + 7]);
                    *(u32x4*)(H + (size_t)row * D + hh * 512 + lane * 8) = w;
                    if (rr_[r] < FRAME0) {
#pragma unroll
                        for (int k = 1; k < GB; ++k) *(u32x4*)(H + ((size_t)row + (size_t)k * TP) * D + hh * 512 + lane * 8) = w; } }
                if (FINAL && rr_[r] >= FRAME0) { float* op = F.out + ((size_t)(g * GB + row / TP) * SEQ + (rr_[r] - FRAME0)) * D;
#pragma unroll
                    for (int hh = 0; hh < 2; ++hh)
#pragma unroll
                        for (int q = 0; q < 2; ++q) *(f32x4*)(op + hh * 512 + lane * 8 + 4 * q) = (f32x4){v[r][hh * 8 + q * 4], v[r][hh * 8 + q * 4 + 1], v[r][hh * 8 + q * 4 + 2], v[r][hh * 8 + q * 4 + 3]}; }
            }
        }
    }
}

constexpr int NSC = 16;
constexpr int LRU_WAVE_LDS = 14336;
template <bool PASS2, bool META = false>
DI void lru_phase(Ctx& F, const Args& a, int l, bool dummy = false) {
    const int lane = opaque(threadIdx.x) & 63, r32 = lane & 31, hi = lane >> 5;
    bf16_t* Z = (bf16_t*)(F.ws + WS_Z);
    const bf16_t* WrT = (const bf16_t*)(F.ws + WS_WR) + (size_t)l * 16 * 4096;
    const bf16_t* WiT = (const bf16_t*)(F.ws + WS_WI) + (size_t)l * 16 * 4096;
    float* aggA = (float*)(F.ws + WS_AGG); float* aggH = aggA + (size_t)GB * NSC * D; float* aggM = aggH + (size_t)GB * NSC * D;
    const float* spt = (const float*)(F.ws + WS_TAB) + l * D;
    const float* cw = a.in[8] + (size_t)l * 4 * D; const float* cbv = a.in[9] + (size_t)l * D;
    const float* brv = a.in[11] + (size_t)l * D; const float* biv = a.in[13] + (size_t)l * D;
    LAS bf16_t* xraw = (LAS bf16_t*)(F.lds + F.wave * LRU_WAVE_LDS);
    LAS bf16_t* xcb = xraw + 2560;
    LAS bf16_t* gbf = xcb + 2304;
    for (int unit = opaque_s(F.gw); unit < (META ? 16 : GB * 16 * NSC); unit += F.NGW) {
        const int head = unit & 15, sc = META ? 0 : (unit >> 4) & 15, bl = META ? 0 : unit >> 8;
        const int t0 = META ? 1 : 2 + 8 * sc, ntile = opaque_s(META ? 1 : 8);
        const size_t rowb = (size_t)bl * TP;
        bf16x8 wrf[2][4], wif[2][4];
#pragma unroll
        for (int ct = 0; ct < 2; ++ct)
#pragma unroll
            for (int ks = 0; ks < 4; ++ks) { const size_t o = (size_t)(head * 64 + ct * 32 + r32) * 64 + ks * 16 + hi * 8; wrf[ct][ks] = *(const bf16x8*)(WrT + o); wif[ct][ks] = *(const bf16x8*)(WiT + o); }
        float c0[2], c1[2], c2[2], c3[2], cb[2], br[2], bi[2], sp8[2], hst[2], apr[2];
#pragma unroll
        for (int ct = 0; ct < 2; ++ct) { const int ch = head * 64 + ct * 32 + r32;
            c0[ct] = cw[ch]; c1[ct] = cw[D + ch]; c2[ct] = cw[2 * D + ch]; c3[ct] = cw[3 * D + ch]; cb[ct] = cbv[ch]; br[ct] = -LOG2E * brv[ch]; bi[ct] = -LOG2E * biv[ch]; sp8[ct] = -8.0f * LOG2E * spt[ch];
            hst[ct] = 0.f; apr[ct] = 1.f; }
        if (PASS2 && !META) {
#pragma unroll
            for (int ct = 0; ct < 2; ++ct) hst[ct] = aggM[head * 64 + ct * 32 + r32];
#pragma unroll
            for (int kb = 0; kb < 2; ++kb) { float fa[2][8], fh[2][8];
#pragma unroll
                for (int k = 0; k < 8; ++k)
#pragma unroll
                    for (int ct = 0; ct < 2; ++ct) { const int kk = kb * 8 + k; const bool on = kk < sc; const size_t o = ((size_t)bl * NSC + (on ? kk : 0)) * D + head * 64 + ct * 32 + r32;
                        const float av = aggA[o], hv = aggH[o]; fa[ct][k] = on ? av : 1.0f; fh[ct][k] = on ? hv : 0.f; }
#pragma unroll
                for (int k = 0; k < 8; ++k)
#pragma unroll
                    for (int ct = 0; ct < 2; ++ct) hst[ct] = fa[ct][k] * hst[ct] + fh[ct][k]; }
        }
        u32x4 px[5], pg[4];
#define LRU_LOAD(tile) do { const int _r0 = (tile) * 32; \
            _Pragma("unroll") for (int k = 0; k < 5; ++k) { const int p = lane + 64 * k; const int j = p >> 3, c8 = p & 7; const int rr = _r0 - 3 + j; const int rc = rr < 0 ? 0 : rr; \
                u32x4 v = (u32x4){0u, 0u, 0u, 0u}; if (p < 280) v = *(const u32x4*)(Z + ZOFF(rowb + rc, ZXR + head * 64 + c8 * 8)); if (META && rr < PADR) v = (u32x4){0u, 0u, 0u, 0u}; px[k] = v; } \
            if (PASS2) { _Pragma("unroll") for (int k = 0; k < 4; ++k) { const int p = lane + 64 * k; pg[k] = *(const u32x4*)(Z + ZOFF(rowb + _r0 + (p >> 3), ZGR + head * 64 + (p & 7) * 8)); } } } while (0)
        LRU_LOAD(t0);
        for (int ti = 0; ti < ntile; ++ti) {
            const int r0 = (t0 + ti) * 32;
#pragma unroll
            for (int k = 0; k < 5; ++k) { const int p = lane + 64 * k; if (p < 280) *(LAS u32x4*)(xraw + (p >> 3) * 72 + (p & 7) * 8) = px[k]; }
            if (PASS2) {
#pragma unroll
                for (int k = 0; k < 4; ++k) { const int p = lane + 64 * k; *(LAS u32x4*)(gbf + (p >> 3) * 72 + (p & 7) * 8) = pg[k]; } }
            if (ti + 1 < ntile) LRU_LOAD(t0 + ti + 1);
            f32x16 xc[2];
#pragma unroll
            for (int ct = 0; ct < 2; ++ct) {
#pragma unroll
                for (int sg = 0; sg < 4; ++sg) { float xw[7];
#pragma unroll
                    for (int d = 0; d < 7; ++d) xw[d] = bf2f(xraw[(8 * sg + 4 * hi + d) * 72 + ct * 32 + r32]);
#pragma unroll
                    for (int q = 0; q < 4; ++q) xc[ct][4 * sg + q] = cb[ct] + c0[ct] * xw[q] + c1[ct] * xw[q + 1] + c2[ct] * xw[q + 2] + c3[ct] * xw[q + 3]; } }
#pragma unroll
            for (int ct = 0; ct < 2; ++ct)
#pragma unroll
                for (int r = 0; r < 16; ++r) xcb[crow(r, hi) * 72 + ct * 32 + r32] = f2bf(xc[ct][r]);
            bf16x8 af[4];
#pragma unroll
            for (int ks = 0; ks < 4; ++ks) af[ks] = *(const LAS bf16x8*)(xcb + r32 * 72 + ks * 16 + hi * 8);
#pragma unroll
            for (int ct = 0; ct < 2; ++ct) {
                f32x16 grx, gix;
#pragma unroll
                for (int r = 0; r < 16; ++r) { grx[r] = 0.f; gix[r] = 0.f; }
#pragma unroll
                for (int ks = 0; ks < 4; ++ks) { grx = __builtin_amdgcn_mfma_f32_32x32x16_bf16(af[ks], wrf[ct][ks], grx, 0, 0, 0); gix = __builtin_amdgcn_mfma_f32_32x32x16_bf16(af[ks], wif[ct][ks], gix, 0, 0, 0); }
                f32x16 av, uv;
#pragma unroll
                for (int r = 0; r < 16; ++r) { const float rg = rcpf_(1.0f + ex2(__builtin_fmaf(grx[r], -LOG2E, br[ct]))), ig = rcpf_(1.0f + ex2(__builtin_fmaf(gix[r], -LOG2E, bi[ct])));
                    const float aa = ex2(sp8[ct] * rg); const float m2 = 1.0f - aa * aa; const float mult = __builtin_amdgcn_sqrtf(__builtin_fmaxf(m2, 0.f));
                    const bool pad = (r0 + crow(r, hi)) < PADR;
                    av[r] = pad ? 1.0f : aa; uv[r] = pad ? 0.f : mult * ig * xc[ct][r]; }
                float As[4], Us[4];
#pragma unroll
                for (int sg = 0; sg < 4; ++sg) { As[sg] = (av[4 * sg] * av[4 * sg + 1]) * (av[4 * sg + 2] * av[4 * sg + 3]);
                    Us[sg] = ((uv[4 * sg] * av[4 * sg + 1] + uv[4 * sg + 1]) * av[4 * sg + 2] + uv[4 * sg + 2]) * av[4 * sg + 3] + uv[4 * sg + 3]; }
                float h = hst[ct], hs[4];
#pragma unroll
                for (int sg = 0; sg < 4; ++sg) { const float he0 = As[sg] * h + Us[sg]; const float t = bcast_lo(he0);
                    const float he1 = As[sg] * t + Us[sg];
                    hs[sg] = hi ? t : h; h = bcast_hi(he1); }
                hst[ct] = h;
                if (!PASS2) { const float own = (As[0] * As[1]) * (As[2] * As[3]); apr[ct] *= bcast_lo(own) * bcast_hi(own); }
                else {
#pragma unroll
                    for (int sg = 0; sg < 4; ++sg) { float hh = hs[sg];
#pragma unroll
                        for (int q = 0; q < 4; ++q) { hh = av[4 * sg + q] * hh + uv[4 * sg + q];
                            LAS bf16_t* p = gbf + (8 * sg + 4 * hi + q) * 72 + ct * 32 + r32; *p = f2bf(hh * bf2f(*p)); } }
                }
            }
            if (PASS2) {
#pragma unroll
                for (int k = 0; k < 4; ++k) { const int p = lane + 64 * k; const u32x4 v = *(const LAS u32x4*)(gbf + (p >> 3) * 72 + (p & 7) * 8);
                    bf16_t* dst = dummy ? (bf16_t*)(F.ws + WS_YSLOT) + (rowb + r0 + (p >> 3)) * 1024 + head * 64 + (p & 7) * 8 : Z + ZOFF(rowb + r0 + (p >> 3), ZGR + head * 64 + (p & 7) * 8);
                    *(u32x4*)dst = v; } }
        }
#undef LRU_LOAD
        if (!PASS2 && hi == 0) {
#pragma unroll
            for (int ct = 0; ct < 2; ++ct) { const size_t o = ((size_t)bl * NSC + sc) * D + head * 64 + ct * 32 + r32; aggA[o] = apr[ct]; aggH[o] = hst[ct]; } }
        if (META && hi == 0) {
#pragma unroll
            for (int ct = 0; ct < 2; ++ct) aggM[head * 64 + ct * 32 + r32] = hst[ct]; }
    }
}

DI float max3f(float a, float b, float c) { float r; asm("v_max3_f32 %0, %1, %2, %3" : "=v"(r) : "v"(a), "v"(b), "v"(c)); return r; }
DI float max16f(const f32x16& a) { float r;
    asm("v_max3_f32 %0, %1, %2, %3\n\tv_max3_f32 %0, %0, %4, %5\n\tv_max3_f32 %0, %0, %6, %7\n\tv_max3_f32 %0, %0, %8, %9\n\tv_max3_f32 %0, %0, %10, %11\n\tv_max3_f32 %0, %0, %12, %13\n\tv_max3_f32 %0, %0, %14, %15\n\tv_max3_f32 %0, %0, %16, %16"
        : "=&v"(r) : "v"(a[0]), "v"(a[1]), "v"(a[2]), "v"(a[3]), "v"(a[4]), "v"(a[5]), "v"(a[6]), "v"(a[7]), "v"(a[8]), "v"(a[9]), "v"(a[10]), "v"(a[11]), "v"(a[12]), "v"(a[13]), "v"(a[14]), "v"(a[15]));
    return r; }
DI float max16f(float acc, const f32x16& a) {
    asm("v_max3_f32 %0, %0, %1, %2\n\tv_max3_f32 %0, %0, %3, %4\n\tv_max3_f32 %0, %0, %5, %6\n\tv_max3_f32 %0, %0, %7, %8\n\tv_max3_f32 %0, %0, %9, %10\n\tv_max3_f32 %0, %0, %11, %12\n\tv_max3_f32 %0, %0, %13, %14\n\tv_max3_f32 %0, %0, %15, %16"
        : "+v"(acc) : "v"(a[0]), "v"(a[1]), "v"(a[2]), "v"(a[3]), "v"(a[4]), "v"(a[5]), "v"(a[6]), "v"(a[7]), "v"(a[8]), "v"(a[9]), "v"(a[10]), "v"(a[11]), "v"(a[12]), "v"(a[13]), "v"(a[14]), "v"(a[15]));
    return acc; }
constexpr float ATT_PBIG = 4096.0f, ATT_MARGIN = 6.0f;
DI void attn_qk(const LAS unsigned char* Kb, const bf16x8 (&qf)[2][2], const float nref, f32x16 (&S)[2][2], int koff, int kswz, int hi) {
    f32x16 Cneg;
#pragma unroll
    for (int r = 0; r < 16; ++r) Cneg[r] = nref;
#pragma unroll
    for (int s = 0; s < 2; ++s)
#pragma unroll
        for (int hf = 0; hf < 2; ++hf)
#pragma unroll
            for (int m = 0; m < 2; ++m) { const bf16x8 kfr = *(const LAS bf16x8*)(Kb + hf * 4096 + koff + (((m * 4 + s * 2 + hi) ^ kswz) * 16));
                S[m][hf] = __builtin_amdgcn_mfma_f32_32x32x16_bf16(kfr, qf[m][s], s == 0 ? Cneg : S[m][hf], 0, 0, 0); }
}
DI void attn_exps(f32x16 (&S)[2][2], float (&ps)[2]) {
#pragma unroll
    for (int m = 0; m < 2; ++m) { float t = 0.f;
#pragma unroll
        for (int hf = 0; hf < 2; ++hf)
#pragma unroll
            for (int r = 0; r < 16; ++r) { S[m][hf][r] = ex2(S[m][hf][r]); t += S[m][hf][r]; }
        ps[m] = t; }
}
#define ATT_LOADV() do { _Pragma("unroll") for (int vh = 0; vh < 2; ++vh) _Pragma("unroll") for (int s = 0; s < 4; ++s) vf[vh][s] = *(const LAS bf16x8*)(Vb + vh * 4096 + voff + (((s * 2 + hi) ^ vswz) * 16)); } while (0)
DI void attn_tile(const LAS unsigned char* Kb, bool first, const bf16x8 (&qf)[2][2], f32x16 (&O)[2][2], float& nref, float (&lrun)[2], int koff, int kswz, int voff, int vswz, int hi) {
    const LAS unsigned char* Vb = Kb + 8192;
    f32x16 S[2][2]; bf16x8 vf[2][4]; float ps[2];
    bool slow = first;
    if (!first) {
        attn_qk(Kb, qf, nref, S, koff, kswz, hi);
        asm volatile("" ::: "memory");
        ATT_LOADV();
        attn_exps(S, ps);
        slow = __any(__builtin_fmaxf(ps[0], ps[1]) > ATT_PBIG); }
    if (slow) {
        attn_qk(Kb, qf, nref, S, koff, kswz, hi);
        asm volatile("s_nop 15\n\ts_nop 7" : "+v"(S[0][0]), "+v"(S[0][1]), "+v"(S[1][0]), "+v"(S[1][1]) :: "memory");
        ATT_LOADV();
        if (first) {
#pragma unroll
            for (int m = 0; m < 2; ++m) {
#pragma unroll
                for (int r = 0; r < 16; ++r) S[m][0][r] = -INFINITY;
#pragma unroll
                for (int r = 0; r < 8; ++r) S[m][1][r] = -INFINITY; } }
        float mxb;
        { float mx0 = max16f(max16f(S[0][0]), S[0][1]), mx1 = max16f(max16f(S[1][0]), S[1][1]); mxb = __builtin_fmaxf(mx0, mx1);
          const auto rr = __builtin_amdgcn_permlane32_swap(__float_as_uint(mxb), __float_as_uint(mxb), false, false); mxb = __builtin_fmaxf(__uint_as_float(rr[0]), __uint_as_float(rr[1])); }
        const float d = __builtin_fmaxf(mxb + ATT_MARGIN, first ? -INFINITY : 0.f); const float alpha = ex2(__builtin_fminf(-d, 0.f));
#pragma unroll
        for (int m = 0; m < 2; ++m) { lrun[m] *= alpha;
#pragma unroll
            for (int vh = 0; vh < 2; ++vh)
#pragma unroll
                for (int r = 0; r < 16; ++r) O[m][vh][r] *= alpha;
#pragma unroll
            for (int hf = 0; hf < 2; ++hf)
#pragma unroll
                for (int r = 0; r < 16; ++r) S[m][hf][r] -= d; }
        nref -= d;
        attn_exps(S, ps); }
#pragma unroll
    for (int m = 0; m < 2; ++m) {
        lrun[m] += ps[m];
#pragma unroll
        for (int s = 0; s < 4; ++s) { const int hf = s >> 1, b0 = 8 * (s & 1);
            u32x4 w; w.x = cvt_pk_bf16(S[m][hf][b0], S[m][hf][b0 + 1]); w.y = cvt_pk_bf16(S[m][hf][b0 + 2], S[m][hf][b0 + 3]); w.z = cvt_pk_bf16(S[m][hf][b0 + 4], S[m][hf][b0 + 5]); w.w = cvt_pk_bf16(S[m][hf][b0 + 6], S[m][hf][b0 + 7]);
            const bf16x8 pfr = __builtin_bit_cast(bf16x8, w);
#pragma unroll
            for (int vh = 0; vh < 2; ++vh) O[m][vh] = __builtin_amdgcn_mfma_f32_32x32x16_bf16(vf[vh][s], pfr, O[m][vh], 0, 0, 0); }
    }
}
#undef ATT_LOADV
constexpr int ATT_BUFB = 16384;
DI void attn_unit(Ctx& F, const Args& a, int l, int bl, int head, int j, bool dummy) {
    const int lane = opaque(threadIdx.x) & 63, r32 = lane & 31, hi = lane >> 5;
    const int wid = F.wave;
    bf16_t* Z = (bf16_t*)(F.ws + WS_Z); const bf16_t* VT = (const bf16_t*)(F.ws + WS_VT);
    const float* tab = (const float*)(F.ws + WS_TAB) + DEPTH * D + 2 * l;
    const float lam = tab[0], omli = tab[1];
    const int qt0 = j == 0 ? 0 : 4 * j - 3, nq = j == 0 ? 1 : 4;
    const int myqt = qt0 + (wid >> 1);
    const bool active = (wid >> 1) < nq;
    const int ktlast = qt0 + nq - 1;
    const int qb = (active ? myqt : qt0) * 2 + (wid & 1);
    const size_t rowq = (size_t)bl * TP + qb * 32 + r32;
    bf16_t* zq = Z + ZOFF(rowq, ZQ + head * 64);
    const int drow = 8 * wid + (lane >> 3), dch = (lane & 7) ^ ((drow >> 1) & 7);
    const unsigned kso = (unsigned)ZOFF((size_t)bl * TP + drow, ZK + head * 64 + dch * 8);
    const unsigned vso = (unsigned)((size_t)(head * 64 + drow) * MG + (size_t)bl * TP + dch * 8);
    LAS unsigned char* ring = F.lds;
#define ATT_ISSUE(kt) do { const int _b = ((kt) % 4) * ATT_BUFB + wid * 1024; \
        __builtin_amdgcn_global_load_lds((const unsigned*)(Z + (kso + (unsigned)(kt) * (64u * 512u))), (LAS unsigned*)(ring + _b), 16, 0, 0); \
        __builtin_amdgcn_global_load_lds((const unsigned*)(VT + (vso + (unsigned)(kt) * 64u)), (LAS unsigned*)(ring + _b + 8192), 16, 0, 0); } while (0)
    bf16x8 qf[2][2];
#pragma unroll
    for (int m = 0; m < 2; ++m)
#pragma unroll
        for (int s = 0; s < 2; ++s) qf[m][s] = *(const bf16x8*)(zq + m * 32 + s * 16 + hi * 8);
    if (wid >= 4) __builtin_amdgcn_s_setprio(1);
    ATT_ISSUE(0);
    if (ktlast >= 1) ATT_ISSUE(1);
    if (ktlast >= 2) ATT_ISSUE(2);
    f32x16 O[2][2];
#pragma unroll
    for (int m = 0; m < 2; ++m)
#pragma unroll
        for (int vh = 0; vh < 2; ++vh)
#pragma unroll
            for (int r = 0; r < 16; ++r) O[m][vh][r] = 0.f;
    float lrun[2] = {0.f, 0.f};
    float nref = 0.f;
    const int pr = (r32 & ~12) | ((r32 & 4) << 1) | ((r32 & 8) >> 1);
    const int koff = pr * 128, kswz = (pr >> 1) & 7, voff = r32 * 128, vswz = (r32 >> 1) & 7;
#define ATT_STEP(kt, RB) do { \
        if ((kt) + 2 <= ktlast) asm volatile("s_waitcnt vmcnt(4) lgkmcnt(0)\n\ts_barrier" ::: "memory"); \
        else if ((kt) < ktlast) asm volatile("s_waitcnt vmcnt(2) lgkmcnt(0)\n\ts_barrier" ::: "memory"); \
        else asm volatile("s_waitcnt vmcnt(0) lgkmcnt(0)\n\ts_barrier" ::: "memory"); \
        if ((kt) + 3 <= ktlast) { const int _b = (((RB) + 3) % 4) * ATT_BUFB + wid * 1024; \
            __builtin_amdgcn_global_load_lds((const unsigned*)(Z + (kso + (unsigned)((kt) + 3) * (64u * 512u))), (LAS unsigned*)(ring + _b), 16, 0, 0); \
            __builtin_amdgcn_global_load_lds((const unsigned*)(VT + (vso + (unsigned)((kt) + 3) * 64u)), (LAS unsigned*)(ring + _b + 8192), 16, 0, 0); } \
        if (active && (kt) <= myqt) attn_tile(ring + (RB) * ATT_BUFB, (kt) == 0, qf, O, nref, lrun, koff, kswz, voff, vswz, hi); } while (0)
    for (int kt0 = 0; kt0 <= ktlast; kt0 += 4) {
        ATT_STEP(kt0, 0);
        if (kt0 + 1 <= ktlast) ATT_STEP(kt0 + 1, 1);
        if (kt0 + 2 <= ktlast) ATT_STEP(kt0 + 2, 2);
        if (kt0 + 3 <= ktlast) ATT_STEP(kt0 + 3, 3);
    }
#undef ATT_STEP
#undef ATT_ISSUE
    if (active) {
        const float l1 = half_sum(lrun[0]), l2 = half_sum(lrun[1]);
        const float c1 = 1.0f / l1, c2 = lam / l2;
        float ss = 0.f;
#pragma unroll
        for (int vh = 0; vh < 2; ++vh)
#pragma unroll
            for (int r = 0; r < 16; ++r) { const float o = O[0][vh][r] * c1 - O[1][vh][r] * c2; O[0][vh][r] = o; ss += o * o; }
        ss = half_sum(ss);
        const float rms = omli / sqrtf(ss * (1.0f / 64.0f) + 1e-5f);
        const float* sg = a.in[7] + l * 64;
        bf16_t* zo = dummy ? (bf16_t*)(F.ws + WS_YSLOT) + rowq * 512 + head * 64 : zq;
#pragma unroll
        for (int vh = 0; vh < 2; ++vh)
#pragma unroll
            for (int g4 = 0; g4 < 4; g4 += 2) {
                u32x2 w[2];
#pragma unroll
                for (int q = 0; q < 2; ++q) { const int vd = vh * 32 + 8 * (g4 + q) + 4 * hi; const f32x4 gv = *(const f32x4*)(sg + vd);
                    w[q].x = cvt_pk_bf16(O[0][vh][4 * (g4 + q)] * rms * gv[0], O[0][vh][4 * (g4 + q) + 1] * rms * gv[1]); w[q].y = cvt_pk_bf16(O[0][vh][4 * (g4 + q) + 2] * rms * gv[2], O[0][vh][4 * (g4 + q) + 3] * rms * gv[3]); }
                const auto rx = __builtin_amdgcn_permlane32_swap(w[0].x, w[1].x, false, false); const auto ry = __builtin_amdgcn_permlane32_swap(w[0].y, w[1].y, false, false);
                *(u32x4*)(zo + vh * 32 + 8 * g4 + 8 * hi) = (u32x4){rx[0], ry[0], rx[1], ry[1]}; }
    }
    __builtin_amdgcn_s_setprio(0);
    asm volatile("s_waitcnt lgkmcnt(0)\n\ts_barrier" ::: "memory");
}
DI void conv_batch(Ctx& F, const Args& a, int cl, int b) {
    using namespace cv;
    const int lane = opaque(threadIdx.x) & 63;
    LAS float* scr = (LAS float*)(F.lds + F.wave * 16384);
    const int n1 = L_ALL, n2 = ffn_count(cl), base2 = ffn_base(cl);
    f32x4 la[8], lb[8];
#pragma unroll 1
    for (int k = 0; k < 4; k += 2) {
        const int j0 = b * PER_BATCH + F.wave * 4 + k, j1 = j0 + 1;
        const bool on0 = j0 < n1 + n2, on1 = j1 < n1 + n2;
        const int it0 = j0 < n1 ? cl * L_ALL + j0 : base2 + (j0 - n1), it1 = j1 < n1 ? cl * L_ALL + j1 : base2 + (j1 - n1);
        if (on0) conv_item<0>(F, a, it0, scr, lane, la);
        if (on1) conv_item<0>(F, a, it1, scr, lane, lb);
        if (on0) conv_item<1>(F, a, it0, scr, lane, la);
        if (on1) conv_item<1>(F, a, it1, scr, lane, lb); }
    __syncthreads();
}
DI void attn_phase(Ctx& F, const Args& a, int l, unsigned* qhead, bool dummy, int cl = 0) {
    const int tid = opaque(threadIdx.x);
    const unsigned NA = 17u * 64u, NB = cl ? (unsigned)((cv::L_ALL + cv::ffn_count(cl) + cv::PER_BATCH - 1) / cv::PER_BATCH) : 0u, T = NA + NB;
    for (;;) {
        if (tid == 0) F.MISC[0] = atomicAdd(qhead, 1u);
        __syncthreads();
        const unsigned t = F.MISC[0];
        __syncthreads();
        if (t >= T) break;
        const unsigned cb = (t * NB) / T, cb1 = ((t + 1u) * NB) / T;
        if (cb1 > cb) { conv_batch(F, a, cl, (int)cb); continue; }
        const unsigned u = t - cb;
        const int j = 16 - (int)(u >> 6), bh = (int)(u & 63);
        attn_unit(F, a, l, bh >> 3, bh & 7, j, dummy);
    }
}
DI void mini_dot(const bf16_t* A, int lda, const bf16_t* B, int ldb, int k0, int klen, f32x4 (&acc)[4], int lane) {
    const int rr = lane & 15, kq = (lane >> 4) * 8;
#pragma unroll 4
    for (int kk = 0; kk < klen; kk += 32) {
        const bf16x8 af = *(const bf16x8*)(A + (size_t)rr * lda + k0 + kk + kq);
#pragma unroll
        for (int cb = 0; cb < 4; ++cb) { const bf16x8 bfr = *(const bf16x8*)(B + (size_t)(cb * 16 + rr) * ldb + k0 + kk + kq);
            acc[cb] = __builtin_amdgcn_mfma_f32_16x16x32_bf16(bfr, af, acc[cb], 0, 0, 0); }
    }
}
template <int KIND>
DI void mini_task(Ctx& F, int l, int mi, int task) {
    const int tid = opaque(threadIdx.x), lane = tid & 63, wv = F.wave;
    bf16_t* Z = (bf16_t*)(F.ws + WS_Z); bf16_t* H = (bf16_t*)(F.ws + WS_H); bf16_t* ACT = (bf16_t*)(F.ws + WS_ACT);
    bf16_t* Y = (bf16_t*)((unsigned char*)F.out + OUT_Y);
    LAS float* red = (LAS float*)F.lds;
    f32x4 acc[4], acc2[4];
#pragma unroll
    for (int cb = 0; cb < 4; ++cb) { acc[cb] = (f32x4){0.f, 0.f, 0.f, 0.f}; acc2[cb] = (f32x4){0.f, 0.f, 0.f, 0.f}; }
    const size_t prow0 = PADR;
    if (KIND == 0) { const bf16_t* B = (const bf16_t*)(F.ws + WS_WMIX) + (size_t)l * D * 1536 + (size_t)task * 64 * 1536;
        mini_dot(Z + ZOFF(prow0, ZQ + wv * 64), 512, B + wv * 64, 1536, 0, 64, acc, lane);
        mini_dot(Z + ZOFF(prow0, ZGR + wv * 128), 512, B + 512 + wv * 128, 1536, 0, 128, acc2, lane); }
    if (KIND == 1) { const bf16_t* B = (const bf16_t*)(F.ws + WS_WO) + (size_t)l * D * D + (size_t)task * 64 * D;
        mini_dot(Z + ZOFF(prow0, ZGA + wv * 128), 512, B + wv * 128, D, 0, 128, acc, lane); }
    if (KIND == 2) { const bf16_t* B = (const bf16_t*)(F.ws + WS_WGUD) + (size_t)mi * PROJW * D + (size_t)task * 64 * D;
        mini_dot(H + prow0 * D, D, B, D, wv * 128, 128, acc, lane); }
    if (KIND == 3) { const bf16_t* B = (const bf16_t*)(F.ws + WS_WDD) + (size_t)mi * D * DFF + (size_t)task * 64 * DFF;
        mini_dot(ACT + (size_t)META_ACT * DFF, DFF, B, DFF, wv * 352, 352, acc, lane); }
    { const int fr = lane & 15, fq = lane >> 4;
#pragma unroll
        for (int cb = 0; cb < 4; ++cb) { *(LAS f32x4*)(red + wv * 1024 + fr * 64 + cb * 16 + 4 * fq) = acc[cb];
            if (KIND == 0) *(LAS f32x4*)(red + 8192 + wv * 1024 + fr * 64 + cb * 16 + 4 * fq) = acc2[cb]; } }
    __syncthreads();
    if (tid < 256) {
        const int row = tid >> 4, c0 = (tid & 15) * 4;
        f32x4 u = (f32x4){0.f, 0.f, 0.f, 0.f}, v = (f32x4){0.f, 0.f, 0.f, 0.f};
#pragma unroll
        for (int w = 0; w < 8; ++w) { u += *(const LAS f32x4*)(red + w * 1024 + row * 64 + c0); if (KIND == 0) v += *(const LAS f32x4*)(red + 8192 + w * 1024 + row * 64 + c0); }
        const size_t pr = prow0 + row; const int n = task * 64 + c0;
        if (KIND == 0) { const u32x2 sa = *(const u32x2*)(Z + ZOFF(pr, ZGA + n)), sl = *(const u32x2*)(Z + ZOFF(pr, ZGL + n));
            u32x2 w; w.x = cvt_pk_bf16(bf_lo(sa.x) * u[0] + bf_lo(sl.x) * v[0], bf_hi(sa.x) * u[1] + bf_hi(sl.x) * v[1]); w.y = cvt_pk_bf16(bf_lo(sa.y) * u[2] + bf_lo(sl.y) * v[2], bf_hi(sa.y) * u[3] + bf_hi(sl.y) * v[3]);
            *(u32x2*)(Z + ZOFF(pr, ZGA + n)) = w; }
        if (KIND == 1 || KIND == 3) { const u32x2 hv = *(const u32x2*)(H + pr * D + n);
            u32x2 w; w.x = cvt_pk_bf16(u[0] + ALPHA * bf_lo(hv.x), u[1] + ALPHA * bf_hi(hv.x)); w.y = cvt_pk_bf16(u[2] + ALPHA * bf_lo(hv.y), u[3] + ALPHA * bf_hi(hv.y));
            *(u32x2*)(Y + pr * D + n) = w; *(u32x2*)((bf16_t*)(F.ws + WS_MSAVE) + (size_t)((l * 2 + (KIND == 3 ? 1 : 0)) * 16 + row) * D + n) = w; }
        if (KIND == 2) {
            if ((c0 & 16) == 0) { f32x4 up = (f32x4){0.f, 0.f, 0.f, 0.f};
#pragma unroll
                for (int w = 0; w < 8; ++w) up += *(const LAS f32x4*)(red + w * 1024 + row * 64 + c0 + 16);
                const int oc = task * 32 + (c0 >> 5) * 16 + (c0 & 15);
                u32x2 w2; w2.x = cvt_pk_bf16(silu_(u[0]) * up[0], silu_(u[1]) * up[1]); w2.y = cvt_pk_bf16(silu_(u[2]) * up[2], silu_(u[3]) * up[3]);
                *(u32x2*)(ACT + (size_t)(META_ACT + row) * DFF + oc) = w2; } }
    }
    __syncthreads();
}

DI void meta_restore(Ctx& F, int slot) {
    const int tid = opaque(threadIdx.x);
    bf16_t* Y = (bf16_t*)((unsigned char*)F.out + OUT_Y); const bf16_t* save = (const bf16_t*)(F.ws + WS_MSAVE) + (size_t)slot * 16 * D;
    for (int i = tid; i < 16 * D / 8; i += 512) ((u32x4*)(Y + (size_t)PADR * D))[i] = ((const u32x4*)save)[i];
}
__global__ void __launch_bounds__(512, 2) fwd_kernel(Args a) {
    extern __shared__ __attribute__((aligned(16))) unsigned char lds_raw[];
    Ctx F;
    F.lds = (LAS unsigned char*)lds_raw; F.MISC = (volatile LAS unsigned*)(F.lds + MISC_OFF);
    F.wave = __builtin_amdgcn_readfirstlane(threadIdx.x >> 6);
    F.G = gridDim.x; F.gw = blockIdx.x * 8 + F.wave; F.NGW = F.G * 8;
    F.ws = a.ws; F.ctl = (unsigned*)(a.ws + WS_CTL); F.out = a.out;
    if (threadIdx.x < 64) F.MISC[threadIdx.x] = 0u;
    __syncthreads();
    XcdBarrier bar = xcd_barrier_post(F.ctl + CW_BAR, F.MISC + 8);
    const char* wsb = (const char*)a.ws;
    bf16_t* Zp = (bf16_t*)(a.ws + WS_Z); bf16_t* Hp = (bf16_t*)(a.ws + WS_H); bf16_t* Yp = (bf16_t*)((unsigned char*)a.out + OUT_Y);
    bf16_t* ACTp = (bf16_t*)(a.ws + WS_ACT);

#ifndef PH_MASK
#define PH_MASK 0xffff
#endif
#define GRIDBAR() do { xcd_barrier(bar); if (PROBE_DUP == 13) xcd_barrier(bar); } while (0)
    unsigned long long t_prev = PROBE_T ? wall_clock64() : 0ull, t_acc = 0ull;
#define TSTAMP(ty) do { if (PROBE_T) { const unsigned long long _t = wall_clock64(); if (PROBE_T == (ty)) t_acc += _t - t_prev; t_prev = _t; } } while (0)
    if (PROBE_DUP == 12) prologue(F, a);
    if (PH_MASK & 1) prologue(F, a);
#pragma unroll 1
    for (int g = 0; g < NGRP; ++g) {
        if (PH_MASK & 2) ln_in_phase(F, a, g);
        GRIDBAR(); TSTAMP(14);
#pragma unroll 1
        for (int l = 0; l < DEPTH; ++l) {
            const int mi = l >> 1;
            { ProbInProj P; P.Abase = wsb; P.G = F.G; P.c = opaque_s(blockIdx.x); P.offW = (unsigned)(WS_WIN + (size_t)l * PROJW * D * 2); P.bg0 = a.in[5] + (size_t)l * 2 * D; P.bg1 = P.bg0 + D; P.Z = Zp; P.VT = (bf16_t*)(a.ws + WS_VT);
              if (PROBE_DUP == 1) g8::gemm_phase(F.lds, P);
              if (PH_MASK & 4) g8::gemm_phase(F.lds, P); }
            GRIDBAR(); TSTAMP(1);
            if (PROBE_DUP == 3) lru_phase<false>(F, a, l);
            if (PH_MASK & 8) { lru_phase<true, true>(F, a, l); lru_phase<false>(F, a, l); }
            __syncthreads();
            if (PROBE_DUP == 2) attn_phase(F, a, l, F.ctl + CW_Q + 64 * (8 + g * 4 + l), true);
            if (PH_MASK & 16) attn_phase(F, a, l, F.ctl + CW_Q + 64 * (g * 4 + l), false, (g == 0 && l + 1 < DEPTH) ? l + 1 : 0);
            GRIDBAR(); TSTAMP(2);
            if (PROBE_DUP == 4) lru_phase<true>(F, a, l, true);
            if (PH_MASK & 32) lru_phase<true>(F, a, l);
            GRIDBAR(); TSTAMP(3);
            if (g == 0 && (int)blockIdx.x < 16) mini_task<0>(F, l, mi, blockIdx.x);
            { ProbMix P; P.Abase = wsb; P.G = F.G; P.c = opaque_s(blockIdx.x); P.offW = (unsigned)(WS_WMIX + (size_t)l * D * 1536 * 2); P.Z = Zp;
              if (PH_MASK & 64) g8::gemm_phase(F.lds, P); }
            GRIDBAR(); TSTAMP(4);
            if (g == 0) { if ((int)blockIdx.x < 16) mini_task<1>(F, l, mi, blockIdx.x); }
            else if (blockIdx.x == 0) meta_restore(F, l * 2);
            { ProbResid<16, 1024> P; P.Abase = wsb; P.G = F.G; P.c = opaque_s(blockIdx.x); P.offA = (unsigned)(WS_Z + (ZGA >> 9) * ZBLK * 2); P.lda2 = 1024; P.kblk = (unsigned)(ZBLK * 2); P.a_phys = 1; P.offW = (unsigned)(WS_WO + (size_t)l * D * D * 2); P.H = Hp; P.Y = Yp;
              if (PROBE_DUP == 6) g8::gemm_phase(F.lds, P);
              if (PH_MASK & 128) g8::gemm_phase(F.lds, P); }
            GRIDBAR(); TSTAMP(5);
            const float* g1 = a.in[18] + (size_t)(l * 2) * D; const float* b1 = a.in[19] + (size_t)(l * 2) * D;
            unsigned* cntw = F.ctl + CW_CNT + 64 * (g * 2 + mi);
            if ((l & 1) == 0) {
                if (PROBE_DUP == 7) ln_fast<0, false>(F, a, g, g1, b1, nullptr);
                if (PH_MASK & 256) ln_fast<0, false>(F, a, g, g1, b1, nullptr);
                GRIDBAR(); TSTAMP(6);
                if (g == 0 && (int)blockIdx.x < 88) mini_task<2>(F, l, mi, blockIdx.x);
                { ProbUpD P; P.Abase = wsb; P.G = F.G; P.c = opaque_s(blockIdx.x); P.offW = (unsigned)(WS_WGUD + (size_t)mi * PROJW * D * 2); P.ACT = ACTp;
                  if (PROBE_DUP == 8) g8::gemm_phase(F.lds, P);
                  if (PH_MASK & 512) g8::gemm_phase(F.lds, P); }
                GRIDBAR(); TSTAMP(7);
                if (g == 0) { if ((int)blockIdx.x < 16) mini_task<3>(F, l, mi, blockIdx.x); }
                else if (blockIdx.x == 0) meta_restore(F, l * 2 + 1);
                { ProbResid<44, 2816> P; P.Abase = wsb; P.G = F.G; P.c = opaque_s(blockIdx.x); P.offA = (unsigned)WS_ACT; P.lda2 = DFF * 2; P.kblk = 0; P.a_phys = 0; P.offW = (unsigned)(WS_WDD + (size_t)mi * D * DFF * 2); P.H = Hp; P.Y = Yp;
                  if (PROBE_DUP == 9) g8::gemm_phase(F.lds, P);
                  if (PH_MASK & 1024) g8::gemm_phase(F.lds, P); }
                GRIDBAR(); TSTAMP(8);
                if (PH_MASK & 256) ln_fast<0, false>(F, a, g, g1 + D, b1 + D, nullptr);
                GRIDBAR(); TSTAMP(9);
            } else {
                if (PH_MASK & 2048) ln_phase<1, false>(F, a, g, g1, b1, a.in[23] + (size_t)mi * D * 8, cntw);
                GRIDBAR(); TSTAMP(10);
                { ProbUpM P; P.Abase = wsb; P.G = F.G; P.c = opaque_s(blockIdx.x); P.offW = (unsigned)(WS_WGUM + (size_t)mi * 8 * PROJW * D * 2); P.ACT = ACTp;
                  P.list = (const int*)(a.ws + WS_ROUTE + (size_t)MG * 32); P.tab.init(cntw, 22);
                  if (PROBE_DUP == 10) g8::gemm_phase(F.lds, P);
                  if (PH_MASK & 4096) g8::gemm_phase(F.lds, P); }
                GRIDBAR(); TSTAMP(11);
                { ProbDownM P; P.Abase = wsb; P.G = F.G; P.c = opaque_s(blockIdx.x); P.offW = (unsigned)(WS_WDM + (size_t)mi * 8 * D * DFF * 2); P.YS = (bf16_t*)(a.ws + WS_YSLOT);
                  P.wlist = (const float*)(a.ws + WS_ROUTE + (size_t)MG * 32 + (size_t)8 * MG * 4); P.tab.init(cntw, 4);
                  if (PROBE_DUP == 11) g8::gemm_phase(F.lds, P);
                  if (PH_MASK & 8192) g8::gemm_phase(F.lds, P); }
                GRIDBAR(); TSTAMP(12);
                if (PH_MASK & 16384) { if (l == DEPTH - 1) ln_fast<3, true>(F, a, g, g1 + D, b1 + D, cntw);
                else ln_fast<3, false>(F, a, g, g1 + D, b1 + D, cntw); }
                GRIDBAR(); TSTAMP(13);
            }
        }
    }
    if (PROBE_T) {
        if (blockIdx.x == 0 && threadIdx.x == 0) __hip_atomic_store(F.ctl + 2048, (unsigned)(t_acc / 100ull), __ATOMIC_RELAXED, __HIP_MEMORY_SCOPE_AGENT);
        GRIDBAR();
        const float V0 = (float)__hip_atomic_load(F.ctl + 2048, __ATOMIC_RELAXED, __HIP_MEMORY_SCOPE_AGENT) * 0.01f;
        const float V = exp2f(rintf(log2f(V0 > 0.01f ? V0 : 0.01f) * 6.0f + PROBE_OFS) * (1.0f / 6.0f) - PROBE_OFS * (1.0f / 6.0f));
        for (size_t i = (size_t)blockIdx.x * 512 + threadIdx.x; i < (size_t)NBATCH * SEQ * D; i += (size_t)gridDim.x * 512) F.out[i] = V;
    }
}

extern "C" void kernel_launch(void* const* d_in, const int* in_sizes, int n_in, void* d_out, int out_size, void* d_ws, size_t ws_size, hipStream_t stream) {
    static int grid = 0;
    if (grid == 0) {
        if (n_in != 27 || out_size != NBATCH * SEQ * D || ws_size < WS_END) { fprintf(stderr, "kernel_launch: unexpected problem (n_in %d, out %d, ws %zu)\n", n_in, out_size, ws_size); grid = -1; return; }
        int dev = 0, cus = 0;
        if (hipGetDevice(&dev) != hipSuccess || hipDeviceGetAttribute(&cus, hipDeviceAttributeMultiprocessorCount, dev) != hipSuccess) { grid = -1; return; }
        if (hipFuncSetAttribute((const void*)fwd_kernel, hipFuncAttributeMaxDynamicSharedMemorySize, LDS_BYTES) != hipSuccess) { fprintf(stderr, "kernel_launch: hipFuncSetAttribute failed\n"); grid = -1; return; }
        int per_cu = 0;
        if (hipOccupancyMaxActiveBlocksPerMultiprocessor(&per_cu, (const void*)fwd_kernel, 512, LDS_BYTES) != hipSuccess || per_cu < 1) fprintf(stderr, "kernel_launch: occupancy query says %d\n", per_cu);
        (void)hipGetLastError();
        grid = cus;
    }
    if (grid < 0) return;
    (void)hipMemsetAsync((char*)d_ws + WS_CTL, 0, CTL_BYTES, stream);
    Args a{};
    for (int i = 0; i < 27; ++i) a.in[i] = (const float*)d_in[i];
    a.out = (float*)d_out; a.ws = (unsigned char*)d_ws;
    hipLaunchKernelGGL(fwd_kernel, dim3(grid), dim3(512), LDS_BYTES, stream, a);
}
```
